# Optimizing an MI355X kernel written in HIP

```python
import math
import jax, jax.numpy as jnp
from jax import lax
import numpy as np

D_MODEL = 1024
BATCH = 4
SEQ = 4096
DEPTH = 2

HEAD_DIM = 64
N_HEADS_TOTAL = D_MODEL // HEAD_DIM
N_SB_HEADS = N_HEADS_TOTAL // 4
DIL_GROUPS = ((128, 1), (512, 4), (2048, 16))
N_DIL_GROUPS = len(DIL_GROUPS)
HEADS_PER_GROUP = (N_HEADS_TOTAL - N_SB_HEADS) // N_DIL_GROUPS
N_DIL_HEADS = HEADS_PER_GROUP * N_DIL_GROUPS
D_DIL = N_DIL_HEADS * HEAD_DIM
D_DIL_OUT = HEADS_PER_GROUP * HEAD_DIM
D_SB = N_SB_HEADS * HEAD_DIM
D_IN = 3 * D_DIL + 3 * D_SB + 2 * D_MODEL
D_FF = 128 * ((8 * D_MODEL // 3 + 127) // 128)
ROPE_THETA = 500000.0
ROPE_DIM = HEAD_DIM // 4
Q_BLOCK = 128
RMS_EPS = 1e-6

kernel_name = "hybrid_dilated_stickbreaking_macaron"


def rms_norm(x, gain):
    xf = x.astype(jnp.float32)
    xf = xf * lax.rsqrt(jnp.mean(xf * xf, axis=-1, keepdims=True) + RMS_EPS)
    return (xf * gain.astype(jnp.float32)).astype(x.dtype)


def swiglu(x, w_gate, w_up, w_down):
    return (jax.nn.silu(x @ w_gate) * (x @ w_up)) @ w_down


def rope_tables(seq_len):
    pos = jnp.arange(seq_len, dtype=jnp.float32)
    inv_freq = ROPE_THETA ** (-jnp.arange(0, ROPE_DIM, 2, dtype=jnp.float32) / ROPE_DIM)
    ang = pos[:, None] * inv_freq[None, :]
    return jnp.cos(ang), jnp.sin(ang)


def apply_partial_rope(x, cos, sin):
    half = ROPE_DIM // 2
    x1 = x[..., :half]
    x2 = x[..., half:ROPE_DIM]
    c = cos.astype(x.dtype)
    s = sin.astype(x.dtype)
    return jnp.concatenate([x1 * c - x2 * s, x2 * c + x1 * s, x[..., ROPE_DIM:]], axis=-1)


def dilated_window_attention(q, k, v, window, dilation):
    B, H, T, dh = q.shape
    span = window // dilation
    unit = span * dilation
    t_pad = -(-T // unit) * unit
    n_sub = t_pad // dilation
    n_blk = n_sub // span

    def to_blocks(a):
        a = jnp.pad(a, ((0, 0), (0, 0), (0, t_pad - T), (0, 0)))
        a = a.reshape(B, H, n_sub, dilation, dh).transpose(0, 1, 3, 2, 4)
        return a.reshape(B, H, dilation, n_blk, span, dh)

    qb, kb, vb = to_blocks(q), to_blocks(k), to_blocks(v)

    def with_prev(a):
        prev = jnp.pad(a, ((0, 0), (0, 0), (0, 0), (1, 0), (0, 0), (0, 0)))[:, :, :, :-1]
        return jnp.concatenate([prev, a], axis=4)

    kw, vw = with_prev(kb), with_prev(vb)
    s = jnp.einsum('bhrnqd,bhrnkd->bhrnqk', qb, kw).astype(jnp.float32) * (dh ** -0.5)
    qi = jnp.arange(span)[:, None]
    kj = jnp.arange(2 * span)[None, :]
    dist = qi + span - kj
    band = (dist >= 0) & (dist <= span)
    blk = jnp.arange(n_blk)[:, None, None]
    valid = band[None] & ((blk > 0) | (kj >= span)[None])
    s = jnp.where(valid, s, -jnp.inf)
    m = jnp.max(s, axis=-1, keepdims=True)
    p = jnp.exp(s - m)
    denom = jnp.sum(p, axis=-1, keepdims=True)
    o = jnp.einsum('bhrnqk,bhrnkd->bhrnqd', p, vw.astype(jnp.float32)) / denom
    lse = (m + jnp.log(denom))[..., 0]
    o = o.reshape(B, H, dilation, n_sub, dh).transpose(0, 1, 3, 2, 4).reshape(B, H, t_pad, dh)[:, :, :T]
    lse = lse.reshape(B, H, dilation, n_sub).transpose(0, 1, 3, 2).reshape(B, H, t_pad)[:, :, :T]
    return o, lse


def stick_breaking_attention(q, k, v):
    B, H, T, dh = q.shape
    n_blk = T // Q_BLOCK
    qb = q.reshape(B, H, n_blk, Q_BLOCK, dh).transpose(2, 0, 1, 3, 4)
    kpos = jnp.arange(T)
    vf = v.astype(jnp.float32)

    def block(args):
        q_blk, b = args
        z = jnp.einsum('bhqd,bhkd->bhqk', q_blk, k).astype(jnp.float32) * (dh ** -0.5)
        qpos = b * Q_BLOCK + jnp.arange(Q_BLOCK)
        past = kpos[None, :] < qpos[:, None]
        log_beta = jax.nn.log_sigmoid(z)
        log_keep = jnp.where(past, jax.nn.log_sigmoid(-z), 0.0)
        after = lax.cumsum(log_keep, axis=3, reverse=True) - log_keep
        w = jnp.where(past, jnp.exp(log_beta + after), 0.0)
        return jnp.einsum('bhqk,bhkd->bhqd', w, vf)

    o = lax.map(block, (qb, jnp.arange(n_blk)))
    return o.transpose(1, 2, 0, 3, 4).reshape(B, H, T, dh).astype(q.dtype)


def hybrid_mixer(h, w_in, w_proj_dil, w_proj_sb, w_out, cos, sin):
    B, T, _ = h.shape
    proj = h @ w_in
    o1 = 3 * D_DIL
    o2 = o1 + 3 * D_SB
    o3 = o2 + D_MODEL
    qkv_d = proj[..., :o1].reshape(B, T, 3, N_DIL_HEADS, HEAD_DIM).transpose(2, 0, 3, 1, 4)
    q_d = apply_partial_rope(qkv_d[0], cos, sin)
    k_d = apply_partial_rope(qkv_d[1], cos, sin)
    v_d = qkv_d[2]
    outs, lses = [], []
    for g, (window, dilation) in enumerate(DIL_GROUPS):
        hs = slice(g * HEADS_PER_GROUP, (g + 1) * HEADS_PER_GROUP)
        o, lse = dilated_window_attention(q_d[:, hs], k_d[:, hs], v_d[:, hs], window, dilation)
        outs.append(o)
        lses.append(lse)
    w_grp = jax.nn.softmax(jnp.stack(lses, axis=0), axis=0)
    o_dil = jnp.sum(w_grp[..., None] * jnp.stack(outs, axis=0), axis=0).astype(h.dtype)
    o_dil = o_dil.transpose(0, 2, 1, 3).reshape(B, T, D_DIL_OUT)
    qkv_s = proj[..., o1:o2].reshape(B, T, 3, N_SB_HEADS, HEAD_DIM).transpose(2, 0, 3, 1, 4)
    o_sb = stick_breaking_attention(qkv_s[0], qkv_s[1], qkv_s[2])
    o_sb = o_sb.transpose(0, 2, 1, 3).reshape(B, T, D_SB)
    gate_dil = jax.nn.sigmoid(proj[..., o2:o3])
    gate_sb = jax.nn.sigmoid(proj[..., o3:])
    y = gate_dil * (o_dil @ w_proj_dil) + gate_sb * (o_sb @ w_proj_sb)
    return y @ w_out


def setup_inputs(seed: int = 0) -> dict:
    key = jax.random.key(seed)
    ks = jax.random.split(key, 16)
    f32 = jnp.float32

    def dense(k, shape, fan_in):
        return jax.random.normal(k, shape, f32) * (fan_in ** -0.5)

    def gain(k, shape):
        return 1.0 + 0.05 * jax.random.normal(k, shape, f32)

    return {
        "x": jax.random.normal(ks[0], (BATCH, SEQ, D_MODEL), f32),
        "norm_ffn1": gain(ks[1], (DEPTH, D_MODEL)),
        "ffn1_w_gate": dense(ks[2], (DEPTH, D_MODEL, D_FF), D_MODEL),
        "ffn1_w_up": dense(ks[3], (DEPTH, D_MODEL, D_FF), D_MODEL),
        "ffn1_w_down": dense(ks[4], (DEPTH, D_FF, D_MODEL), D_FF),
        "norm_mix": gain(ks[5], (DEPTH, D_MODEL)),
        "w_in": dense(ks[6], (DEPTH, D_MODEL, D_IN), D_MODEL),
        "w_proj_dil": dense(ks[7], (DEPTH, D_DIL_OUT, D_MODEL), D_DIL_OUT),
        "w_proj_sb": dense(ks[8], (DEPTH, D_SB, D_MODEL), D_SB),
        "w_out": dense(ks[9], (DEPTH, D_MODEL, D_MODEL), D_MODEL),
        "norm_ffn2": gain(ks[10], (DEPTH, D_MODEL)),
        "ffn2_w_gate": dense(ks[11], (DEPTH, D_MODEL, D_FF), D_MODEL),
        "ffn2_w_up": dense(ks[12], (DEPTH, D_MODEL, D_FF), D_MODEL),
        "ffn2_w_down": dense(ks[13], (DEPTH, D_FF, D_MODEL), D_FF),
        "norm_final": gain(ks[14], (D_MODEL,)),
    }


def reference(x, norm_ffn1, ffn1_w_gate, ffn1_w_up, ffn1_w_down, norm_mix, w_in,
              w_proj_dil, w_proj_sb, w_out, norm_ffn2, ffn2_w_gate, ffn2_w_up,
              ffn2_w_down, norm_final):
    T = x.shape[1]
    cos, sin = rope_tables(T)
    for l in range(DEPTH):
        x = x + 0.5 * swiglu(rms_norm(x, norm_ffn1[l]), ffn1_w_gate[l], ffn1_w_up[l], ffn1_w_down[l])
        x = x + hybrid_mixer(rms_norm(x, norm_mix[l]), w_in[l], w_proj_dil[l], w_proj_sb[l],
                             w_out[l], cos, sin)
        x = x + 0.5 * swiglu(rms_norm(x, norm_ffn2[l]), ffn2_w_gate[l], ffn2_w_up[l], ffn2_w_down[l])
    return rms_norm(x, norm_final)
```

```cpp
#include <hip/hip_runtime.h>
#include <hip/hip_cooperative_groups.h>
#include <cstdio>
#include <cstdint>
namespace cg = cooperative_groups;
namespace pg8 {
#define PG8_LAS __attribute__((address_space(3)))
typedef unsigned short bf16_t;
typedef short bf16x8 __attribute__((ext_vector_type(8)));
typedef float f32x4 __attribute__((ext_vector_type(4)));
typedef unsigned u32x4 __attribute__((ext_vector_type(4)));
constexpr int BM = 256, BK = 64, HALF = 128, HTB = HALF * BK * 2  , STAGE_BYTES = 8 * HTB, NXCD = 8, WGM = 8;

__host__ __device__ __forceinline__ int lds_byte(int r, int c) { const int st = (r >> 4) * 2 + (c >> 5), rr = r & 15, cc = c & 31, ob = rr * 64 + cc * 2; return st * 1024 + (ob ^ (((ob >> 9) & 1) << 5)); }
__host__ __device__ __forceinline__ void stage_rc(int b, int& R, int& C) { const int st = b / 1024, sb = b % 1024, swz = sb ^ (((sb >> 9) & 1) << 5); R = (st >> 1) * 16 + swz / 64; C = (st & 1) * 32 + (swz % 64) / 2; }
__host__ __device__ __forceinline__ int perm32(int rho) { const int n = rho >> 4, i = rho & 15; return 8 * (i >> 2) + 4 * n + (i & 3); }

struct Unit { int pm, pn, ui, sel; };
struct Gemm { const bf16_t* A; const bf16_t* Bt; int M, N, K; const bf16_t* A2 = nullptr; const bf16_t* Bt2 = nullptr; };

struct StaticOrder {
    int nM, nN, nwg, G, c;
    __host__ __device__ void init(int M, int N, int G_, int c_) { nM = M / BM; nN = N / BM; nwg = nM * nN; G = G_; c = c_; }
    __host__ __device__ bool next(int i, Unit& u) const {
        const long L = (long)i * G + c; if (L >= nwg) return false;
        int wgid = (int)L; { const int q = nwg / NXCD, r = nwg % NXCD, xcd = wgid % NXCD, off = wgid / NXCD; wgid = (xcd < r ? xcd * (q + 1) : r * (q + 1) + (xcd - r) * q) + off; }
        const int nig = WGM * nN, gid = wgid / nig, fm = gid * WGM, gsz = (nM - fm) < WGM ? (nM - fm) : WGM;
        u.pm = fm + ((wgid % nig) % gsz); u.pn = (wgid % nig) / gsz; u.ui = i; u.sel = 0; return true;
    }
    __device__ __forceinline__ void a_ready(const Unit&) const {}
    __device__ __forceinline__ void done(const Unit&) const {}
};
struct PairOrder : StaticOrder {
    __host__ __device__ bool next(int i, Unit& u) const { if (i >= 2) return false; if (!StaticOrder::next(0, u)) return false; u.ui = i; u.sel = i; return true; }
};

typedef float f32x2_cv __attribute__((ext_vector_type(2))); typedef __bf16 bf16x2_cv __attribute__((ext_vector_type(2)));
__device__ __forceinline__ unsigned cvt_pk_bf16(float lo, float hi) { const f32x2_cv v = {lo, hi}; const bf16x2_cv b = __builtin_convertvector(v, bf16x2_cv); return __builtin_bit_cast(unsigned, b); }
typedef unsigned u32x2 __attribute__((ext_vector_type(2)));
constexpr float LOG2E = 1.4426950408889634f;
constexpr int RSL_UNITS = 8;
__device__ __forceinline__ float row_rstd(const float* ssqp, int r) {
    const f32x4* p = (const f32x4*)(ssqp + (size_t)r * 16);
    const f32x4 a = p[0], b = p[1], c = p[2], d = p[3];
    const float s = (((a[0] + a[1]) + (a[2] + a[3])) + ((b[0] + b[1]) + (b[2] + b[3]))) + (((c[0] + c[1]) + (c[2] + c[3])) + ((d[0] + d[1]) + (d[2] + d[3])));
    return __builtin_amdgcn_rsqf(s * (1.0f / 1024.0f) + 1e-6f);
}
__device__ __forceinline__ float bf2f(unsigned short b) { return __uint_as_float(((unsigned)b) << 16); }
struct EpiSwiglu {
    static constexpr bool PERM = true, AFTER_DRAIN = false, HAS_INIT = false;
    bf16_t* H; const float* ssqp; const PG8_LAS float* rsl;
    __device__ __forceinline__ void operator()(const f32x4 (&acc)[2][2][4][2], const Unit& u, int wr, int wc, int fr, int fq) const {
        const int row0 = u.pm * BM + wr * 64 + fr, col0 = u.pn * 128 + wc * 32 + 8 * fq;
#pragma unroll
        for (int ai = 0; ai < 2; ++ai)
#pragma unroll
            for (int m = 0; m < 4; ++m) {
                const int r = row0 + ai * HALF + m * 16; const float rs = rsl[u.ui * 256 + ai * HALF + wr * 64 + m * 16 + fr];
                const float nrl = -rs * LOG2E, rs2 = rs * rs; f32x4 hq[2];
#pragma unroll
                for (int n = 0; n < 2; ++n) { const f32x4 ga = acc[ai][0][m][n], ua = acc[ai][1][m][n]; const f32x4 x = ga * nrl; f32x4 e;
                    e[0] = __builtin_amdgcn_exp2f(x[0]); e[1] = __builtin_amdgcn_exp2f(x[1]); e[2] = __builtin_amdgcn_exp2f(x[2]); e[3] = __builtin_amdgcn_exp2f(x[3]);
                    const f32x4 d = e + 1.0f; f32x4 rc; rc[0] = __builtin_amdgcn_rcpf(d[0]); rc[1] = __builtin_amdgcn_rcpf(d[1]); rc[2] = __builtin_amdgcn_rcpf(d[2]); rc[3] = __builtin_amdgcn_rcpf(d[3]);
                    hq[n] = (ga * ua) * (rc * rs2); }
                u32x4 w; w.x = cvt_pk_bf16(hq[0][0], hq[0][1]); w.y = cvt_pk_bf16(hq[0][2], hq[0][3]); w.z = cvt_pk_bf16(hq[1][0], hq[1][1]); w.w = cvt_pk_bf16(hq[1][2], hq[1][3]);
                *(u32x4*)(H + ((unsigned)r * 2816u + (unsigned)col0)) = w;
            }
    }
};
template <bool BASE32> struct EpiResid {
    static constexpr bool PERM = true, AFTER_DRAIN = false, HAS_INIT = true;
    const float* base32; bf16_t* xb; float* ssqp; float alpha;
    __device__ __forceinline__ void init(f32x4 (&acc)[2][2][4][2], const Unit& u, int wr, int wc, int fr, int fq) const {
        const unsigned row0 = u.pm * BM + wr * 64 + fr, col0 = u.pn * BM + wc * 32 + 8 * fq; const float ia = 1.0f / alpha;
#pragma unroll
        for (int ai = 0; ai < 2; ++ai)
#pragma unroll
            for (int m = 0; m < 4; ++m)
#pragma unroll
                for (int bj = 0; bj < 2; ++bj) { const unsigned off = (row0 + ai * HALF + m * 16) * 1024u + col0 + bj * HALF;
                    f32x4 b0, b1;
                    if (BASE32) { b0 = *(const f32x4*)(base32 + off); b1 = *(const f32x4*)(base32 + off + 4); }
                    else { const u32x4 bw = *(const u32x4*)(xb + off);
                        b0[0] = __uint_as_float(bw.x << 16); b0[1] = __uint_as_float(bw.x & 0xffff0000u); b0[2] = __uint_as_float(bw.y << 16); b0[3] = __uint_as_float(bw.y & 0xffff0000u);
                        b1[0] = __uint_as_float(bw.z << 16); b1[1] = __uint_as_float(bw.z & 0xffff0000u); b1[2] = __uint_as_float(bw.w << 16); b1[3] = __uint_as_float(bw.w & 0xffff0000u); }
                    acc[ai][bj][m][0] = b0 * ia; acc[ai][bj][m][1] = b1 * ia; }
    }
    __device__ __forceinline__ void operator()(const f32x4 (&acc)[2][2][4][2], const Unit& u, int wr, int wc, int fr, int fq) const {
        const unsigned row0 = u.pm * BM + wr * 64 + fr, col0 = u.pn * BM + wc * 32 + 8 * fq;
#pragma unroll
        for (int ai = 0; ai < 2; ++ai)
#pragma unroll
            for (int m = 0; m < 4; ++m) {
                const unsigned r = row0 + ai * HALF + m * 16; float s = 0.f;
#pragma unroll
                for (int bj = 0; bj < 2; ++bj) { const unsigned off = r * 1024u + col0 + bj * HALF;
                    const f32x4 o0 = acc[ai][bj][m][0] * alpha, o1 = acc[ai][bj][m][1] * alpha;
                    u32x4 w; w.x = cvt_pk_bf16(o0[0], o0[1]); w.y = cvt_pk_bf16(o0[2], o0[3]); w.z = cvt_pk_bf16(o1[0], o1[1]); w.w = cvt_pk_bf16(o1[2], o1[3]);
                    *(u32x4*)(xb + off) = w;
                    f32x4 q0, q1;
                    q0[0] = __uint_as_float(w.x << 16); q0[1] = __uint_as_float(w.x & 0xffff0000u); q0[2] = __uint_as_float(w.y << 16); q0[3] = __uint_as_float(w.y & 0xffff0000u);
                    q1[0] = __uint_as_float(w.z << 16); q1[1] = __uint_as_float(w.z & 0xffff0000u); q1[2] = __uint_as_float(w.w << 16); q1[3] = __uint_as_float(w.w & 0xffff0000u);
                    const f32x4 sq = q0 * q0 + q1 * q1; s += (sq[0] + sq[1]) + (sq[2] + sq[3]); }
                { const auto t16 = __builtin_amdgcn_permlane16_swap(__float_as_uint(s), __float_as_uint(s), false, false); s = __uint_as_float(t16[0]) + __uint_as_float(t16[1]);
                  const auto t32 = __builtin_amdgcn_permlane32_swap(__float_as_uint(s), __float_as_uint(s), false, false); s = __uint_as_float(t32[0]) + __uint_as_float(t32[1]); }
                if (fq == 0) ssqp[r * 16u + u.pn * 4 + wc] = s;
            }
    }
};
struct EpiResidFinal {
    static constexpr bool PERM = true, AFTER_DRAIN = true, HAS_INIT = true;
    const bf16_t* xb; float* out; const float* gain; unsigned* xslot; unsigned* cnt; float alpha;
    __device__ __forceinline__ void init(f32x4 (&acc)[2][2][4][2], const Unit& u, int wr, int wc, int fr, int fq) const {
        const unsigned row0 = u.pm * BM + wr * 64 + fr, col0 = u.pn * BM + wc * 32 + 8 * fq; const float ia = 1.0f / alpha;
#pragma unroll
        for (int ai = 0; ai < 2; ++ai)
#pragma unroll
            for (int m = 0; m < 4; ++m)
#pragma unroll
                for (int bj = 0; bj < 2; ++bj) { const unsigned off = (row0 + ai * HALF + m * 16) * 1024u + col0 + bj * HALF; const u32x4 bw = *(const u32x4*)(xb + off); f32x4 b0, b1;
                    b0[0] = __uint_as_float(bw.x << 16); b0[1] = __uint_as_float(bw.x & 0xffff0000u); b0[2] = __uint_as_float(bw.y << 16); b0[3] = __uint_as_float(bw.y & 0xffff0000u);
                    b1[0] = __uint_as_float(bw.z << 16); b1[1] = __uint_as_float(bw.z & 0xffff0000u); b1[2] = __uint_as_float(bw.w << 16); b1[3] = __uint_as_float(bw.w & 0xffff0000u);
                    acc[ai][bj][m][0] = b0 * ia; acc[ai][bj][m][1] = b1 * ia; }
    }
    __device__ __forceinline__ void fused(f32x4 (&acc)[2][2][4][2], const Unit& u, int wr, int wc, int fr, int fq, PG8_LAS unsigned char* lds, int wid, int lane) const {
        PG8_LAS float* P = (PG8_LAS float*)lds;
        PG8_LAS float* S = (PG8_LAS float*)(lds + 4096);
        const int tid = wid * 64 + lane;
#pragma unroll
        for (int ai = 0; ai < 2; ++ai)
#pragma unroll
            for (int m = 0; m < 4; ++m) { float s = 0.f;
#pragma unroll
                for (int bj = 0; bj < 2; ++bj)
#pragma unroll
                    for (int n = 0; n < 2; ++n) { const f32x4 o = acc[ai][bj][m][n] * alpha; acc[ai][bj][m][n] = o; const f32x4 q = o * o; s += (q[0] + q[1]) + (q[2] + q[3]); }
                { const auto t16 = __builtin_amdgcn_permlane16_swap(__float_as_uint(s), __float_as_uint(s), false, false); s = __uint_as_float(t16[0]) + __uint_as_float(t16[1]);
                  const auto t32 = __builtin_amdgcn_permlane32_swap(__float_as_uint(s), __float_as_uint(s), false, false); s = __uint_as_float(t32[0]) + __uint_as_float(t32[1]); }
                if (fq == 0) P[(ai * HALF + wr * 64 + m * 16 + fr) * 4 + wc] = s; }
        asm volatile("s_waitcnt lgkmcnt(0)" ::: "memory"); __builtin_amdgcn_s_barrier(); asm volatile("" ::: "memory");
        if (tid < 256) { const float t = (P[tid * 4 + 0] + P[tid * 4 + 1]) + (P[tid * 4 + 2] + P[tid * 4 + 3]);
            __hip_atomic_store(xslot + ((size_t)(u.pm * BM + tid) * 4 + u.pn), __float_as_uint(t), __ATOMIC_RELAXED, __HIP_MEMORY_SCOPE_AGENT); }
        asm volatile("s_waitcnt vmcnt(0)" ::: "memory");
        if (lane == 0) __hip_atomic_fetch_add(cnt + 64 * u.pm, 1u, __ATOMIC_RELAXED, __HIP_MEMORY_SCOPE_AGENT);
        if (wid == 0) { unsigned spins = 0;
            while ((unsigned)__builtin_amdgcn_readfirstlane(__hip_atomic_load(cnt + 64 * u.pm, __ATOMIC_RELAXED, __HIP_MEMORY_SCOPE_AGENT)) < 32u) { __builtin_amdgcn_s_sleep(2); if (++spins > (1u << 20)) break; }
            __builtin_amdgcn_fence(__ATOMIC_ACQUIRE, "agent"); }
        asm volatile("s_waitcnt vmcnt(0) lgkmcnt(0)" ::: "memory"); __builtin_amdgcn_s_barrier(); asm volatile("" ::: "memory");
        if (tid < 256) { const unsigned* sl = xslot + (size_t)(u.pm * BM + tid) * 4; float t = 0.f;
#pragma unroll
            for (int k = 0; k < 4; ++k) t += __uint_as_float(__hip_atomic_load(sl + k, __ATOMIC_RELAXED, __HIP_MEMORY_SCOPE_AGENT));
            S[tid] = __builtin_amdgcn_rsqf(t * (1.0f / 1024.0f) + 1e-6f); }
        asm volatile("s_waitcnt vmcnt(0) lgkmcnt(0)" ::: "memory"); __builtin_amdgcn_s_barrier(); asm volatile("" ::: "memory");
        const unsigned row0 = u.pm * BM + wr * 64 + fr, col0 = u.pn * BM + wc * 32 + 8 * fq;
        f32x4 gv[2][2];
#pragma unroll
        for (int bj = 0; bj < 2; ++bj) { gv[bj][0] = *(const f32x4*)(gain + col0 + bj * HALF); gv[bj][1] = *(const f32x4*)(gain + col0 + bj * HALF + 4); }
#pragma unroll
        for (int ai = 0; ai < 2; ++ai)
#pragma unroll
            for (int m = 0; m < 4; ++m) { const float rs = S[ai * HALF + wr * 64 + m * 16 + fr]; const unsigned r = row0 + ai * HALF + m * 16;
#pragma unroll
                for (int bj = 0; bj < 2; ++bj) { float* op = out + (r * 1024u + col0 + bj * HALF);
                    *(f32x4*)op = acc[ai][bj][m][0] * rs * gv[bj][0]; *(f32x4*)(op + 4) = acc[ai][bj][m][1] * rs * gv[bj][1]; } }
    }
};
struct EpiWin {
    static constexpr bool PERM = true, AFTER_DRAIN = false, HAS_INIT = false;
    bf16_t* QKV; bf16_t* GATE; const float* ssqp; const float* rope; const PG8_LAS float* rsl;
    __device__ __forceinline__ void operator()(const f32x4 (&acc)[2][2][4][2], const Unit& u, int wr, int wc, int fr, int fq) const {
        const int row0 = u.pm * BM + wr * 64 + fr; const int pn = u.pn; const bool isgate = pn >= 12;
        const bool dorope = (pn < 6) && ((wc & 1) == 0) && (fq < 2); const float qs = (pn < 3 || pn == 9) ? 0.125f : 1.0f;
#pragma unroll
        for (int ai = 0; ai < 2; ++ai)
#pragma unroll
            for (int m = 0; m < 4; ++m) {
                const int r = row0 + ai * HALF + m * 16; const float rs = rsl[u.ui * 256 + ai * HALF + wr * 64 + m * 16 + fr]; const int t = r & 4095;
#pragma unroll
                for (int bj = 0; bj < 2; ++bj) {
                    const int colt = bj * HALF + wc * 32 + 8 * fq; float v[8];
#pragma unroll
                    for (int n = 0; n < 2; ++n)
#pragma unroll
                        for (int j = 0; j < 4; ++j) v[n * 4 + j] = acc[ai][bj][m][n][j] * rs;
                    bf16_t* dst;
                    if (isgate) {
#pragma unroll
                        for (int i = 0; i < 8; ++i) v[i] = __builtin_amdgcn_rcpf(1.0f + __builtin_amdgcn_exp2f(-v[i] * LOG2E));
                        dst = GATE + ((unsigned)r * 2048u + (unsigned)((pn - 12) * 256 + colt));
                    } else {
                        if (dorope) {
                            const f32x4* cs = (const f32x4*)(rope + ((unsigned)t * 16u + 8u * (unsigned)fq));
                            const f32x4 c01 = cs[0], c23 = cs[1];
                            { const float x1 = v[0], x2 = v[1]; v[0] = x1 * c01[0] - x2 * c01[1]; v[1] = x2 * c01[0] + x1 * c01[1]; }
                            { const float x1 = v[2], x2 = v[3]; v[2] = x1 * c01[2] - x2 * c01[3]; v[3] = x2 * c01[2] + x1 * c01[3]; }
                            { const float x1 = v[4], x2 = v[5]; v[4] = x1 * c23[0] - x2 * c23[1]; v[5] = x2 * c23[0] + x1 * c23[1]; }
                            { const float x1 = v[6], x2 = v[7]; v[6] = x1 * c23[2] - x2 * c23[3]; v[7] = x2 * c23[2] + x1 * c23[3]; }
                        }
#pragma unroll
                        for (int i = 0; i < 8; ++i) v[i] *= qs;
                        { const unsigned cc = (unsigned)(pn * 256 + colt); dst = QKV + (((cc >> 6) * 16384u + (unsigned)r) * 64u + (cc & 63u)); }
                    }
                    u32x4 w; w.x = cvt_pk_bf16(v[0], v[1]); w.y = cvt_pk_bf16(v[2], v[3]); w.z = cvt_pk_bf16(v[4], v[5]); w.w = cvt_pk_bf16(v[6], v[7]);
                    *(u32x4*)dst = w;
                }
                asm volatile("" ::: "memory");
            }
    }
};
template <bool SECOND> struct EpiGate {
    static constexpr bool PERM = true, AFTER_DRAIN = false, HAS_INIT = false;
    const bf16_t* gate; bf16_t* Y1; bf16_t* Y;
    __device__ __forceinline__ void operator()(const f32x4 (&acc)[2][2][4][2], const Unit& u, int wr, int wc, int fr, int fq) const {
        const unsigned row0 = u.pm * BM + wr * 64 + fr, col0 = u.pn * BM + wc * 32 + 8 * fq;
#pragma unroll
        for (int ai = 0; ai < 2; ++ai)
#pragma unroll
            for (int m = 0; m < 4; ++m) {
                const unsigned r = row0 + ai * HALF + m * 16;
#pragma unroll
                for (int bj = 0; bj < 2; ++bj) {
                    const unsigned c = col0 + bj * HALF; const unsigned go = r * 2048u + c, yo = r * 1024u + c;
                    const u32x4 gw = *(const u32x4*)(gate + go);
                    f32x4 a0 = acc[ai][bj][m][0], a1 = acc[ai][bj][m][1];
                    a0[0] *= __uint_as_float(gw.x << 16); a0[1] *= __uint_as_float(gw.x & 0xffff0000u); a0[2] *= __uint_as_float(gw.y << 16); a0[3] *= __uint_as_float(gw.y & 0xffff0000u);
                    a1[0] *= __uint_as_float(gw.z << 16); a1[1] *= __uint_as_float(gw.z & 0xffff0000u); a1[2] *= __uint_as_float(gw.w << 16); a1[3] *= __uint_as_float(gw.w & 0xffff0000u);
                    if (!SECOND) { u32x4 w; w.x = cvt_pk_bf16(a0[0], a0[1]); w.y = cvt_pk_bf16(a0[2], a0[3]); w.z = cvt_pk_bf16(a1[0], a1[1]); w.w = cvt_pk_bf16(a1[2], a1[3]); *(u32x4*)(Y1 + yo) = w; }
                    else { const u32x4 yw = *(const u32x4*)(Y1 + yo);
                        a0[0] += __uint_as_float(yw.x << 16); a0[1] += __uint_as_float(yw.x & 0xffff0000u); a0[2] += __uint_as_float(yw.y << 16); a0[3] += __uint_as_float(yw.y & 0xffff0000u);
                        a1[0] += __uint_as_float(yw.z << 16); a1[1] += __uint_as_float(yw.z & 0xffff0000u); a1[2] += __uint_as_float(yw.w << 16); a1[3] += __uint_as_float(yw.w & 0xffff0000u);
                        u32x4 w; w.x = cvt_pk_bf16(a0[0], a0[1]); w.y = cvt_pk_bf16(a0[2], a0[3]); w.z = cvt_pk_bf16(a1[0], a1[1]); w.w = cvt_pk_bf16(a1[2], a1[3]);
                        __builtin_amdgcn_raw_buffer_store_b128(w, __builtin_amdgcn_make_buffer_rsrc(Y, 0, 16384 * 1024 * 2, 0x00020000), yo * 2u, 0,   16); }
                    asm volatile("" ::: "memory");
                }
            }
    }
};
struct EpiGate2 {
    static constexpr bool PERM = true, AFTER_DRAIN = false, HAS_INIT = false;
    const bf16_t* gate; bf16_t* Y1; bf16_t* Y;
    __device__ __forceinline__ void operator()(const f32x4 (&acc)[2][2][4][2], const Unit& u, int wr, int wc, int fr, int fq) const {
        const unsigned row0 = u.pm * BM + wr * 64 + fr, col0 = u.pn * BM + wc * 32 + 8 * fq; const bool second = u.sel != 0; const unsigned gofs = second ? 1024u : 0u;
#pragma unroll
        for (int ai = 0; ai < 2; ++ai)
#pragma unroll
            for (int m = 0; m < 4; ++m) {
                const unsigned r = row0 + ai * HALF + m * 16;
#pragma unroll
                for (int bj = 0; bj < 2; ++bj) {
                    const unsigned c = col0 + bj * HALF; const unsigned go = r * 2048u + gofs + c, yo = r * 1024u + c;
                    const u32x4 gw = *(const u32x4*)(gate + go);
                    f32x4 a0 = acc[ai][bj][m][0], a1 = acc[ai][bj][m][1];
                    a0[0] *= __uint_as_float(gw.x << 16); a0[1] *= __uint_as_float(gw.x & 0xffff0000u); a0[2] *= __uint_as_float(gw.y << 16); a0[3] *= __uint_as_float(gw.y & 0xffff0000u);
                    a1[0] *= __uint_as_float(gw.z << 16); a1[1] *= __uint_as_float(gw.z & 0xffff0000u); a1[2] *= __uint_as_float(gw.w << 16); a1[3] *= __uint_as_float(gw.w & 0xffff0000u);
                    if (second) { const u32x4 yw = *(const u32x4*)(Y1 + yo);
                        a0[0] += __uint_as_float(yw.x << 16); a0[1] += __uint_as_float(yw.x & 0xffff0000u); a0[2] += __uint_as_float(yw.y << 16); a0[3] += __uint_as_float(yw.y & 0xffff0000u);
                        a1[0] += __uint_as_float(yw.z << 16); a1[1] += __uint_as_float(yw.z & 0xffff0000u); a1[2] += __uint_as_float(yw.w << 16); a1[3] += __uint_as_float(yw.w & 0xffff0000u); }
                    u32x4 w; w.x = cvt_pk_bf16(a0[0], a0[1]); w.y = cvt_pk_bf16(a0[2], a0[3]); w.z = cvt_pk_bf16(a1[0], a1[1]); w.w = cvt_pk_bf16(a1[2], a1[3]);
                    if (second) __builtin_amdgcn_raw_buffer_store_b128(w, __builtin_amdgcn_make_buffer_rsrc(Y, 0, 16384 * 1024 * 2, 0x00020000), yo * 2u, 0,   16);
                    else *(u32x4*)(Y1 + yo) = w;
                    asm volatile("" ::: "memory");
                }
            }
    }
};

template <class Epi, class Sched, bool ALIGN_EPI = false, bool SP2 = false>
__device__ __forceinline__ void gemm_phase(PG8_LAS unsigned char* lds, const Gemm g, const Sched& S, const Epi& E) {
    int tid_ = threadIdx.x; asm volatile("" : "+v"(tid_));
    const int tid = tid_, wid = __builtin_amdgcn_readfirstlane(tid >> 6), lane = tid & 63, wr = wid >> 2, wc = wid & 3, fr = lane & 15, fq = lane >> 4;
    const int K = g.K, nt = K / BK;
    unsigned voffA[2], voffB[2];
#pragma unroll
    for (int i = 0; i < 2; ++i) { int R, C; stage_rc(tid * 16 + i * 8192, R, C); const int Rb = Epi::PERM ? ((R & ~31) + perm32(R & 31)) : R;
        voffA[i] = (unsigned)(R * K + C) * 2u; voffB[i] = (unsigned)(Rb * K + C) * 2u; }
    const size_t kstep = (size_t)(BK * 2);
    const size_t hstep = (size_t)HALF * K * 2;
    const size_t tstep = 2 * hstep;
    const unsigned ldsw = (unsigned)wid * 1024u;
    const int aoff = lds_byte(wr * 64 + fr, fq * 8), boff = lds_byte(wc * 32 + fr, fq * 8);
#define PG8_SA(b, h) (((b) * 2 + (h)) * HTB)
#define PG8_SB(b, h) ((4 + (b) * 2 + (h)) * HTB)
#define PG8_STAGE(bufoff, gbase, voff) do { _Pragma("unroll") for (int _i = 0; _i < 2; ++_i) \
        __builtin_amdgcn_global_load_lds((const unsigned*)((const char*)(gbase) + (voff)[_i]), (PG8_LAS unsigned*)(lds + (bufoff) + ldsw + _i * 8192), 16, 0, 0); } while (0)
#define PG8_LDA(dst, b, h) do { _Pragma("unroll") for (int m = 0; m < 4; ++m) _Pragma("unroll") for (int k = 0; k < 2; ++k) dst[m][k] = *(const PG8_LAS bf16x8*)(lds + PG8_SA(b, h) + aoff + m * 2048 + k * 1024); } while (0)
#define PG8_LDB(dst, b, h) do { _Pragma("unroll") for (int n = 0; n < 2; ++n) _Pragma("unroll") for (int k = 0; k < 2; ++k) dst[n][k] = *(const PG8_LAS bf16x8*)(lds + PG8_SB(b, h) + boff + n * 2048 + k * 1024); } while (0)
#define PG8_MMA(ai, bj, At, Bt) do { __builtin_amdgcn_s_setprio(1); _Pragma("unroll") for (int m = 0; m < 4; ++m) _Pragma("unroll") for (int n = 0; n < 2; ++n) _Pragma("unroll") for (int k = 0; k < 2; ++k) \
        acc[ai][bj][m][n] = __builtin_amdgcn_mfma_f32_16x16x32_bf16(Bt[n][k], At[m][k], acc[ai][bj][m][n], 0, 0, 0); __builtin_amdgcn_s_setprio(0); } while (0)
#define PG8_WAIT_V(n) asm volatile("s_waitcnt vmcnt(" #n ")" ::: "memory")
#define PG8_WAIT_L(n) asm volatile("s_waitcnt lgkmcnt(" #n ")" ::: "memory")
#define PG8_BAR __builtin_amdgcn_s_barrier()
#define PG8_SCHED __builtin_amdgcn_sched_barrier(0)
    Unit cur, nxt; int ui = 0;
    if (!S.next(0, cur)) return;
    f32x4 acc[2][2][4][2];
    if constexpr (Epi::HAS_INIT) E.init(acc, cur, wr, wc, fr, fq);
    else {
#pragma unroll
    for (int a = 0; a < 2; ++a)
#pragma unroll
        for (int b = 0; b < 2; ++b)
#pragma unroll
            for (int m = 0; m < 4; ++m)
#pragma unroll
                for (int n = 0; n < 2; ++n) acc[a][b][m][n] = (f32x4){0.f, 0.f, 0.f, 0.f};
    }
    bf16x8 At[4][2], B0[2][2], B1[2][2];
    const char* cA = (const char*)(cur.sel ? g.A2 : g.A) + (size_t)cur.pm * tstep; const char* cB = (const char*)(cur.sel ? g.Bt2 : g.Bt) + (size_t)cur.pn * tstep;
    S.a_ready(cur);
    if constexpr (SP2) {
        PG8_STAGE(PG8_SB(0, 0), cB, voffB); PG8_STAGE(PG8_SB(0, 1), cB + hstep, voffB); PG8_STAGE(PG8_SA(0, 0), cA, voffA); PG8_STAGE(PG8_SA(0, 1), cA + hstep, voffA);
        if (wr == 1) PG8_BAR;
        PG8_WAIT_V(2); PG8_BAR;
        PG8_STAGE(PG8_SB(1, 0), cB + kstep, voffB); PG8_STAGE(PG8_SA(1, 0), cA + kstep, voffA); PG8_STAGE(PG8_SB(1, 1), cB + hstep + kstep, voffB);
        PG8_WAIT_V(6); PG8_BAR;
    } else {
        PG8_STAGE(PG8_SB(0, 0), cB, voffB); PG8_STAGE(PG8_SA(0, 0), cA, voffA); PG8_STAGE(PG8_SB(0, 1), cB + hstep, voffB); PG8_STAGE(PG8_SA(0, 1), cA + hstep, voffA);
        if (wr == 1) PG8_BAR;
        PG8_WAIT_V(4); PG8_BAR;
        PG8_STAGE(PG8_SB(1, 0), cB + kstep, voffB); PG8_STAGE(PG8_SA(1, 0), cA + kstep, voffA); PG8_STAGE(PG8_SB(1, 1), cB + hstep + kstep, voffB);
        PG8_WAIT_V(6); PG8_BAR;
    }
    for (;;) {
        const bool has_next = S.next(ui + 1, nxt);
        const char* nA = has_next ? (const char*)(nxt.sel ? g.A2 : g.A) + (size_t)nxt.pm * tstep : cA; const char* nB = has_next ? (const char*)(nxt.sel ? g.Bt2 : g.Bt) + (size_t)nxt.pn * tstep : cB;
        for (int t = 0; t < nt; t += 2) {
            const bool last = (t == nt - 2);
            const char* a1 = cA + (size_t)(t + 1) * kstep;
            const char* a2 = last ? nA : cA + (size_t)(t + 2) * kstep; const char* b2 = last ? nB : cB + (size_t)(t + 2) * kstep;
            const char* a3 = a2 + kstep; const char* b3 = b2 + kstep;
            if (last && has_next) S.a_ready(nxt);
            if constexpr (SP2) {
            PG8_LDB(B0, 0, 0); PG8_LDB(B1, 0, 1); PG8_SCHED; PG8_LDA(At, 0, 0); PG8_STAGE(PG8_SA(1, 1), a1 + hstep, voffA);
            PG8_WAIT_V(8); PG8_WAIT_L(0); PG8_BAR; PG8_MMA(0, 0, At, B0); PG8_MMA(0, 1, At, B1); PG8_BAR; PG8_SCHED;
            PG8_LDA(At, 0, 1); PG8_STAGE(PG8_SB(0, 0), b2, voffB); PG8_STAGE(PG8_SB(0, 1), b2 + hstep, voffB); PG8_STAGE(PG8_SA(0, 0), a2, voffA);
            PG8_WAIT_V(8); PG8_WAIT_L(0); PG8_BAR; PG8_MMA(1, 0, At, B0); PG8_MMA(1, 1, At, B1); PG8_BAR; PG8_SCHED;
            PG8_LDB(B0, 1, 0); PG8_LDB(B1, 1, 1); PG8_SCHED; PG8_LDA(At, 1, 0); PG8_STAGE(PG8_SA(0, 1), a2 + hstep, voffA);
            PG8_WAIT_V(8); PG8_WAIT_L(0); PG8_BAR; PG8_MMA(0, 0, At, B0); PG8_MMA(0, 1, At, B1); PG8_BAR; PG8_SCHED;
            PG8_LDA(At, 1, 1); PG8_STAGE(PG8_SB(1, 0), b3, voffB); PG8_STAGE(PG8_SB(1, 1), b3 + hstep, voffB); PG8_STAGE(PG8_SA(1, 0), a3, voffA);
            PG8_WAIT_V(8); PG8_WAIT_L(0); PG8_BAR; PG8_MMA(1, 0, At, B0); PG8_MMA(1, 1, At, B1); PG8_BAR; PG8_SCHED;
            } else {
            PG8_LDB(B0, 0, 0); PG8_SCHED; PG8_LDA(At, 0, 0); PG8_STAGE(PG8_SA(1, 1), a1 + hstep, voffA);
            PG8_WAIT_L(8); PG8_BAR; PG8_WAIT_L(0); PG8_MMA(0, 0, At, B0); PG8_BAR; PG8_SCHED;
            PG8_LDB(B1, 0, 1); PG8_STAGE(PG8_SB(0, 0), b2, voffB);
            PG8_BAR; PG8_WAIT_L(0); PG8_MMA(0, 1, At, B1); PG8_BAR;
            PG8_LDA(At, 0, 1); PG8_STAGE(PG8_SA(0, 0), a2, voffA);
            PG8_BAR; PG8_WAIT_L(0); PG8_MMA(1, 0, At, B0); PG8_BAR; PG8_SCHED;
            PG8_STAGE(PG8_SB(0, 1), b2 + hstep, voffB);
            PG8_WAIT_V(6); PG8_BAR; PG8_MMA(1, 1, At, B1); PG8_BAR;
            PG8_LDB(B0, 1, 0); PG8_SCHED; PG8_LDA(At, 1, 0); PG8_STAGE(PG8_SA(0, 1), a2 + hstep, voffA);
            PG8_WAIT_L(8); PG8_BAR; PG8_WAIT_L(0); PG8_MMA(0, 0, At, B0); PG8_BAR; PG8_SCHED;
            PG8_LDB(B1, 1, 1); PG8_STAGE(PG8_SB(1, 0), b3, voffB);
            PG8_BAR; PG8_WAIT_L(0); PG8_MMA(0, 1, At, B1); PG8_BAR;
            PG8_LDA(At, 1, 1); PG8_STAGE(PG8_SA(1, 0), a3, voffA);
            PG8_BAR; PG8_WAIT_L(0); PG8_MMA(1, 0, At, B0); PG8_BAR; PG8_SCHED;
            PG8_STAGE(PG8_SB(1, 1), b3 + hstep, voffB);
            PG8_WAIT_V(6); PG8_BAR; PG8_MMA(1, 1, At, B1); PG8_BAR;
            }
        }
        if constexpr (ALIGN_EPI) { if (wr == 0) PG8_BAR; }
        if constexpr (!Epi::AFTER_DRAIN) { E(acc, cur, wr, wc, fr, fq); S.done(cur); }
        if (!has_next) break;
        if constexpr (Epi::HAS_INIT) E.init(acc, nxt, wr, wc, fr, fq);
        else {
#pragma unroll
        for (int a = 0; a < 2; ++a)
#pragma unroll
            for (int b = 0; b < 2; ++b)
#pragma unroll
                for (int m = 0; m < 4; ++m)
#pragma unroll
                    for (int n = 0; n < 2; ++n) acc[a][b][m][n] = (f32x4){0.f, 0.f, 0.f, 0.f};
        }
        cur = nxt; cA = nA; cB = nB; ++ui;
        if constexpr (ALIGN_EPI) { if (wr == 1) PG8_BAR; }
    }
    PG8_WAIT_V(0);
    if constexpr (!ALIGN_EPI) { if (wr == 0) PG8_BAR; }
    PG8_BAR;
    if constexpr (Epi::AFTER_DRAIN) { E.fused(acc, cur, wr, wc, fr, fq, lds, wid, lane); S.done(cur); }
#undef PG8_SA
#undef PG8_SB
#undef PG8_STAGE
#undef PG8_LDA
#undef PG8_LDB
#undef PG8_MMA
#undef PG8_WAIT_V
#undef PG8_WAIT_L
#undef PG8_BAR
#undef PG8_SCHED
}
}

#define LAS __attribute__((address_space(3)))
typedef unsigned short bf16;
typedef short bf16x8 __attribute__((ext_vector_type(8)));
typedef short s16x4 __attribute__((ext_vector_type(4)));
typedef float f32x4 __attribute__((ext_vector_type(4)));
typedef float f32x16 __attribute__((ext_vector_type(16)));
typedef unsigned u32x4 __attribute__((ext_vector_type(4)));
typedef unsigned u32x2 __attribute__((ext_vector_type(2)));
constexpr int NWAVES = 8;
constexpr int M = 16384, D = 1024, SEQ = 4096, FF = 2816, NIN = 5120, NQKV = 3072, NGATE = 2048, DEPTH = 2;
constexpr float LOG2E = 1.4426950408889634f;
#ifndef SB_EARLY_EXIT
#define SB_EARLY_EXIT 1
#endif
#ifndef N_LAUNCH_MODE
#define N_LAUNCH_MODE 0
#endif
constexpr size_t MiB = 1u << 20;
constexpr size_t WS_CNT = 16384, WS_PCNT = 32768, WS_ZERO_BYTES = 32768 + 4 * 16384;
constexpr size_t WS_XSLOT = 250 * MiB;
constexpr size_t WS_BAR = 0;
constexpr size_t WS_SSQ = 1 * MiB, WS_ROPE = 2 * MiB, WS_LSE = 3 * MiB;
constexpr size_t WS_W = 4 * MiB;
constexpr size_t W_1CAT = 0, W_D1 = W_1CAT + (size_t)2 * FF * D * 2, W_IN = W_D1 + (size_t)D * FF * 2, W_PD = W_IN + (size_t)NIN * D * 2, W_PS = W_PD + (size_t)D * 256 * 2,
                 W_OUT = W_PS + (size_t)D * 256 * 2, W_2CAT = W_OUT + (size_t)D * D * 2, W_D2 = W_2CAT + (size_t)2 * FF * D * 2, W_END = W_D2 + (size_t)D * FF * 2;
static_assert(W_END <= 46 * MiB, "weights");
constexpr size_t WS_XB = 50 * MiB;
constexpr size_t OUT_OD3 = 0, OUT_OD = 24 * MiB;
constexpr size_t WS_R = 82 * MiB;
constexpr size_t WS_Y1 = WS_R, WS_Y = WS_R + 64 * MiB;
constexpr size_t WS_GATE = 178 * MiB;
constexpr size_t WS_OS = 242 * MiB;
constexpr size_t WS_END = 251 * MiB;
constexpr int RSL_OFF = 131072 + 1024;
constexpr int LDS_BYTES = RSL_OFF + 8 * 256 * 4;

__device__ __forceinline__ float wave_sum(float v) {
#pragma unroll
    for (int o = 1; o < 64; o <<= 1) v += __shfl_xor(v, o);
    return v;
}
__device__ __forceinline__ unsigned pk2(float lo, float hi) { return pg8::cvt_pk_bf16(lo, hi); }
#define LDS_WAIT() asm volatile("s_waitcnt lgkmcnt(0)" ::: "memory")

typedef __attribute__((address_space(1))) unsigned gu32;
#define XB_TMO      128
#define XB_XCNT(j)  (256  + 64 * (j))
#define XB_XSUB(j)  (1280 + 64 * (j))
#define XB_XGEN(j)  (2304 + 64 * (j))
#define XB_TOP      3328
#define XB_TOPGEN   3392
#define XCD_BAR_WORDS 3456
#define XB_SPIN_CAP (1u << 18)

__device__ __forceinline__ unsigned xb_ld(unsigned* p)              { return __hip_atomic_load(p, __ATOMIC_RELAXED, __HIP_MEMORY_SCOPE_AGENT); }
__device__ __forceinline__ unsigned xb_add(unsigned* p, unsigned v) { return __hip_atomic_fetch_add(p, v, __ATOMIC_RELAXED, __HIP_MEMORY_SCOPE_AGENT); }
__device__ __forceinline__ unsigned xb_xcc_id() { return (unsigned)__builtin_amdgcn_s_getreg((3 << 11) | 20) & 0xFu; }
#define XB_SPIN(cond, bar) do { unsigned _sp = 0; while (cond) { __builtin_amdgcn_s_sleep(1); \
    if ((++_sp & 255u) == 0u) { if (xb_ld(&(bar)[XB_TMO])) break; if (_sp > XB_SPIN_CAP) { atomicAdd(&(bar)[XB_TMO], 1u); break; } } } } while (0)

struct XcdBarrier {
    unsigned* bar; unsigned x;
    volatile LAS unsigned* st;
};

__device__ __forceinline__ XcdBarrier xcd_barrier_post(unsigned* bar, volatile LAS unsigned* st) {
    XcdBarrier b; b.bar = bar; b.x = xb_xcc_id(); b.st = st;
    if (threadIdx.x == 0) (void)xb_add(&bar[XB_XCNT(b.x)], 1u);
    return b;
}
__device__ __forceinline__ void xcd_barrier_complete(unsigned* bar, unsigned x, unsigned& nloc, unsigned& nx) {
    const unsigned G = gridDim.x * gridDim.y * gridDim.z;
    unsigned sum, cnt, mine, sp = 0u;
    for (;;) {
        sum = 0u; cnt = 0u; mine = 0u;
#pragma unroll
        for (unsigned j = 0; j < 16; ++j) { const unsigned c = xb_ld(&bar[XB_XCNT(j)]); sum += c; cnt += (c > 0u) ? 1u : 0u; mine = (j == x) ? c : mine; }
        if (sum == G) break;
        __builtin_amdgcn_s_sleep(1);
        if ((++sp & 255u) == 0u) { if (xb_ld(&bar[XB_TMO])) break; if (sp > XB_SPIN_CAP) { atomicAdd(&bar[XB_TMO], 1u); break; } }
    }
    nloc = mine > 0u ? mine : 1u; nx = cnt > 0u ? cnt : 1u;
}

__device__ __forceinline__ void xcd_barrier(const XcdBarrier& b) {
    asm volatile("s_waitcnt vmcnt(0)" ::: "memory");
    __syncthreads();
    if (threadIdx.x == 0) {
        unsigned* bar = b.bar;
        __builtin_amdgcn_s_waitcnt(0);
        unsigned nloc = b.st[0], nx = b.st[1];
        if (nloc == 0u) { xcd_barrier_complete(bar, b.x, nloc, nx); b.st[0] = nloc; b.st[1] = nx; }
        const unsigned old = xb_add(&bar[XB_XSUB(b.x)], 1u);
        const unsigned gen = old / nloc;
        if (old + 1u == (gen + 1u) * nloc) {
            __builtin_amdgcn_fence(__ATOMIC_RELEASE, "agent");
            asm volatile("s_waitcnt vmcnt(0)" ::: "memory");
            const unsigned og = xb_add(&bar[XB_TOP], 1u);
            const unsigned tg = og / nx;
            if (og + 1u == (tg + 1u) * nx) xb_add(&bar[XB_TOPGEN], 1u);
            else XB_SPIN(xb_ld(&bar[XB_TOPGEN]) == tg, bar);
            __builtin_amdgcn_fence(__ATOMIC_ACQUIRE, "agent");
            xb_add(&bar[XB_XGEN(b.x)], 1u);
            asm volatile("s_waitcnt vmcnt(0)" ::: "memory");
        } else {
            XB_SPIN(xb_ld(&bar[XB_XGEN(b.x)]) == gen, bar);
            __builtin_amdgcn_fence(__ATOMIC_ACQUIRE, "agent");
            asm volatile("s_waitcnt vmcnt(0)" ::: "memory");
        }
    }
    __syncthreads();
}


template <class Sched> __device__ __forceinline__ void fill_rstd_table(const Sched& S, const float* ssqp, LAS unsigned char* lds, int tid) {
    LAS float* rsl_w = (LAS float*)(lds + RSL_OFF); const int half = tid >> 8, row = tid & 255;
    f32x4 pv[4][4]; bool ok[4];
#pragma unroll
    for (int k = 0; k < 4; ++k) { pg8::Unit uu; ok[k] = S.next(2 * k + half, uu);
        if (ok[k]) { const f32x4* p = (const f32x4*)(ssqp + (size_t)(uu.pm * 256 + row) * 16); pv[k][0] = p[0]; pv[k][1] = p[1]; pv[k][2] = p[2]; pv[k][3] = p[3]; } }
#pragma unroll
    for (int k = 0; k < 4; ++k) if (ok[k]) { const f32x4 t = (pv[k][0] + pv[k][1]) + (pv[k][2] + pv[k][3]);
        rsl_w[(2 * k + half) * 256 + row] = __builtin_amdgcn_rsqf(((t[0] + t[1]) + (t[2] + t[3])) * (1.0f / 1024.0f) + 1e-6f); }
    __syncthreads();
}
constexpr int CI_D1 = 2816, CI_IN = 4224, CI_B = 6784, CI_D2 = 9600, CI_PD = 11008, CI_PS = 11136, CI_OUT = 11264, CI_END = 11776;
struct ConvItem { const float* wp; const float* gp; bf16* dp; int ldw, K; bool rperm; };
struct ConvSrc { const float *n1, *wg1, *wu1, *wd1, *nm, *win, *wpd, *wps, *wout, *n2, *wg2, *wu2, *wd2; };
__device__ __forceinline__ ConvItem conv_decode(const ConvSrc& S, int l, int r, unsigned char* dA, unsigned char* dB, int lane) {
    const float* src; const float* gain = nullptr; bf16* dst; int ldw = D, K = D, kb, nb, sc0; bool rperm = false;
    if (r < CI_D1) { kb = r / 176; nb = r % 176; const int pn = nb >> 3, i8 = nb & 7; src = (i8 < 4 ? S.wg1 : S.wu1) + (size_t)l * D * FF; gain = S.n1 + (size_t)l * D; dst = (bf16*)(dA + W_1CAT); ldw = FF; sc0 = 128 * pn + 32 * (i8 & 3); }
    else if (r < CI_IN) { r -= CI_D1; kb = r / 32; nb = r % 32; src = S.wd1 + (size_t)l * FF * D; dst = (bf16*)(dA + W_D1); K = FF; sc0 = 32 * nb; }
    else if (r < CI_B) { r -= CI_IN; kb = r / 160; nb = r % 160; src = S.win + (size_t)l * D * NIN; gain = S.nm + (size_t)l * D; dst = (bf16*)(dA + W_IN); ldw = NIN; sc0 = 32 * nb; rperm = (nb < 48) && !(nb & 1); }
    else if (r < CI_D2) { r -= CI_B; kb = r / 176; nb = r % 176; const int pn = nb >> 3, i8 = nb & 7; src = (i8 < 4 ? S.wg2 : S.wu2) + (size_t)l * D * FF; gain = S.n2 + (size_t)l * D; dst = (bf16*)(dB + W_2CAT); ldw = FF; sc0 = 128 * pn + 32 * (i8 & 3); }
    else if (r < CI_PD) { r -= CI_D2; kb = r / 32; nb = r % 32; src = S.wd2 + (size_t)l * FF * D; dst = (bf16*)(dB + W_D2); K = FF; sc0 = 32 * nb; }
    else if (r < CI_PS) { r -= CI_PD; kb = r / 32; nb = r % 32; src = S.wpd + (size_t)l * 256 * D; dst = (bf16*)(dB + W_PD); K = 256; sc0 = 32 * nb; }
    else if (r < CI_OUT) { r -= CI_PS; kb = r / 32; nb = r % 32; src = S.wps + (size_t)l * 256 * D; dst = (bf16*)(dB + W_PS); K = 256; sc0 = 32 * nb; }
    else { r -= CI_OUT; kb = r / 32; nb = r % 32; src = S.wout + (size_t)l * D * D; dst = (bf16*)(dB + W_OUT); sc0 = 32 * nb; }
    const int c4 = lane & 7, kr = lane >> 3, k0 = 64 * kb;
    ConvItem I; I.wp = src + (size_t)(k0 + kr) * ldw + sc0 + 4 * c4; I.gp = gain ? gain + k0 + kr : nullptr; I.dp = dst + (size_t)(32 * nb) * K + k0; I.ldw = ldw; I.K = K; I.rperm = rperm;
    return I;
}
__device__ __forceinline__ void conv_load(f32x4 (&v)[8], const ConvItem& I) {
#pragma unroll
    for (int i = 0; i < 8; ++i) v[i] = *(const f32x4*)(I.wp + (size_t)(8 * i) * I.ldw);
}
__device__ __forceinline__ void conv_finish(f32x4 (&v)[8], const ConvItem& I, LAS float* scr, int lane) {
    const int c4 = lane & 7, kr = lane >> 3;
    if (I.gp) {
#pragma unroll
        for (int i = 0; i < 8; ++i) v[i] *= I.gp[8 * i];
    }
    int p[4];
#pragma unroll
    for (int e = 0; e < 4; ++e) { const int sc = 4 * c4 + e; p[e] = (I.rperm && sc < 16) ? (sc < 8 ? 2 * sc : 2 * (sc - 8) + 1) : sc; }
#pragma unroll
    for (int i = 0; i < 8; ++i)
#pragma unroll
        for (int e = 0; e < 4; ++e) scr[(kr + 8 * i) * 33 + p[e]] = v[i][e];
    LDS_WAIT();
    const int c = lane & 7;
#pragma unroll
    for (int jj = 0; jj < 4; ++jj) { const int n = (lane >> 3) + 8 * jj; const LAS float* s = scr + (8 * c) * 33 + n;
        u32x4 o; o.x = pk2(s[0 * 33], s[1 * 33]); o.y = pk2(s[2 * 33], s[3 * 33]); o.z = pk2(s[4 * 33], s[5 * 33]); o.w = pk2(s[6 * 33], s[7 * 33]);
        *(u32x4*)(I.dp + (size_t)n * I.K + 8 * c) = o; }
    LDS_WAIT();
}
__device__ __forceinline__ void conv_items(const ConvSrc& S, int l, int lo, int hi, unsigned char* dA, unsigned char* dB, LAS unsigned char* lds, int widx, int nw, int wave, int lane) {
    LAS float* scr = (LAS float*)(lds + wave * 8704);
    int it = lo + widx; if (it >= hi) return;
    ConvItem cur = conv_decode(S, l, __builtin_amdgcn_readfirstlane(it), dA, dB, lane); f32x4 v[8]; conv_load(v, cur);
    for (;;) {
        const int itn = it + nw; const bool more = itn < hi;
        ConvItem nxt = cur; f32x4 vn[8];
        if (more) { nxt = conv_decode(S, l, __builtin_amdgcn_readfirstlane(itn), dA, dB, lane); conv_load(vn, nxt); }
        conv_finish(v, cur, scr, lane);
        if (!more) break;
        cur = nxt; it = itn;
#pragma unroll
        for (int i = 0; i < 8; ++i) v[i] = vn[i];
    }
}
__device__ __forceinline__ void conv_phase(const float* Px, const ConvSrc& S, unsigned char* Pws, int l, LAS unsigned char* lds, int gw, int NGW, int wave, int lane) {
    unsigned char* wsw = Pws + WS_W;
    conv_items(S, l, 0, CI_END, wsw, wsw, lds, gw, NGW, wave, lane);
    if (l == 0) {
        const float* x = Px; bf16* xb = (bf16*)(Pws + WS_XB); float* ssqp = (float*)(Pws + WS_SSQ);
        for (int m = gw; m < M; m += NGW) {
            const f32x4* xr = (const f32x4*)(x + (size_t)m * D) + 2 * lane; f32x4 v[4]; float s = 0.f;
#pragma unroll
            for (int j = 0; j < 2; ++j) { v[2 * j] = xr[128 * j]; v[2 * j + 1] = xr[128 * j + 1]; }
#pragma unroll
            for (int j = 0; j < 4; ++j) s += (v[j][0] * v[j][0] + v[j][1] * v[j][1]) + (v[j][2] * v[j][2] + v[j][3] * v[j][3]);
            s = wave_sum(s);
            u32x4* o = (u32x4*)(xb + (size_t)m * D) + lane;
#pragma unroll
            for (int j = 0; j < 2; ++j) { u32x4 w; w.x = pk2(v[2 * j][0], v[2 * j][1]); w.y = pk2(v[2 * j][2], v[2 * j][3]); w.z = pk2(v[2 * j + 1][0], v[2 * j + 1][1]); w.w = pk2(v[2 * j + 1][2], v[2 * j + 1][3]); o[64 * j] = w; }
            if (lane < 16) ssqp[(size_t)m * 16 + lane] = (lane == 0) ? s : 0.f;
        }
        float* rope = (float*)(Pws + WS_ROPE);
        for (int idx = gw * 64 + lane; idx < SEQ * 8; idx += NGW * 64) {
            const int t = idx >> 3, i = idx & 7;
            const float invf = (i == 0) ? 1.0f : (i == 1) ? 0.1939227432012558f : (i == 2) ? 0.03760603070259094f : (i == 3) ? 0.007292664609849453f : (i == 4) ? 0.0014142135623842478f
                             : (i == 5) ? 0.00027424818836152554f : (i == 6) ? 5.3182957344688475e-05f : 1.0313385246263351e-05f;
            const float angf = (float)t * invf; const double a = (double)angf;
            const double kq = __builtin_rint(a * 0.63661977236758134308);
            double rr = __builtin_fma(-kq, 1.57079632679489655800, a); rr = __builtin_fma(-kq, 6.12323399573676603587e-17, rr);
            const int qd = ((int)kq) & 3; const float rf = (float)rr, r2 = rf * rf;
            const float sn = rf + rf * r2 * (-1.0f / 6 + r2 * (1.0f / 120 + r2 * (-1.0f / 5040 + r2 * (1.0f / 362880))));
            const float cn = 1.0f + r2 * (-0.5f + r2 * (1.0f / 24 + r2 * (-1.0f / 720 + r2 * (1.0f / 40320 + r2 * (-1.0f / 3628800)))));
            const float c = (qd == 0) ? cn : (qd == 1) ? -sn : (qd == 2) ? -cn : sn;
            const float s = (qd == 0) ? sn : (qd == 1) ? cn : (qd == 2) ? -sn : -cn;
            rope[2 * idx] = c; rope[2 * idx + 1] = s;
        }
    }
}

__device__ __forceinline__ int crow(int r, int hi) { return (r & 3) + 8 * (r >> 2) + 4 * hi; }
struct F2 { float a, b; };
__device__ __forceinline__ F2 pair32(float v) { const auto rr = __builtin_amdgcn_permlane32_swap(__float_as_uint(v), __float_as_uint(v), false, false); return F2{__uint_as_float(rr[0]), __uint_as_float(rr[1])}; }
__device__ __forceinline__ void ld_frag4(bf16x8 (&f)[4], const bf16* ubase, unsigned rowstride, int lane) {
    const unsigned off = (unsigned)(lane & 31) * rowstride + (unsigned)(lane >> 5) * 8u;
#pragma unroll
    for (int d0 = 0; d0 < 4; ++d0) f[d0] = *(const bf16x8*)(ubase + (off + d0 * 16));
}
__device__ __forceinline__ f32x16 qk_tile(const bf16x8 (&kf)[4], const bf16x8 (&qf)[4]) {
    f32x16 s = {};
#pragma unroll
    for (int d0 = 0; d0 < 4; ++d0) s = __builtin_amdgcn_mfma_f32_32x32x16_bf16(kf[d0], qf[d0], s, 0, 0, 0);
    return s;
}
__device__ __forceinline__ void v_load(u32x4 (&vr)[4], const bf16* ubase, unsigned rowstride, int lane) {
#pragma unroll
    for (int i = 0; i < 4; ++i) { const unsigned c = lane + 64 * i; vr[i] = *(const u32x4*)(ubase + ((c >> 3) * rowstride + (c & 7) * 8u)); }
}
__device__ __forceinline__ void v_stage(LAS unsigned char* vb, const u32x4 (&vr)[4], int lane) {
#pragma unroll
    for (int i = 0; i < 4; ++i) { const int c = lane + 64 * i, key = c >> 3, ch = c & 7; *(LAS u32x4*)(vb + key * 128 + ((ch * 16) ^ (((key >> 1) & 1) << 6))) = vr[i]; }
}
__device__ __forceinline__ void pv_tile(f32x16 (&o)[2], LAS unsigned char* vb, const f32x16& p, int lane) {
    const int hi = lane >> 5, g1 = (lane >> 4) & 1, q4 = (lane & 15) >> 2, pp = lane & 3;
    bf16x8 pf[2];
#pragma unroll
    for (int s = 0; s < 2; ++s) { u32x4 w; w.x = pk2(p[8 * s + 0], p[8 * s + 1]); w.y = pk2(p[8 * s + 2], p[8 * s + 3]); w.z = pk2(p[8 * s + 4], p[8 * s + 5]); w.w = pk2(p[8 * s + 6], p[8 * s + 7]);
        pf[s] = __builtin_bit_cast(bf16x8, w); }
    const int swz = ((q4 >> 1) & 1) << 6;
#pragma unroll
    for (int dblk = 0; dblk < 2; ++dblk)
#pragma unroll
        for (int s = 0; s < 2; ++s) {
            const int colb = (dblk * 64 + g1 * 32 + pp * 8) ^ swz;
            const int row0 = 16 * s + 4 * hi + q4;
            const s16x4 t0 = __builtin_bit_cast(s16x4, __builtin_amdgcn_ds_read_tr16_b64_v4i16((LAS s16x4*)(vb + row0 * 128 + colb)));
            const s16x4 t1 = __builtin_bit_cast(s16x4, __builtin_amdgcn_ds_read_tr16_b64_v4i16((LAS s16x4*)(vb + (row0 + 8) * 128 + colb)));
            const bf16x8 a = (bf16x8){t0[0], t0[1], t0[2], t0[3], t1[0], t1[1], t1[2], t1[3]};
            o[dblk] = __builtin_amdgcn_mfma_f32_32x32x16_bf16(a, pf[s], o[dblk], 0, 0, 0);
        }
}
__device__ __forceinline__ void store_ot(bf16* rowp, const f32x16 (&o)[2], float sc, int hi) {
#pragma unroll
    for (int dblk = 0; dblk < 2; ++dblk)
#pragma unroll
        for (int p = 0; p < 2; ++p) {
            const unsigned x0 = pk2(o[dblk][8 * p] * sc, o[dblk][8 * p + 1] * sc), x1 = pk2(o[dblk][8 * p + 2] * sc, o[dblk][8 * p + 3] * sc);
            const unsigned y0 = pk2(o[dblk][8 * p + 4] * sc, o[dblk][8 * p + 5] * sc), y1 = pk2(o[dblk][8 * p + 6] * sc, o[dblk][8 * p + 7] * sc);
            const auto s0 = __builtin_amdgcn_permlane32_swap(x0, y0, false, false), s1 = __builtin_amdgcn_permlane32_swap(x1, y1, false, false);
            u32x4 w; w.x = s0[0]; w.y = s1[0]; w.z = s0[1]; w.w = s1[1];
            *(u32x4*)(rowp + dblk * 32 + 16 * p + 8 * hi) = w; }
}
struct DilGeo { size_t rowb, kstride; int h12, dil, r, i0; };
__device__ __forceinline__ DilGeo dil_geo(int item) {
    DilGeo g; const int b = item / 1536, rem = item % 1536, ch = rem & 127; g.h12 = rem >> 7;
    const int gg = g.h12 >> 2, ncl = 7 - 2 * gg; g.dil = 1 << (2 * gg); g.r = ch >> ncl; g.i0 = 32 * (ch & ((1 << ncl) - 1));
    g.rowb = (size_t)b * SEQ; g.kstride = (size_t)g.dil * 64; return g;
}
__device__ __forceinline__ void dil_load_qk(const bf16* QKV, const DilGeo& g, bf16x8 (&qf)[4], bf16x8 (&kf)[5][4], int lane) {
    const int q = lane & 31, hi = lane >> 5;
    ld_frag4(qf, QKV + ((size_t)g.h12 * M + g.rowb + (size_t)g.i0 * g.dil + g.r) * 64, (unsigned)g.kstride, lane);
#pragma unroll
    for (int kt = 0; kt < 5; ++kt) { const int ib = g.i0 - 128 + 32 * kt, ibc = ib < 0 ? 0 : ib; ld_frag4(kf[kt], QKV + ((size_t)(12 + g.h12) * M + g.rowb + (size_t)ibc * g.dil + g.r) * 64, (unsigned)g.kstride, lane); }
}
__device__ __forceinline__ void dil_vload(const bf16* QKV, const DilGeo& g, u32x4 (&vr)[4], int kt, int lane) {
    const int ib = g.i0 - 128 + 32 * kt, ibc = ib < 0 ? 0 : ib;
    v_load(vr, QKV + ((size_t)(24 + g.h12) * M + g.rowb + g.r) * 64 + (size_t)ibc * g.kstride, (unsigned)g.kstride, lane);
}
__device__ __forceinline__ void pv_tile_p(f32x16 (&o)[2], LAS unsigned char* vb, const bf16x8 (&pf)[2], int lane) {
    const int hi = lane >> 5, g1 = (lane >> 4) & 1, q4 = (lane & 15) >> 2, pp = lane & 3;
    const int swz = ((q4 >> 1) & 1) << 6;
#pragma unroll
    for (int dblk = 0; dblk < 2; ++dblk)
#pragma unroll
        for (int s = 0; s < 2; ++s) {
            const int colb = (dblk * 64 + g1 * 32 + pp * 8) ^ swz;
            const int row0 = 16 * s + 4 * hi + q4;
            const s16x4 t0 = __builtin_bit_cast(s16x4, __builtin_amdgcn_ds_read_tr16_b64_v4i16((LAS s16x4*)(vb + row0 * 128 + colb)));
            const s16x4 t1 = __builtin_bit_cast(s16x4, __builtin_amdgcn_ds_read_tr16_b64_v4i16((LAS s16x4*)(vb + (row0 + 8) * 128 + colb)));
            const bf16x8 a = (bf16x8){t0[0], t0[1], t0[2], t0[3], t1[0], t1[1], t1[2], t1[3]};
            o[dblk] = __builtin_amdgcn_mfma_f32_32x32x16_bf16(a, pf[s], o[dblk], 0, 0, 0);
        }
}
__device__ __forceinline__ void dil_items(const bf16* QKV, bf16* OD3, float* LSE, LAS unsigned char* vb, int first, int stride, int lane) {
    int it = first; if (it >= 6144) return;
    const int q = lane & 31, hi = lane >> 5;
    DilGeo g = dil_geo(__builtin_amdgcn_readfirstlane(it));
    for (;;) {
        bf16x8 qf[4], kf[5][4];
        dil_load_qk(QKV, g, qf, kf, lane);
        u32x4 vr[5][4];
#pragma unroll
        for (int kt = 0; kt < 5; ++kt) dil_vload(QKV, g, vr[kt], kt, lane);
        bf16x8 pf[5][2]; float mx = -INFINITY, l = 0.f;
        {
            f32x16 s[5];
#pragma unroll
            for (int kt = 0; kt < 5; ++kt) {
                s[kt] = qk_tile(kf[kt], qf);
                if (g.i0 - 128 + 32 * kt < 0) {
#pragma unroll
                    for (int rr = 0; rr < 16; ++rr) s[kt][rr] = -INFINITY;
                }
            }
#pragma unroll
            for (int rr = 0; rr < 16; ++rr) { const int kk = crow(rr, hi); if (kk < q) s[0][rr] = -INFINITY; if (kk > q) s[4][rr] = -INFINITY; }
#pragma unroll
            for (int kt = 0; kt < 5; ++kt)
#pragma unroll
                for (int rr = 0; rr < 16; ++rr) mx = fmaxf(mx, s[kt][rr]);
            { const F2 t = pair32(mx); mx = fmaxf(t.a, t.b); }
            const float mb = mx * LOG2E;
#pragma unroll
            for (int kt = 0; kt < 5; ++kt) {
#pragma unroll
                for (int rr = 0; rr < 16; ++rr) { const float p = __builtin_amdgcn_exp2f(__builtin_fmaf(s[kt][rr], LOG2E, -mb)); s[kt][rr] = p; l += p; }
#pragma unroll
                for (int h2 = 0; h2 < 2; ++h2) { u32x4 w; w.x = pk2(s[kt][8 * h2 + 0], s[kt][8 * h2 + 1]); w.y = pk2(s[kt][8 * h2 + 2], s[kt][8 * h2 + 3]); w.z = pk2(s[kt][8 * h2 + 4], s[kt][8 * h2 + 5]); w.w = pk2(s[kt][8 * h2 + 6], s[kt][8 * h2 + 7]);
                    pf[kt][h2] = __builtin_bit_cast(bf16x8, w); }
            }
            { const F2 t = pair32(l); l = t.a + t.b; }
        }
        const int itn = it + stride; const bool more = itn < 6144;
        const DilGeo gn = dil_geo(__builtin_amdgcn_readfirstlane(more ? itn : it));
        f32x16 o[2]; o[0] = f32x16{}; o[1] = f32x16{};
#pragma unroll
        for (int kt = 0; kt < 5; ++kt) {
            LDS_WAIT();
            v_stage(vb, vr[kt], lane);
            LDS_WAIT();
            pv_tile_p(o, vb, pf[kt], lane);
        }
        const float inv = 1.0f / l;
        const size_t tok = g.rowb + (size_t)(g.i0 + q) * g.dil + g.r;
        store_ot(OD3 + (g.rowb + (size_t)g.i0 * g.dil + g.r) * 768 + g.h12 * 64 + (unsigned)q * (unsigned)(g.dil * 768), o, inv, hi);
        if (hi == 0) LSE[tok * 12 + g.h12] = mx + __logf(l);
        if (!more) break;
        it = itn; g = gn;
    }
}
__device__ __forceinline__ void sb_step(f32x16 (&o)[2], float& R, const bf16x8 (&kf)[4], const bf16x8 (&qf)[4], const u32x4 (&vr)[4], LAS unsigned char* vb, int dq, int lane) {
    const int hi = lane >> 5;
    f32x16 z = qk_tile(kf, qf);
    float gp[4];
#pragma unroll
    for (int c4 = 0; c4 < 4; ++c4) {
        float be[4], ke[4];
#pragma unroll
        for (int i = 0; i < 4; ++i) { const float zz = z[4 * c4 + i]; const float e = __builtin_amdgcn_exp2f(-fabsf(zz) * LOG2E); const float rr = __builtin_amdgcn_rcpf(1.0f + e), sm = e * rr;
            const bool pos = zz >= 0.f; const bool past = (8 * c4 + 4 * hi + i) < dq;
            be[i] = past ? (pos ? rr : sm) : 0.f; ke[i] = past ? (pos ? sm : rr) : 1.f; }
        const float e2 = ke[3], e1 = e2 * ke[2], e0 = e1 * ke[1];
        gp[c4] = e0 * ke[0];
        z[4 * c4 + 3] = be[3]; z[4 * c4 + 2] = be[2] * e2; z[4 * c4 + 1] = be[1] * e1; z[4 * c4 + 0] = be[0] * e0;
    }
    float U = R;
#pragma unroll
    for (int c4 = 3; c4 >= 0; --c4) {
        const F2 t = pair32(gp[c4]);
        const float T = (hi == 0) ? U * t.b : U;
#pragma unroll
        for (int i = 0; i < 4; ++i) z[4 * c4 + i] *= T;
        U *= t.a * t.b;
    }
    R = U;
    LDS_WAIT();
    v_stage(vb, vr, lane);
    LDS_WAIT();
    pv_tile(o, vb, z, lane);
}
__device__ __forceinline__ void sb_item(const bf16* QKV, bf16* OS, LAS unsigned char* vb, int bh, int c, int lane) {
    const int b = bh >> 2, h = bh & 3, q = lane & 31, hi = lane >> 5;
    const size_t rowb = (size_t)b * SEQ;
    const bf16* Qp = QKV + ((size_t)(36 + h) * M + rowb + 32 * c) * 64;
    const bf16* Kb = QKV + ((size_t)(40 + h) * M + rowb) * 64;
    const bf16* Vb = QKV + ((size_t)(44 + h) * M + rowb) * 64;
    bf16x8 qf[4]; ld_frag4(qf, Qp, 64, lane);
    f32x16 o[2]; o[0] = f32x16{}; o[1] = f32x16{};
    float R = 1.0f;
    bf16x8 kf[3][4]; u32x4 vr[3][4];
#pragma unroll
    for (int j = 0; j < 3; ++j) { const int t = (c - j) < 0 ? 0 : (c - j); ld_frag4(kf[j], Kb + (size_t)(32 * t) * 64, 64, lane); v_load(vr[j], Vb + (size_t)(32 * t) * 64, 64, lane); }
#if SB_EARLY_EXIT
#define SB_DONE() (__all(R < 1e-20f))
#else
#define SB_DONE() (false)
#endif
#define SB_STEP(j, kt_) do { sb_step(o, R, kf[j], qf, vr[j], vb, 32 * (c - (kt_)) + q, lane); \
        { const int t = (kt_) - 3 < 0 ? 0 : (kt_) - 3; ld_frag4(kf[j], Kb + (size_t)(32 * t) * 64, 64, lane); v_load(vr[j], Vb + (size_t)(32 * t) * 64, 64, lane); } } while (0)
    for (int kt = c; kt >= 0; kt -= 3) {
        SB_STEP(0, kt); if (kt - 1 < 0 || SB_DONE()) break;
        SB_STEP(1, kt - 1); if (kt - 2 < 0 || SB_DONE()) break;
        SB_STEP(2, kt - 2); if (SB_DONE()) break;
    }
#undef SB_STEP
#undef SB_DONE
    store_ot(OS + (rowb + 32 * c) * 256 + h * 64 + (unsigned)q * 256u, o, 1.0f, hi);
}
__device__ __forceinline__ void attn_phase(unsigned char* Pws, unsigned char* Pscr, LAS unsigned char* lds, int G, int wg, int NGW, int wave, int lane) {
    LAS unsigned char* vb = lds + wave * 4096;
    const bf16* QKV = (const bf16*)(Pws + WS_R);
    const int v = (G % 8 == 0) ? (wg % 8) * (G / 8) + wg / 8 : wg;
    const int base = v * NWAVES + wave;
    for (int it = base; it < 2048; it += NGW) { const int itu = __builtin_amdgcn_readfirstlane(it);
#if SB_EARLY_EXIT
        sb_item(QKV, (bf16*)(Pws + WS_OS), vb, itu >> 7, itu & 127, lane);
#else
        sb_item(QKV, (bf16*)(Pws + WS_OS), vb, itu >> 7, ((itu & 127) + 16 * (itu >> 8)) & 127, lane);
#endif
    }
    dil_items(QKV, (bf16*)(Pscr + OUT_OD3), (float*)(Pws + WS_LSE), vb, base, NGW, lane);
}
__device__ __forceinline__ void merge_phase(unsigned char* Pws, unsigned char* Pscr, int idx_lo, int idx_hi, int first, int stride) {
    const bf16* OD3 = (const bf16*)(Pscr + OUT_OD3); bf16* OD = (bf16*)(Pscr + OUT_OD); const float* LSE = (const float*)(Pws + WS_LSE);
    const __amdgpu_buffer_rsrc_t odr = __builtin_amdgcn_make_buffer_rsrc(OD, 0, M * 256 * 2, 0x00020000);
    for (int idx = idx_lo + first; idx < idx_hi; idx += stride) {
        const int t = idx >> 5, hh = (idx >> 3) & 3, ch = idx & 7;
        const float l0 = LSE[(size_t)t * 12 + hh], l1 = LSE[(size_t)t * 12 + 4 + hh], l2 = LSE[(size_t)t * 12 + 8 + hh];
        const float mx = fmaxf(l0, fmaxf(l1, l2)); float e0 = __expf(l0 - mx), e1 = __expf(l1 - mx), e2 = __expf(l2 - mx); const float inv = 1.0f / (e0 + e1 + e2);
        e0 *= inv; e1 *= inv; e2 *= inv;
        const u32x4 a = *(const u32x4*)(OD3 + (size_t)t * 768 + hh * 64 + ch * 8), bq = *(const u32x4*)(OD3 + (size_t)t * 768 + (4 + hh) * 64 + ch * 8), cq = *(const u32x4*)(OD3 + (size_t)t * 768 + (8 + hh) * 64 + ch * 8);
        u32x4 o;
#pragma unroll
        for (int k = 0; k < 4; ++k) {
            const float lo = e0 * __uint_as_float(a[k] << 16) + e1 * __uint_as_float(bq[k] << 16) + e2 * __uint_as_float(cq[k] << 16);
            const float hi = e0 * __uint_as_float(a[k] & 0xffff0000u) + e1 * __uint_as_float(bq[k] & 0xffff0000u) + e2 * __uint_as_float(cq[k] & 0xffff0000u);
            o[k] = pk2(lo, hi);
        }
        __builtin_amdgcn_raw_buffer_store_b128(o, odr, (unsigned)(t * 256 + hh * 64 + ch * 8) * 2u, 0,   16);
    }
}
__device__ __forceinline__ void merge_quarter(unsigned char* Pws, unsigned char* Pscr, int idx_lo, int tid) {
    const bf16* OD3 = (const bf16*)(Pscr + OUT_OD3); bf16* OD = (bf16*)(Pscr + OUT_OD); const float* LSE = (const float*)(Pws + WS_LSE);
    const __amdgpu_buffer_rsrc_t odr = __builtin_amdgcn_make_buffer_rsrc(OD, 0, M * 256 * 2, 0x00020000);
    float ls[4][3]; u32x4 v[4][3];
#pragma unroll
    for (int j = 0; j < 4; ++j) { const unsigned idx = (unsigned)(idx_lo + tid + 512 * j), t = idx >> 5, hh = (idx >> 3) & 3, ch = idx & 7;
#pragma unroll
        for (int g = 0; g < 3; ++g) { ls[j][g] = LSE[t * 12u + 4u * g + hh]; v[j][g] = *(const u32x4*)(OD3 + (t * 768u + (4u * g + hh) * 64u + ch * 8u)); } }
#pragma unroll
    for (int j = 0; j < 4; ++j) { const unsigned idx = (unsigned)(idx_lo + tid + 512 * j), t = idx >> 5, hh = (idx >> 3) & 3, ch = idx & 7;
        const float mx = fmaxf(ls[j][0], fmaxf(ls[j][1], ls[j][2])); float e0 = __expf(ls[j][0] - mx), e1 = __expf(ls[j][1] - mx), e2 = __expf(ls[j][2] - mx); const float inv = 1.0f / (e0 + e1 + e2);
        e0 *= inv; e1 *= inv; e2 *= inv;
        u32x4 o;
#pragma unroll
        for (int k = 0; k < 4; ++k) {
            const float lo = e0 * __uint_as_float(v[j][0][k] << 16) + e1 * __uint_as_float(v[j][1][k] << 16) + e2 * __uint_as_float(v[j][2][k] << 16);
            const float hi = e0 * __uint_as_float(v[j][0][k] & 0xffff0000u) + e1 * __uint_as_float(v[j][1][k] & 0xffff0000u) + e2 * __uint_as_float(v[j][2][k] & 0xffff0000u);
            o[k] = pk2(lo, hi);
        }
        __builtin_amdgcn_raw_buffer_store_b128(o, odr, (t * 256u + hh * 64u + ch * 8u) * 2u, 0,   16); }
}
__device__ __forceinline__ void panel_sync(unsigned* cnt, int pm, int wave, int lane) {
    asm volatile("s_waitcnt vmcnt(0)" ::: "memory");
    __syncthreads();
    if (wave == 0) {
        if (lane == 0) __hip_atomic_fetch_add(cnt + 64 * pm, 1u, __ATOMIC_RELAXED, __HIP_MEMORY_SCOPE_AGENT);
        unsigned spins = 0;
        while ((unsigned)__builtin_amdgcn_readfirstlane(__hip_atomic_load(cnt + 64 * pm, __ATOMIC_RELAXED, __HIP_MEMORY_SCOPE_AGENT)) < 4u) { __builtin_amdgcn_s_sleep(1); if (++spins > (1u << 20)) break; }
        __builtin_amdgcn_fence(__ATOMIC_ACQUIRE, "agent"); }
    asm volatile("s_waitcnt vmcnt(0) lgkmcnt(0)" ::: "memory"); __syncthreads();
}
__device__ __forceinline__ void final_phase(unsigned char* Pws, float* Pout, const float* Pnf, int gw, int NGW, int lane) {
    const float* ssqp = (const float*)(Pws + WS_SSQ); const f32x4* gf = (const f32x4*)Pnf + 2 * lane; const bf16* xb = (const bf16*)(Pws + WS_XB);
    for (int m = gw; m < M; m += NGW) {
        const float rs = pg8::row_rstd(ssqp, m);
        const u32x4* xr = (const u32x4*)(xb + (size_t)m * D) + lane; f32x4* orow = (f32x4*)(Pout + (size_t)m * D) + 2 * lane;
#pragma unroll
        for (int j = 0; j < 2; ++j) { const u32x4 w = xr[64 * j];
            const f32x4 v0 = {__uint_as_float(w.x << 16), __uint_as_float(w.x & 0xffff0000u), __uint_as_float(w.y << 16), __uint_as_float(w.y & 0xffff0000u)};
            const f32x4 v1 = {__uint_as_float(w.z << 16), __uint_as_float(w.z & 0xffff0000u), __uint_as_float(w.w << 16), __uint_as_float(w.w & 0xffff0000u)};
            orow[128 * j] = v0 * rs * gf[128 * j]; orow[128 * j + 1] = v1 * rs * gf[128 * j + 1]; }
    }
}

struct Args { const float* in[15]; float* out; unsigned char* ws; int ph_lo, ph_hi; };
constexpr int N_PHASES = 10 * DEPTH + 1;
__global__ void __launch_bounds__(NWAVES * 64, 2) fwd_megakernel(Args args) {
    extern __shared__ __attribute__((aligned(16))) unsigned char lds_raw[];
    LAS unsigned char* lds = (LAS unsigned char*)lds_raw;
    cg::grid_group grid = cg::this_grid();
    volatile LAS unsigned* bst = (volatile LAS unsigned*)(lds + 131072);
    if (threadIdx.x < 2) bst[threadIdx.x] = 0u;
    __syncthreads();
    (void)xcd_barrier_post((unsigned*)(args.ws + WS_BAR), bst);
    for (int ph = args.ph_lo; ph < args.ph_hi; ++ph) {
        const __attribute__((address_space(4))) unsigned char* ka = (const __attribute__((address_space(4))) unsigned char*)__builtin_amdgcn_kernarg_segment_ptr();
        asm volatile("" : "+s"(ka));
#define KARG(i) (*(const float* const __attribute__((address_space(4)))*)(ka + 8 * (i)))
        const float* Px = KARG(0); float* Pout = (float*)KARG(15); unsigned char* ws = (unsigned char*)KARG(16);
        int tid = threadIdx.x, G = gridDim.x, wg = blockIdx.x; asm volatile("" : "+v"(tid), "+s"(G), "+s"(wg));
        const int lane = tid & 63, wave = __builtin_amdgcn_readfirstlane(tid >> 6);
        const int gw = wave * G + wg, NGW = G * NWAVES;
        const int gtid = wg * (NWAVES * 64) + tid, NT = G * NWAVES * 64;
        unsigned char* wsw = ws + WS_W;
        float* ssqp = (float*)(ws + WS_SSQ);
        bf16* XB = (bf16*)(ws + WS_XB); bf16* H = (bf16*)(ws + WS_R); bf16* QKV = (bf16*)(ws + WS_R); bf16* GATE = (bf16*)(ws + WS_GATE);
        const int l = ph / 10, k = (ph == N_PHASES - 1) ? 10 : ph % 10;
        const bool fuse_final = (G == 256);
        if (k == 10 && fuse_final) continue;
        const bool chain = (G == 256);
        if ((k == 6 || k == 7) && chain) continue;
        if (k == 0 && l > 0) continue;
        unsigned char* dA1 = (unsigned char*)Pout + 32 * MiB;
        unsigned char* wA = (l == 0) ? wsw : dA1;
        if (k == 0) {
            { const ConvSrc CS{KARG(1), KARG(2), KARG(3), KARG(4), KARG(5), KARG(6), KARG(7), KARG(8), KARG(9), KARG(10), KARG(11), KARG(12), KARG(13)}; conv_phase(Px, CS, ws, l, lds, gw, NGW, wave, lane); }
        }
        else if (k == 1 || k == 8) {
            pg8::Gemm g{XB, (const bf16*)(k == 1 ? wA + W_1CAT : wsw + W_2CAT), M, 2 * FF, D}; pg8::StaticOrder S; S.init(M, 2 * FF, G, wg);
            fill_rstd_table(S, ssqp, lds, tid);
            pg8::EpiSwiglu E{H, ssqp, (const LAS float*)(lds + RSL_OFF)};
            pg8::gemm_phase<pg8::EpiSwiglu, pg8::StaticOrder, true, true>(lds, g, S, E);
            if ((l == 0) || (k == 1)) {
                const int rem = ((M / 256) * (2 * FF / 256)) % G; const bool idle = (rem == 0) || (wg >= rem);
                if (idle) {
                    const int nidle = (rem == 0) ? G : G - rem, iw = (rem == 0) ? wg : wg - rem;
                    const ConvSrc CS{KARG(1), KARG(2), KARG(3), KARG(4), KARG(5), KARG(6), KARG(7), KARG(8), KARG(9), KARG(10), KARG(11), KARG(12), KARG(13)};
                    const int lo = (l == 0) ? (k == 1 ? 0 : CI_IN) : CI_B, hi = (l == 0) ? (k == 1 ? CI_IN : CI_B) : CI_END;
                    conv_items(CS, 1, lo, hi, dA1, wsw, lds, wave * nidle + iw, nidle * NWAVES, wave, lane);
                }
            }
        } else if (k == 2 || k == 9) {
            pg8::Gemm g{H, (const bf16*)(k == 2 ? wA + W_D1 : wsw + W_D2), M, D, FF}; pg8::StaticOrder S; S.init(M, D, G, wg);
            if (ph == 2) { pg8::EpiResid<true> E{Px, XB, ssqp, 0.5f}; pg8::gemm_phase<pg8::EpiResid<true>, pg8::StaticOrder, true, true>(lds, g, S, E); }
            else if (ph == N_PHASES - 2 && fuse_final) { pg8::EpiResidFinal E{XB, Pout, KARG(14), (unsigned*)(ws + WS_XSLOT), (unsigned*)(ws + WS_CNT), 0.5f};
                pg8::gemm_phase<pg8::EpiResidFinal, pg8::StaticOrder, true, true>(lds, g, S, E); }
            else { pg8::EpiResid<false> E{nullptr, XB, ssqp, 0.5f}; pg8::gemm_phase<pg8::EpiResid<false>, pg8::StaticOrder, true, true>(lds, g, S, E); }
        } else if (k == 3) {
            pg8::Gemm g{XB, (const bf16*)(wA + W_IN), M, NIN, D}; pg8::StaticOrder S; S.init(M, NIN, G, wg);
            fill_rstd_table(S, ssqp, lds, tid);
            pg8::EpiWin E{QKV, GATE, ssqp, (const float*)(ws + WS_ROPE), (const LAS float*)(lds + RSL_OFF)};
            pg8::gemm_phase<pg8::EpiWin, pg8::StaticOrder, true, true>(lds, g, S, E);
        } else if (k == 4) {
            attn_phase(ws, (unsigned char*)Pout, lds, G, wg, NGW, wave, lane);
        }
        else if (k == 5) {
            pg8::Unit pu; { pg8::StaticOrder S; S.init(M, D, G, wg); S.next(0, pu); }
            unsigned* pcnt = (unsigned*)(ws + WS_PCNT) + (size_t)l * 2 * 4096;
            if (chain) { const int r0 = pu.pm * 256 + pu.pn * 64; merge_quarter(ws, (unsigned char*)Pout, r0 * 32, tid); panel_sync(pcnt, pu.pm, wave, lane); }
            else merge_phase(ws, (unsigned char*)Pout, 0, M * 32, gtid, NT);
            if (chain) {
                int K256 = 256; asm volatile("" : "+s"(K256));
                { pg8::Gemm g{(const bf16*)((unsigned char*)Pout + OUT_OD), (const bf16*)(wsw + W_PD), M, D, K256, (const bf16*)(ws + WS_OS), (const bf16*)(wsw + W_PS)}; pg8::PairOrder S; S.init(M, D, G, wg);
                  pg8::EpiGate2 E{GATE, (bf16*)(ws + WS_Y1), (bf16*)(ws + WS_Y)};
                  pg8::gemm_phase<pg8::EpiGate2, pg8::PairOrder, true, true>(lds, g, S, E); }
                panel_sync(pcnt + 4096, pu.pm, wave, lane);
                { pg8::Gemm g{(const bf16*)(ws + WS_Y), (const bf16*)(wsw + W_OUT), M, D, D}; pg8::StaticOrder S; S.init(M, D, G, wg);
                  pg8::EpiResid<false> E{nullptr, XB, ssqp, 1.0f};
                  pg8::gemm_phase<pg8::EpiResid<false>, pg8::StaticOrder, true, true>(lds, g, S, E); }
            }
        }
        else if (k == 6) {
            int K256 = 256; asm volatile("" : "+s"(K256));
            { pg8::Gemm g{(const bf16*)((unsigned char*)Pout + OUT_OD), (const bf16*)(wsw + W_PD), M, D, K256}; pg8::StaticOrder S; S.init(M, D, G, wg);
              pg8::EpiGate<false> E{GATE, (bf16*)(ws + WS_Y1), (bf16*)(ws + WS_Y)};
              pg8::gemm_phase<pg8::EpiGate<false>, pg8::StaticOrder, true, true>(lds, g, S, E); }
            { pg8::Gemm g{(const bf16*)(ws + WS_OS), (const bf16*)(wsw + W_PS), M, D, K256}; pg8::StaticOrder S; S.init(M, D, G, wg);
              pg8::EpiGate<true> E{GATE + 1024, (bf16*)(ws + WS_Y1), (bf16*)(ws + WS_Y)};
              pg8::gemm_phase<pg8::EpiGate<true>, pg8::StaticOrder, true, true>(lds, g, S, E); }
        } else if (k == 7) {
            pg8::Gemm g{(const bf16*)(ws + WS_Y), (const bf16*)(wsw + W_OUT), M, D, D}; pg8::StaticOrder S; S.init(M, D, G, wg);
            pg8::EpiResid<false> E{nullptr, XB, ssqp, 1.0f};
            pg8::gemm_phase<pg8::EpiResid<false>, pg8::StaticOrder, true, true>(lds, g, S, E);
        } else final_phase(ws, Pout, KARG(14), gw, NGW, lane);
        if (ph + 1 < args.ph_hi && !(fuse_final && ph == N_PHASES - 2)) {
            unsigned* barw = (unsigned*)(ws + WS_BAR);
            if (args.ph_hi > 1000) grid.sync();
            { XcdBarrier bar; bar.bar = barw; bar.x = xb_xcc_id(); bar.st = bst; xcd_barrier(bar);
            }
        }
    }
}

extern "C" void kernel_launch(void* const* d_in, const int* in_sizes, int n_in, void* d_out, int out_size, void* d_ws, size_t ws_size, hipStream_t stream) {
    static int grid = 0;
    if (grid == 0) {
        if (n_in != 15 || in_sizes[0] != M * D || out_size != M * D || ws_size < WS_END) { fprintf(stderr, "kernel_launch: unexpected shapes (n_in %d, in0 %d, out %d, ws %zu)\n", n_in, n_in > 0 ? in_sizes[0] : -1, out_size, ws_size); grid = -1; return; }
        int dev = 0, cus = 0, per_cu = 0;
        if (hipGetDevice(&dev) != hipSuccess || hipDeviceGetAttribute(&cus, hipDeviceAttributeMultiprocessorCount, dev) != hipSuccess) { grid = -1; return; }
        if (hipFuncSetAttribute((const void*)fwd_megakernel, hipFuncAttributeMaxDynamicSharedMemorySize, LDS_BYTES) != hipSuccess) { fprintf(stderr, "kernel_launch: hipFuncSetAttribute failed\n"); grid = -1; return; }
        if (hipOccupancyMaxActiveBlocksPerMultiprocessor(&per_cu, (const void*)fwd_megakernel, NWAVES * 64, LDS_BYTES) != hipSuccess || per_cu < 1) { fprintf(stderr, "kernel_launch: occupancy query says %d\n", per_cu); per_cu = 1; }
        (void)hipGetLastError();
        grid = cus;
        if (grid < 176) { fprintf(stderr, "kernel_launch: %d CUs: the per-workgroup rstd table holds 8 units per GEMM phase (needs >= 176 workgroups)\n", grid); grid = -1; return; }
    }
    if (grid < 0) return;
    Args a{};
    for (int i = 0; i < 15; ++i) a.in[i] = (const float*)d_in[i];
    a.out = (float*)d_out; a.ws = (unsigned char*)d_ws;
#if N_LAUNCH_MODE == 0
    a.ph_lo = 0; a.ph_hi = N_PHASES;
    if (hipMemsetAsync((char*)d_ws + WS_BAR, 0, WS_ZERO_BYTES, stream) != hipSuccess) { fprintf(stderr, "kernel_launch: memset of the barrier words failed\n"); return; }
    void* kargs[] = {&a};
    const hipError_t e = hipLaunchCooperativeKernel((const void*)fwd_megakernel, dim3(grid), dim3(NWAVES * 64), kargs, LDS_BYTES, stream);
    if (e != hipSuccess) fprintf(stderr, "kernel_launch: cooperative launch failed: %s (grid %d)\n", hipGetErrorString(e), grid);
#else
    for (int ph = 0; ph < N_PHASES; ++ph) {
        a.ph_lo = ph; a.ph_hi = ph + 1;
        hipLaunchKernelGGL(fwd_megakernel, dim3(grid), dim3(NWAVES * 64), LDS_BYTES, stream, a);
    }
#endif
}
```

```cpp
#include <hip/hip_runtime.h>
#include <hip/hip_cooperative_groups.h>
#include <cstdio>
#include <cstdint>
namespace cg = cooperative_groups;
namespace pg8 {
#define PG8_LAS __attribute__((address_space(3)))
typedef unsigned short bf16_t;
typedef short bf16x8 __attribute__((ext_vector_type(8)));
typedef float f32x4 __attribute__((ext_vector_type(4)));
typedef unsigned u32x4 __attribute__((ext_vector_type(4)));
constexpr int BM = 256, BK = 64, HALF = 128, HTB = HALF * BK * 2  , STAGE_BYTES = 8 * HTB, NXCD = 8, WGM = 8;

__host__ __device__ __forceinline__ int lds_byte(int r, int c) { const int st = (r >> 4) * 2 + (c >> 5), rr = r & 15, cc = c & 31, ob = rr * 64 + cc * 2; return st * 1024 + (ob ^ (((ob >> 9) & 1) << 5)); }
__host__ __device__ __forceinline__ void stage_rc(int b, int& R, int& C) { const int st = b / 1024, sb = b % 1024, swz = sb ^ (((sb >> 9) & 1) << 5); R = (st >> 1) * 16 + swz / 64; C = (st & 1) * 32 + (swz % 64) / 2; }
__host__ __device__ __forceinline__ int perm32(int rho) { const int n = rho >> 4, i = rho & 15; return 8 * (i >> 2) + 4 * n + (i & 3); }

struct Unit { int pm, pn, ui, sel; };
struct Gemm { const bf16_t* A; const bf16_t* Bt; int M, N, K; const bf16_t* A2 = nullptr; const bf16_t* Bt2 = nullptr; };

struct StaticOrder {
    int nM, nN, nwg, G, c;
    __host__ __device__ void init(int M, int N, int G_, int c_) { nM = M / BM; nN = N / BM; nwg = nM * nN; G = G_; c = c_; }
    __host__ __device__ bool next(int i, Unit& u) const {
        const long L = (long)i * G + c; if (L >= nwg) return false;
        int wgid = (int)L; { const int q = nwg / NXCD, r = nwg % NXCD, xcd = wgid % NXCD, off = wgid / NXCD; wgid = (xcd < r ? xcd * (q + 1) : r * (q + 1) + (xcd - r) * q) + off; }
        const int nig = WGM * nN, gid = wgid / nig, fm = gid * WGM, gsz = (nM - fm) < WGM ? (nM - fm) : WGM;
        u.pm = fm + ((wgid % nig) % gsz); u.pn = (wgid % nig) / gsz; u.ui = i; u.sel = 0; return true;
    }
    __device__ __forceinline__ void a_ready(const Unit&) const {}
    __device__ __forceinline__ void done(const Unit&) const {}
};
struct PairOrder : StaticOrder {
    unsigned* cnt;
    __host__ __device__ bool next(int i, Unit& u) const { if (i >= 2) return false; if (!StaticOrder::next(0, u)) return false; u.ui = i; u.sel = i; return true; }
    __device__ __forceinline__ void a_ready(const Unit& u) const {
        if (u.sel == 1 && cnt != nullptr) {
            if (threadIdx.x < 64) { unsigned spins = 0;
                while ((unsigned)__builtin_amdgcn_readfirstlane(__hip_atomic_load(cnt + 64 * u.pm, __ATOMIC_RELAXED, __HIP_MEMORY_SCOPE_AGENT)) < 4u) { __builtin_amdgcn_s_sleep(1); if (++spins > (1u << 20)) break; }
                __builtin_amdgcn_fence(__ATOMIC_ACQUIRE, "agent");
                asm volatile("s_waitcnt vmcnt(0)" ::: "memory"); }
            asm volatile("" ::: "memory"); __builtin_amdgcn_s_barrier(); asm volatile("" ::: "memory");
        }
    }
};

typedef float f32x2_cv __attribute__((ext_vector_type(2))); typedef __bf16 bf16x2_cv __attribute__((ext_vector_type(2)));
__device__ __forceinline__ unsigned cvt_pk_bf16(float lo, float hi) { const f32x2_cv v = {lo, hi}; const bf16x2_cv b = __builtin_convertvector(v, bf16x2_cv); return __builtin_bit_cast(unsigned, b); }
typedef unsigned u32x2 __attribute__((ext_vector_type(2)));
constexpr float LOG2E = 1.4426950408889634f;
constexpr int RSL_UNITS = 8;
__device__ __forceinline__ float row_rstd(const float* ssqp, int r) {
    const f32x4* p = (const f32x4*)(ssqp + (size_t)r * 16);
    const f32x4 a = p[0], b = p[1], c = p[2], d = p[3];
    const float s = (((a[0] + a[1]) + (a[2] + a[3])) + ((b[0] + b[1]) + (b[2] + b[3]))) + (((c[0] + c[1]) + (c[2] + c[3])) + ((d[0] + d[1]) + (d[2] + d[3])));
    return __builtin_amdgcn_rsqf(s * (1.0f / 1024.0f) + 1e-6f);
}
__device__ __forceinline__ float bf2f(unsigned short b) { return __uint_as_float(((unsigned)b) << 16); }
struct EpiSwiglu {
    static constexpr bool PERM = true, AFTER_DRAIN = false, HAS_INIT = false;
    bf16_t* H; const float* ssqp; const PG8_LAS float* rsl;
    __device__ __forceinline__ void operator()(const f32x4 (&acc)[2][2][4][2], const Unit& u, int wr, int wc, int fr, int fq) const {
        const int row0 = u.pm * BM + wr * 64 + fr, col0 = u.pn * 128 + wc * 32 + 8 * fq;
#pragma unroll
        for (int ai = 0; ai < 2; ++ai)
#pragma unroll
            for (int m = 0; m < 4; ++m) {
                const int r = row0 + ai * HALF + m * 16; const float rs = rsl[u.ui * 256 + ai * HALF + wr * 64 + m * 16 + fr];
                const float nrl = -rs * LOG2E, rs2 = rs * rs; f32x4 hq[2];
#pragma unroll
                for (int n = 0; n < 2; ++n) { const f32x4 ga = acc[ai][0][m][n], ua = acc[ai][1][m][n]; const f32x4 x = ga * nrl; f32x4 e;
                    e[0] = __builtin_amdgcn_exp2f(x[0]); e[1] = __builtin_amdgcn_exp2f(x[1]); e[2] = __builtin_amdgcn_exp2f(x[2]); e[3] = __builtin_amdgcn_exp2f(x[3]);
                    const f32x4 d = e + 1.0f; f32x4 rc; rc[0] = __builtin_amdgcn_rcpf(d[0]); rc[1] = __builtin_amdgcn_rcpf(d[1]); rc[2] = __builtin_amdgcn_rcpf(d[2]); rc[3] = __builtin_amdgcn_rcpf(d[3]);
                    hq[n] = (ga * ua) * (rc * rs2); }
                u32x4 w; w.x = cvt_pk_bf16(hq[0][0], hq[0][1]); w.y = cvt_pk_bf16(hq[0][2], hq[0][3]); w.z = cvt_pk_bf16(hq[1][0], hq[1][1]); w.w = cvt_pk_bf16(hq[1][2], hq[1][3]);
                *(u32x4*)(H + ((unsigned)r * 2816u + (unsigned)col0)) = w;
            }
    }
};
template <bool BASE32> struct EpiResid {
    static constexpr bool PERM = true, AFTER_DRAIN = false, HAS_INIT = true;
    const float* base32; bf16_t* xb; float* ssqp; float alpha;
    __device__ __forceinline__ void init(f32x4 (&acc)[2][2][4][2], const Unit& u, int wr, int wc, int fr, int fq) const {
        const unsigned row0 = u.pm * BM + wr * 64 + fr, col0 = u.pn * BM + wc * 32 + 8 * fq; const float ia = 1.0f / alpha;
#pragma unroll
        for (int ai = 0; ai < 2; ++ai)
#pragma unroll
            for (int m = 0; m < 4; ++m)
#pragma unroll
                for (int bj = 0; bj < 2; ++bj) { const unsigned off = (row0 + ai * HALF + m * 16) * 1024u + col0 + bj * HALF;
                    f32x4 b0, b1;
                    if (BASE32) { b0 = *(const f32x4*)(base32 + off); b1 = *(const f32x4*)(base32 + off + 4); }
                    else { const u32x4 bw = *(const u32x4*)(xb + off);
                        b0[0] = __uint_as_float(bw.x << 16); b0[1] = __uint_as_float(bw.x & 0xffff0000u); b0[2] = __uint_as_float(bw.y << 16); b0[3] = __uint_as_float(bw.y & 0xffff0000u);
                        b1[0] = __uint_as_float(bw.z << 16); b1[1] = __uint_as_float(bw.z & 0xffff0000u); b1[2] = __uint_as_float(bw.w << 16); b1[3] = __uint_as_float(bw.w & 0xffff0000u); }
                    acc[ai][bj][m][0] = b0 * ia; acc[ai][bj][m][1] = b1 * ia; }
    }
    __device__ __forceinline__ void operator()(const f32x4 (&acc)[2][2][4][2], const Unit& u, int wr, int wc, int fr, int fq) const {
        const unsigned row0 = u.pm * BM + wr * 64 + fr, col0 = u.pn * BM + wc * 32 + 8 * fq;
#pragma unroll
        for (int ai = 0; ai < 2; ++ai)
#pragma unroll
            for (int m = 0; m < 4; ++m) {
                const unsigned r = row0 + ai * HALF + m * 16; float s = 0.f;
#pragma unroll
                for (int bj = 0; bj < 2; ++bj) { const unsigned off = r * 1024u + col0 + bj * HALF;
                    const f32x4 o0 = acc[ai][bj][m][0] * alpha, o1 = acc[ai][bj][m][1] * alpha;
                    u32x4 w; w.x = cvt_pk_bf16(o0[0], o0[1]); w.y = cvt_pk_bf16(o0[2], o0[3]); w.z = cvt_pk_bf16(o1[0], o1[1]); w.w = cvt_pk_bf16(o1[2], o1[3]);
                    *(u32x4*)(xb + off) = w;
                    f32x4 q0, q1;
                    q0[0] = __uint_as_float(w.x << 16); q0[1] = __uint_as_float(w.x & 0xffff0000u); q0[2] = __uint_as_float(w.y << 16); q0[3] = __uint_as_float(w.y & 0xffff0000u);
                    q1[0] = __uint_as_float(w.z << 16); q1[1] = __uint_as_float(w.z & 0xffff0000u); q1[2] = __uint_as_float(w.w << 16); q1[3] = __uint_as_float(w.w & 0xffff0000u);
                    const f32x4 sq = q0 * q0 + q1 * q1; s += (sq[0] + sq[1]) + (sq[2] + sq[3]); }
                { const auto t16 = __builtin_amdgcn_permlane16_swap(__float_as_uint(s), __float_as_uint(s), false, false); s = __uint_as_float(t16[0]) + __uint_as_float(t16[1]);
                  const auto t32 = __builtin_amdgcn_permlane32_swap(__float_as_uint(s), __float_as_uint(s), false, false); s = __uint_as_float(t32[0]) + __uint_as_float(t32[1]); }
                if (fq == 0) ssqp[r * 16u + u.pn * 4 + wc] = s;
            }
    }
};
struct EpiResidFinal {
    static constexpr bool PERM = true, AFTER_DRAIN = true, HAS_INIT = true;
    const bf16_t* xb; float* out; const float* gain; unsigned* xslot; unsigned* cnt; float alpha;
    __device__ __forceinline__ void init(f32x4 (&acc)[2][2][4][2], const Unit& u, int wr, int wc, int fr, int fq) const {
        const unsigned row0 = u.pm * BM + wr * 64 + fr, col0 = u.pn * BM + wc * 32 + 8 * fq; const float ia = 1.0f / alpha;
#pragma unroll
        for (int ai = 0; ai < 2; ++ai)
#pragma unroll
            for (int m = 0; m < 4; ++m)
#pragma unroll
                for (int bj = 0; bj < 2; ++bj) { const unsigned off = (row0 + ai * HALF + m * 16) * 1024u + col0 + bj * HALF; const u32x4 bw = *(const u32x4*)(xb + off); f32x4 b0, b1;
                    b0[0] = __uint_as_float(bw.x << 16); b0[1] = __uint_as_float(bw.x & 0xffff0000u); b0[2] = __uint_as_float(bw.y << 16); b0[3] = __uint_as_float(bw.y & 0xffff0000u);
                    b1[0] = __uint_as_float(bw.z << 16); b1[1] = __uint_as_float(bw.z & 0xffff0000u); b1[2] = __uint_as_float(bw.w << 16); b1[3] = __uint_as_float(bw.w & 0xffff0000u);
                    acc[ai][bj][m][0] = b0 * ia; acc[ai][bj][m][1] = b1 * ia; }
    }
    __device__ __forceinline__ void fused(f32x4 (&acc)[2][2][4][2], const Unit& u, int wr, int wc, int fr, int fq, PG8_LAS unsigned char* lds, int wid, int lane) const {
        PG8_LAS float* P = (PG8_LAS float*)lds;
        PG8_LAS float* S = (PG8_LAS float*)(lds + 4096);
        const int tid = wid * 64 + lane;
#pragma unroll
        for (int ai = 0; ai < 2; ++ai)
#pragma unroll
            for (int m = 0; m < 4; ++m) { float s = 0.f;
#pragma unroll
                for (int bj = 0; bj < 2; ++bj)
#pragma unroll
                    for (int n = 0; n < 2; ++n) { const f32x4 o = acc[ai][bj][m][n] * alpha; acc[ai][bj][m][n] = o; const f32x4 q = o * o; s += (q[0] + q[1]) + (q[2] + q[3]); }
                { const auto t16 = __builtin_amdgcn_permlane16_swap(__float_as_uint(s), __float_as_uint(s), false, false); s = __uint_as_float(t16[0]) + __uint_as_float(t16[1]);
                  const auto t32 = __builtin_amdgcn_permlane32_swap(__float_as_uint(s), __float_as_uint(s), false, false); s = __uint_as_float(t32[0]) + __uint_as_float(t32[1]); }
                if (fq == 0) P[(ai * HALF + wr * 64 + m * 16 + fr) * 4 + wc] = s; }
        asm volatile("s_waitcnt lgkmcnt(0)" ::: "memory"); __builtin_amdgcn_s_barrier(); asm volatile("" ::: "memory");
        if (tid < 256) { const float t = (P[tid * 4 + 0] + P[tid * 4 + 1]) + (P[tid * 4 + 2] + P[tid * 4 + 3]);
            __hip_atomic_store(xslot + ((size_t)(u.pm * BM + tid) * 4 + u.pn), __float_as_uint(t), __ATOMIC_RELAXED, __HIP_MEMORY_SCOPE_AGENT); }
        asm volatile("s_waitcnt vmcnt(0)" ::: "memory");
        if (lane == 0) __hip_atomic_fetch_add(cnt + 64 * u.pm, 1u, __ATOMIC_RELAXED, __HIP_MEMORY_SCOPE_AGENT);
        if (wid == 0) { unsigned spins = 0;
            while ((unsigned)__builtin_amdgcn_readfirstlane(__hip_atomic_load(cnt + 64 * u.pm, __ATOMIC_RELAXED, __HIP_MEMORY_SCOPE_AGENT)) < 32u) { __builtin_amdgcn_s_sleep(2); if (++spins > (1u << 20)) break; }
            __builtin_amdgcn_fence(__ATOMIC_ACQUIRE, "agent"); }
        asm volatile("s_waitcnt vmcnt(0) lgkmcnt(0)" ::: "memory"); __builtin_amdgcn_s_barrier(); asm volatile("" ::: "memory");
        if (tid < 256) { const unsigned* sl = xslot + (size_t)(u.pm * BM + tid) * 4; float t = 0.f;
#pragma unroll
            for (int k = 0; k < 4; ++k) t += __uint_as_float(__hip_atomic_load(sl + k, __ATOMIC_RELAXED, __HIP_MEMORY_SCOPE_AGENT));
            S[tid] = __builtin_amdgcn_rsqf(t * (1.0f / 1024.0f) + 1e-6f); }
        asm volatile("s_waitcnt vmcnt(0) lgkmcnt(0)" ::: "memory"); __builtin_amdgcn_s_barrier(); asm volatile("" ::: "memory");
        const unsigned row0 = u.pm * BM + wr * 64 + fr, col0 = u.pn * BM + wc * 32 + 8 * fq;
        f32x4 gv[2][2];
#pragma unroll
        for (int bj = 0; bj < 2; ++bj) { gv[bj][0] = *(const f32x4*)(gain + col0 + bj * HALF); gv[bj][1] = *(const f32x4*)(gain + col0 + bj * HALF + 4); }
#pragma unroll
        for (int ai = 0; ai < 2; ++ai)
#pragma unroll
            for (int m = 0; m < 4; ++m) { const float rs = S[ai * HALF + wr * 64 + m * 16 + fr]; const unsigned r = row0 + ai * HALF + m * 16;
#pragma unroll
                for (int bj = 0; bj < 2; ++bj) { float* op = out + (r * 1024u + col0 + bj * HALF);
                    *(f32x4*)op = acc[ai][bj][m][0] * rs * gv[bj][0]; *(f32x4*)(op + 4) = acc[ai][bj][m][1] * rs * gv[bj][1]; } }
    }
};
struct EpiWin {
    static constexpr bool PERM = true, AFTER_DRAIN = false, HAS_INIT = false;
    bf16_t* QKV; bf16_t* GATE; const float* ssqp; const float* rope; const PG8_LAS float* rsl;
    __device__ __forceinline__ void operator()(const f32x4 (&acc)[2][2][4][2], const Unit& u, int wr, int wc, int fr, int fq) const {
        const int row0 = u.pm * BM + wr * 64 + fr; const int pn = u.pn; const bool isgate = pn >= 12;
        const bool dorope = (pn < 6) && ((wc & 1) == 0) && (fq < 2); const float qs = (pn < 3 || pn == 9) ? 0.125f : 1.0f;
#pragma unroll
        for (int ai = 0; ai < 2; ++ai)
#pragma unroll
            for (int m = 0; m < 4; ++m) {
                const int r = row0 + ai * HALF + m * 16; const float rs = rsl[u.ui * 256 + ai * HALF + wr * 64 + m * 16 + fr]; const int t = r & 4095;
#pragma unroll
                for (int bj = 0; bj < 2; ++bj) {
                    const int colt = bj * HALF + wc * 32 + 8 * fq; float v[8];
#pragma unroll
                    for (int n = 0; n < 2; ++n)
#pragma unroll
                        for (int j = 0; j < 4; ++j) v[n * 4 + j] = acc[ai][bj][m][n][j] * rs;
                    bf16_t* dst;
                    if (isgate) {
#pragma unroll
                        for (int i = 0; i < 8; ++i) v[i] = __builtin_amdgcn_rcpf(1.0f + __builtin_amdgcn_exp2f(-v[i] * LOG2E));
                        dst = GATE + ((unsigned)r * 2048u + (unsigned)((pn - 12) * 256 + colt));
                    } else {
                        if (dorope) {
                            const f32x4* cs = (const f32x4*)(rope + ((unsigned)t * 16u + 8u * (unsigned)fq));
                            const f32x4 c01 = cs[0], c23 = cs[1];
                            { const float x1 = v[0], x2 = v[1]; v[0] = x1 * c01[0] - x2 * c01[1]; v[1] = x2 * c01[0] + x1 * c01[1]; }
                            { const float x1 = v[2], x2 = v[3]; v[2] = x1 * c01[2] - x2 * c01[3]; v[3] = x2 * c01[2] + x1 * c01[3]; }
                            { const float x1 = v[4], x2 = v[5]; v[4] = x1 * c23[0] - x2 * c23[1]; v[5] = x2 * c23[0] + x1 * c23[1]; }
                            { const float x1 = v[6], x2 = v[7]; v[6] = x1 * c23[2] - x2 * c23[3]; v[7] = x2 * c23[2] + x1 * c23[3]; }
                        }
#pragma unroll
                        for (int i = 0; i < 8; ++i) v[i] *= qs;
                        { const unsigned cc = (unsigned)(pn * 256 + colt); dst = QKV + (((cc >> 6) * 16384u + (unsigned)r) * 64u + (cc & 63u)); }
                    }
                    u32x4 w; w.x = cvt_pk_bf16(v[0], v[1]); w.y = cvt_pk_bf16(v[2], v[3]); w.z = cvt_pk_bf16(v[4], v[5]); w.w = cvt_pk_bf16(v[6], v[7]);
                    *(u32x4*)dst = w;
                }
                asm volatile("" ::: "memory");
            }
    }
};
template <bool SECOND> struct EpiGate {
    static constexpr bool PERM = true, AFTER_DRAIN = false, HAS_INIT = false;
    const bf16_t* gate; bf16_t* Y1; bf16_t* Y;
    __device__ __forceinline__ void operator()(const f32x4 (&acc)[2][2][4][2], const Unit& u, int wr, int wc, int fr, int fq) const {
        const unsigned row0 = u.pm * BM + wr * 64 + fr, col0 = u.pn * BM + wc * 32 + 8 * fq;
#pragma unroll
        for (int ai = 0; ai < 2; ++ai)
#pragma unroll
            for (int m = 0; m < 4; ++m) {
                const unsigned r = row0 + ai * HALF + m * 16;
#pragma unroll
                for (int bj = 0; bj < 2; ++bj) {
                    const unsigned c = col0 + bj * HALF; const unsigned go = r * 2048u + c, yo = r * 1024u + c;
                    const u32x4 gw = *(const u32x4*)(gate + go);
                    f32x4 a0 = acc[ai][bj][m][0], a1 = acc[ai][bj][m][1];
                    a0[0] *= __uint_as_float(gw.x << 16); a0[1] *= __uint_as_float(gw.x & 0xffff0000u); a0[2] *= __uint_as_float(gw.y << 16); a0[3] *= __uint_as_float(gw.y & 0xffff0000u);
                    a1[0] *= __uint_as_float(gw.z << 16); a1[1] *= __uint_as_float(gw.z & 0xffff0000u); a1[2] *= __uint_as_float(gw.w << 16); a1[3] *= __uint_as_float(gw.w & 0xffff0000u);
                    if (!SECOND) { u32x4 w; w.x = cvt_pk_bf16(a0[0], a0[1]); w.y = cvt_pk_bf16(a0[2], a0[3]); w.z = cvt_pk_bf16(a1[0], a1[1]); w.w = cvt_pk_bf16(a1[2], a1[3]); *(u32x4*)(Y1 + yo) = w; }
                    else { const u32x4 yw = *(const u32x4*)(Y1 + yo);
                        a0[0] += __uint_as_float(yw.x << 16); a0[1] += __uint_as_float(yw.x & 0xffff0000u); a0[2] += __uint_as_float(yw.y << 16); a0[3] += __uint_as_float(yw.y & 0xffff0000u);
                        a1[0] += __uint_as_float(yw.z << 16); a1[1] += __uint_as_float(yw.z & 0xffff0000u); a1[2] += __uint_as_float(yw.w << 16); a1[3] += __uint_as_float(yw.w & 0xffff0000u);
                        u32x4 w; w.x = cvt_pk_bf16(a0[0], a0[1]); w.y = cvt_pk_bf16(a0[2], a0[3]); w.z = cvt_pk_bf16(a1[0], a1[1]); w.w = cvt_pk_bf16(a1[2], a1[3]);
                        __builtin_amdgcn_raw_buffer_store_b128(w, __builtin_amdgcn_make_buffer_rsrc(Y, 0, 16384 * 1024 * 2, 0x00020000), yo * 2u, 0,   16); }
                    asm volatile("" ::: "memory");
                }
            }
    }
};
struct EpiGate2 {
    static constexpr bool PERM = true, AFTER_DRAIN = false, HAS_INIT = false;
    const bf16_t* gate; bf16_t* Y1; bf16_t* Y;
    __device__ __forceinline__ void operator()(const f32x4 (&acc)[2][2][4][2], const Unit& u, int wr, int wc, int fr, int fq) const {
        const unsigned row0 = u.pm * BM + wr * 64 + fr, col0 = u.pn * BM + wc * 32 + 8 * fq; const bool second = u.sel != 0; const unsigned gofs = second ? 0u : 1024u;
#pragma unroll
        for (int ai = 0; ai < 2; ++ai)
#pragma unroll
            for (int m = 0; m < 4; ++m) {
                const unsigned r = row0 + ai * HALF + m * 16;
#pragma unroll
                for (int bj = 0; bj < 2; ++bj) {
                    const unsigned c = col0 + bj * HALF; const unsigned go = r * 2048u + gofs + c, yo = r * 1024u + c;
                    const u32x4 gw = *(const u32x4*)(gate + go);
                    f32x4 a0 = acc[ai][bj][m][0], a1 = acc[ai][bj][m][1];
                    a0[0] *= __uint_as_float(gw.x << 16); a0[1] *= __uint_as_float(gw.x & 0xffff0000u); a0[2] *= __uint_as_float(gw.y << 16); a0[3] *= __uint_as_float(gw.y & 0xffff0000u);
                    a1[0] *= __uint_as_float(gw.z << 16); a1[1] *= __uint_as_float(gw.z & 0xffff0000u); a1[2] *= __uint_as_float(gw.w << 16); a1[3] *= __uint_as_float(gw.w & 0xffff0000u);
                    if (second) { const u32x4 yw = *(const u32x4*)(Y1 + yo);
                        a0[0] += __uint_as_float(yw.x << 16); a0[1] += __uint_as_float(yw.x & 0xffff0000u); a0[2] += __uint_as_float(yw.y << 16); a0[3] += __uint_as_float(yw.y & 0xffff0000u);
                        a1[0] += __uint_as_float(yw.z << 16); a1[1] += __uint_as_float(yw.z & 0xffff0000u); a1[2] += __uint_as_float(yw.w << 16); a1[3] += __uint_as_float(yw.w & 0xffff0000u); }
                    u32x4 w; w.x = cvt_pk_bf16(a0[0], a0[1]); w.y = cvt_pk_bf16(a0[2], a0[3]); w.z = cvt_pk_bf16(a1[0], a1[1]); w.w = cvt_pk_bf16(a1[2], a1[3]);
                    if (second) __builtin_amdgcn_raw_buffer_store_b128(w, __builtin_amdgcn_make_buffer_rsrc(Y, 0, 16384 * 1024 * 2, 0x00020000), yo * 2u, 0,   16);
                    else *(u32x4*)(Y1 + yo) = w;
                    asm volatile("" ::: "memory");
                }
            }
    }
};

template <class Epi, class Sched, bool ALIGN_EPI = false, bool SP2 = false>
__device__ __forceinline__ void gemm_phase(PG8_LAS unsigned char* lds, const Gemm g, const Sched& S, const Epi& E) {
    int tid_ = threadIdx.x; asm volatile("" : "+v"(tid_));
    const int tid = tid_, wid = __builtin_amdgcn_readfirstlane(tid >> 6), lane = tid & 63, wr = wid >> 2, wc = wid & 3, fr = lane & 15, fq = lane >> 4;
    const int K = g.K, nt = K / BK;
    unsigned voffA[2], voffB[2];
#pragma unroll
    for (int i = 0; i < 2; ++i) { int R, C; stage_rc(tid * 16 + i * 8192, R, C); const int Rb = Epi::PERM ? ((R & ~31) + perm32(R & 31)) : R;
        voffA[i] = (unsigned)(R * K + C) * 2u; voffB[i] = (unsigned)(Rb * K + C) * 2u; }
    const size_t kstep = (size_t)(BK * 2);
    const size_t hstep = (size_t)HALF * K * 2;
    const size_t tstep = 2 * hstep;
    const unsigned ldsw = (unsigned)wid * 1024u;
    const int aoff = lds_byte(wr * 64 + fr, fq * 8), boff = lds_byte(wc * 32 + fr, fq * 8);
#define PG8_SA(b, h) (((b) * 2 + (h)) * HTB)
#define PG8_SB(b, h) ((4 + (b) * 2 + (h)) * HTB)
#define PG8_STAGE(bufoff, gbase, voff) do { _Pragma("unroll") for (int _i = 0; _i < 2; ++_i) \
        __builtin_amdgcn_global_load_lds((const unsigned*)((const char*)(gbase) + (voff)[_i]), (PG8_LAS unsigned*)(lds + (bufoff) + ldsw + _i * 8192), 16, 0, 0); } while (0)
#define PG8_LDA(dst, b, h) do { _Pragma("unroll") for (int m = 0; m < 4; ++m) _Pragma("unroll") for (int k = 0; k < 2; ++k) dst[m][k] = *(const PG8_LAS bf16x8*)(lds + PG8_SA(b, h) + aoff + m * 2048 + k * 1024); } while (0)
#define PG8_LDB(dst, b, h) do { _Pragma("unroll") for (int n = 0; n < 2; ++n) _Pragma("unroll") for (int k = 0; k < 2; ++k) dst[n][k] = *(const PG8_LAS bf16x8*)(lds + PG8_SB(b, h) + boff + n * 2048 + k * 1024); } while (0)
#define PG8_MMA(ai, bj, At, Bt) do { __builtin_amdgcn_s_setprio(1); _Pragma("unroll") for (int m = 0; m < 4; ++m) _Pragma("unroll") for (int n = 0; n < 2; ++n) _Pragma("unroll") for (int k = 0; k < 2; ++k) \
        acc[ai][bj][m][n] = __builtin_amdgcn_mfma_f32_16x16x32_bf16(Bt[n][k], At[m][k], acc[ai][bj][m][n], 0, 0, 0); __builtin_amdgcn_s_setprio(0); } while (0)
#define PG8_WAIT_V(n) asm volatile("s_waitcnt vmcnt(" #n ")" ::: "memory")
#define PG8_WAIT_L(n) asm volatile("s_waitcnt lgkmcnt(" #n ")" ::: "memory")
#define PG8_BAR __builtin_amdgcn_s_barrier()
#define PG8_SCHED __builtin_amdgcn_sched_barrier(0)
    Unit cur, nxt; int ui = 0;
    if (!S.next(0, cur)) return;
    f32x4 acc[2][2][4][2];
    if constexpr (Epi::HAS_INIT) E.init(acc, cur, wr, wc, fr, fq);
    else {
#pragma unroll
    for (int a = 0; a < 2; ++a)
#pragma unroll
        for (int b = 0; b < 2; ++b)
#pragma unroll
            for (int m = 0; m < 4; ++m)
#pragma unroll
                for (int n = 0; n < 2; ++n) acc[a][b][m][n] = (f32x4){0.f, 0.f, 0.f, 0.f};
    }
    bf16x8 At[4][2], B0[2][2], B1[2][2];
    const char* cA = (const char*)(cur.sel ? g.A2 : g.A) + (size_t)cur.pm * tstep; const char* cB = (const char*)(cur.sel ? g.Bt2 : g.Bt) + (size_t)cur.pn * tstep;
    S.a_ready(cur);
    if constexpr (SP2) {
        PG8_STAGE(PG8_SB(0, 0), cB, voffB); PG8_STAGE(PG8_SB(0, 1), cB + hstep, voffB); PG8_STAGE(PG8_SA(0, 0), cA, voffA); PG8_STAGE(PG8_SA(0, 1), cA + hstep, voffA);
        if (wr == 1) PG8_BAR;
        PG8_WAIT_V(2); PG8_BAR;
        PG8_STAGE(PG8_SB(1, 0), cB + kstep, voffB); PG8_STAGE(PG8_SA(1, 0), cA + kstep, voffA); PG8_STAGE(PG8_SB(1, 1), cB + hstep + kstep, voffB);
        PG8_WAIT_V(6); PG8_BAR;
    } else {
        PG8_STAGE(PG8_SB(0, 0), cB, voffB); PG8_STAGE(PG8_SA(0, 0), cA, voffA); PG8_STAGE(PG8_SB(0, 1), cB + hstep, voffB); PG8_STAGE(PG8_SA(0, 1), cA + hstep, voffA);
        if (wr == 1) PG8_BAR;
        PG8_WAIT_V(4); PG8_BAR;
        PG8_STAGE(PG8_SB(1, 0), cB + kstep, voffB); PG8_STAGE(PG8_SA(1, 0), cA + kstep, voffA); PG8_STAGE(PG8_SB(1, 1), cB + hstep + kstep, voffB);
        PG8_WAIT_V(6); PG8_BAR;
    }
    for (;;) {
        const bool has_next = S.next(ui + 1, nxt);
        const char* nA = has_next ? (const char*)(nxt.sel ? g.A2 : g.A) + (size_t)nxt.pm * tstep : cA; const char* nB = has_next ? (const char*)(nxt.sel ? g.Bt2 : g.Bt) + (size_t)nxt.pn * tstep : cB;
        for (int t = 0; t < nt; t += 2) {
            const bool last = (t == nt - 2);
            const char* a1 = cA + (size_t)(t + 1) * kstep;
            const char* a2 = last ? nA : cA + (size_t)(t + 2) * kstep; const char* b2 = last ? nB : cB + (size_t)(t + 2) * kstep;
            const char* a3 = a2 + kstep; const char* b3 = b2 + kstep;
            if (last && has_next) S.a_ready(nxt);
            if constexpr (SP2) {
            PG8_LDB(B0, 0, 0); PG8_LDB(B1, 0, 1); PG8_SCHED; PG8_LDA(At, 0, 0); PG8_STAGE(PG8_SA(1, 1), a1 + hstep, voffA);
            PG8_WAIT_V(8); PG8_WAIT_L(0); PG8_BAR; PG8_MMA(0, 0, At, B0); PG8_MMA(0, 1, At, B1); PG8_BAR; PG8_SCHED;
            PG8_LDA(At, 0, 1); PG8_STAGE(PG8_SB(0, 0), b2, voffB); PG8_STAGE(PG8_SB(0, 1), b2 + hstep, voffB); PG8_STAGE(PG8_SA(0, 0), a2, voffA);
            PG8_WAIT_V(8); PG8_WAIT_L(0); PG8_BAR; PG8_MMA(1, 0, At, B0); PG8_MMA(1, 1, At, B1); PG8_BAR; PG8_SCHED;
            PG8_LDB(B0, 1, 0); PG8_LDB(B1, 1, 1); PG8_SCHED; PG8_LDA(At, 1, 0); PG8_STAGE(PG8_SA(0, 1), a2 + hstep, voffA);
            PG8_WAIT_V(8); PG8_WAIT_L(0); PG8_BAR; PG8_MMA(0, 0, At, B0); PG8_MMA(0, 1, At, B1); PG8_BAR; PG8_SCHED;
            PG8_LDA(At, 1, 1); PG8_STAGE(PG8_SB(1, 0), b3, voffB); PG8_STAGE(PG8_SB(1, 1), b3 + hstep, voffB); PG8_STAGE(PG8_SA(1, 0), a3, voffA);
            PG8_WAIT_V(8); PG8_WAIT_L(0); PG8_BAR; PG8_MMA(1, 0, At, B0); PG8_MMA(1, 1, At, B1); PG8_BAR; PG8_SCHED;
            } else {
            PG8_LDB(B0, 0, 0); PG8_SCHED; PG8_LDA(At, 0, 0); PG8_STAGE(PG8_SA(1, 1), a1 + hstep, voffA);
            PG8_WAIT_L(8); PG8_BAR; PG8_WAIT_L(0); PG8_MMA(0, 0, At, B0); PG8_BAR; PG8_SCHED;
            PG8_LDB(B1, 0, 1); PG8_STAGE(PG8_SB(0, 0), b2, voffB);
            PG8_BAR; PG8_WAIT_L(0); PG8_MMA(0, 1, At, B1); PG8_BAR;
            PG8_LDA(At, 0, 1); PG8_STAGE(PG8_SA(0, 0), a2, voffA);
            PG8_BAR; PG8_WAIT_L(0); PG8_MMA(1, 0, At, B0); PG8_BAR; PG8_SCHED;
            PG8_STAGE(PG8_SB(0, 1), b2 + hstep, voffB);
            PG8_WAIT_V(6); PG8_BAR; PG8_MMA(1, 1, At, B1); PG8_BAR;
            PG8_LDB(B0, 1, 0); PG8_SCHED; PG8_LDA(At, 1, 0); PG8_STAGE(PG8_SA(0, 1), a2 + hstep, voffA);
            PG8_WAIT_L(8); PG8_BAR; PG8_WAIT_L(0); PG8_MMA(0, 0, At, B0); PG8_BAR; PG8_SCHED;
            PG8_LDB(B1, 1, 1); PG8_STAGE(PG8_SB(1, 0), b3, voffB);
            PG8_BAR; PG8_WAIT_L(0); PG8_MMA(0, 1, At, B1); PG8_BAR;
            PG8_LDA(At, 1, 1); PG8_STAGE(PG8_SA(1, 0), a3, voffA);
            PG8_BAR; PG8_WAIT_L(0); PG8_MMA(1, 0, At, B0); PG8_BAR; PG8_SCHED;
            PG8_STAGE(PG8_SB(1, 1), b3 + hstep, voffB);
            PG8_WAIT_V(6); PG8_BAR; PG8_MMA(1, 1, At, B1); PG8_BAR;
            }
        }
        if constexpr (ALIGN_EPI) { if (wr == 0) PG8_BAR; }
        if constexpr (!Epi::AFTER_DRAIN) { E(acc, cur, wr, wc, fr, fq); S.done(cur); }
        if (!has_next) break;
        if constexpr (Epi::HAS_INIT) E.init(acc, nxt, wr, wc, fr, fq);
        else {
#pragma unroll
        for (int a = 0; a < 2; ++a)
#pragma unroll
            for (int b = 0; b < 2; ++b)
#pragma unroll
                for (int m = 0; m < 4; ++m)
#pragma unroll
                    for (int n = 0; n < 2; ++n) acc[a][b][m][n] = (f32x4){0.f, 0.f, 0.f, 0.f};
        }
        cur = nxt; cA = nA; cB = nB; ++ui;
        if constexpr (ALIGN_EPI) { if (wr == 1) PG8_BAR; }
    }
    PG8_WAIT_V(0);
    if constexpr (!ALIGN_EPI) { if (wr == 0) PG8_BAR; }
    PG8_BAR;
    if constexpr (Epi::AFTER_DRAIN) { E.fused(acc, cur, wr, wc, fr, fq, lds, wid, lane); S.done(cur); }
#undef PG8_SA
#undef PG8_SB
#undef PG8_STAGE
#undef PG8_LDA
#undef PG8_LDB
#undef PG8_MMA
#undef PG8_WAIT_V
#undef PG8_WAIT_L
#undef PG8_BAR
#undef PG8_SCHED
}
}

#define LAS __attribute__((address_space(3)))
typedef unsigned short bf16;
typedef short bf16x8 __attribute__((ext_vector_type(8)));
typedef short s16x4 __attribute__((ext_vector_type(4)));
typedef float f32x4 __attribute__((ext_vector_type(4)));
typedef float f32x16 __attribute__((ext_vector_type(16)));
typedef unsigned u32x4 __attribute__((ext_vector_type(4)));
typedef unsigned u32x2 __attribute__((ext_vector_type(2)));
constexpr int NWAVES = 8;
constexpr int M = 16384, D = 1024, SEQ = 4096, FF = 2816, NIN = 5120, NQKV = 3072, NGATE = 2048, DEPTH = 2;
constexpr float LOG2E = 1.4426950408889634f;
#ifndef SB_EARLY_EXIT
#define SB_EARLY_EXIT 1
#endif
#ifndef N_LAUNCH_MODE
#define N_LAUNCH_MODE 0
#endif
constexpr size_t MiB = 1u << 20;
constexpr size_t WS_CNT = 16384, WS_PCNT = 32768, WS_ZERO_BYTES = 32768 + 4 * 16384;
constexpr size_t WS_XSLOT = 250 * MiB;
constexpr size_t WS_BAR = 0;
constexpr size_t WS_SSQ = 1 * MiB, WS_ROPE = 2 * MiB, WS_LSE = 3 * MiB;
constexpr size_t WS_W = 4 * MiB;
constexpr size_t W_1CAT = 0, W_D1 = W_1CAT + (size_t)2 * FF * D * 2, W_IN = W_D1 + (size_t)D * FF * 2, W_PD = W_IN + (size_t)NIN * D * 2, W_PS = W_PD + (size_t)D * 256 * 2,
                 W_OUT = W_PS + (size_t)D * 256 * 2, W_2CAT = W_OUT + (size_t)D * D * 2, W_D2 = W_2CAT + (size_t)2 * FF * D * 2, W_END = W_D2 + (size_t)D * FF * 2;
static_assert(W_END <= 46 * MiB, "weights");
constexpr size_t WS_XB = 50 * MiB;
constexpr size_t OUT_OD3 = 0, OUT_OD = 24 * MiB;
constexpr size_t WS_R = 82 * MiB;
constexpr size_t WS_Y1 = WS_R, WS_Y = WS_R + 64 * MiB;
constexpr size_t WS_GATE = 178 * MiB;
constexpr size_t WS_OS = 242 * MiB;
constexpr size_t WS_END = 251 * MiB;
constexpr int RSL_OFF = 131072 + 1024;
constexpr int LDS_BYTES = RSL_OFF + 8 * 256 * 4;

__device__ __forceinline__ float wave_sum(float v) {
#pragma unroll
    for (int o = 1; o < 64; o <<= 1) v += __shfl_xor(v, o);
    return v;
}
__device__ __forceinline__ unsigned pk2(float lo, float hi) { return pg8::cvt_pk_bf16(lo, hi); }
#define LDS_WAIT() asm volatile("s_waitcnt lgkmcnt(0)" ::: "memory")

typedef __attribute__((address_space(1))) unsigned gu32;
#define XB_TMO      128
#define XB_XCNT(j)  (256  + 64 * (j))
#define XB_XSUB(j)  (1280 + 64 * (j))
#define XB_XGEN(j)  (2304 + 64 * (j))
#define XB_TOP      3328
#define XB_TOPGEN   3392
#define XCD_BAR_WORDS 3456
#define XB_SPIN_CAP (1u << 18)

__device__ __forceinline__ unsigned xb_ld(unsigned* p)              { return __hip_atomic_load(p, __ATOMIC_RELAXED, __HIP_MEMORY_SCOPE_AGENT); }
__device__ __forceinline__ unsigned xb_add(unsigned* p, unsigned v) { return __hip_atomic_fetch_add(p, v, __ATOMIC_RELAXED, __HIP_MEMORY_SCOPE_AGENT); }
__device__ __forceinline__ unsigned xb_xcc_id() { return (unsigned)__builtin_amdgcn_s_getreg((3 << 11) | 20) & 0xFu; }
#define XB_SPIN(cond, bar) do { unsigned _sp = 0; while (cond) { __builtin_amdgcn_s_sleep(1); \
    if ((++_sp & 255u) == 0u) { if (xb_ld(&(bar)[XB_TMO])) break; if (_sp > XB_SPIN_CAP) { atomicAdd(&(bar)[XB_TMO], 1u); break; } } } } while (0)

struct XcdBarrier {
    unsigned* bar; unsigned x;
    volatile LAS unsigned* st;
};

__device__ __forceinline__ XcdBarrier xcd_barrier_post(unsigned* bar, volatile LAS unsigned* st) {
    XcdBarrier b; b.bar = bar; b.x = xb_xcc_id(); b.st = st;
    if (threadIdx.x == 0) (void)xb_add(&bar[XB_XCNT(b.x)], 1u);
    return b;
}
__device__ __forceinline__ void xcd_barrier_complete(unsigned* bar, unsigned x, unsigned& nloc, unsigned& nx) {
    const unsigned G = gridDim.x * gridDim.y * gridDim.z;
    unsigned sum, cnt, mine, sp = 0u;
    for (;;) {
        sum = 0u; cnt = 0u; mine = 0u;
#pragma unroll
        for (unsigned j = 0; j < 16; ++j) { const unsigned c = xb_ld(&bar[XB_XCNT(j)]); sum += c; cnt += (c > 0u) ? 1u : 0u; mine = (j == x) ? c : mine; }
        if (sum == G) break;
        __builtin_amdgcn_s_sleep(1);
        if ((++sp & 255u) == 0u) { if (xb_ld(&bar[XB_TMO])) break; if (sp > XB_SPIN_CAP) { atomicAdd(&bar[XB_TMO], 1u); break; } }
    }
    nloc = mine > 0u ? mine : 1u; nx = cnt > 0u ? cnt : 1u;
}

__device__ __forceinline__ void xcd_barrier(const XcdBarrier& b) {
    asm volatile("s_waitcnt vmcnt(0)" ::: "memory");
    __syncthreads();
    if (threadIdx.x == 0) {
        unsigned* bar = b.bar;
        __builtin_amdgcn_s_waitcnt(0);
        unsigned nloc = b.st[0], nx = b.st[1];
        if (nloc == 0u) { xcd_barrier_complete(bar, b.x, nloc, nx); b.st[0] = nloc; b.st[1] = nx; }
        const unsigned old = xb_add(&bar[XB_XSUB(b.x)], 1u);
        const unsigned gen = old / nloc;
        if (old + 1u == (gen + 1u) * nloc) {
            __builtin_amdgcn_fence(__ATOMIC_RELEASE, "agent");
            asm volatile("s_waitcnt vmcnt(0)" ::: "memory");
            const unsigned og = xb_add(&bar[XB_TOP], 1u);
            const unsigned tg = og / nx;
            if (og + 1u == (tg + 1u) * nx) xb_add(&bar[XB_TOPGEN], 1u);
            else XB_SPIN(xb_ld(&bar[XB_TOPGEN]) == tg, bar);
            __builtin_amdgcn_fence(__ATOMIC_ACQUIRE, "agent");
            xb_add(&bar[XB_XGEN(b.x)], 1u);
            asm volatile("s_waitcnt vmcnt(0)" ::: "memory");
        } else {
            XB_SPIN(xb_ld(&bar[XB_XGEN(b.x)]) == gen, bar);
            __builtin_amdgcn_fence(__ATOMIC_ACQUIRE, "agent");
            asm volatile("s_waitcnt vmcnt(0)" ::: "memory");
        }
    }
    __syncthreads();
}


constexpr int CI_D1 = 2816, CI_IN = 4224, CI_B = 6784, CI_D2 = 9600, CI_PD = 11008, CI_PS = 11136, CI_OUT = 11264, CI_END = 11776;
struct ConvItem { const float* wp; const float* gp; bf16* dp; int ldw, K; bool rperm; };
struct ConvSrc { const float *n1, *wg1, *wu1, *wd1, *nm, *win, *wpd, *wps, *wout, *n2, *wg2, *wu2, *wd2; };
__device__ __forceinline__ ConvItem conv_decode(const ConvSrc& S, int l, int r, unsigned char* dA, unsigned char* dB, int lane) {
    const float* src; const float* gain = nullptr; bf16* dst; int ldw = D, K = D, kb, nb, sc0; bool rperm = false;
    if (r < CI_D1) { kb = r / 176; nb = r % 176; const int pn = nb >> 3, i8 = nb & 7; src = (i8 < 4 ? S.wg1 : S.wu1) + (size_t)l * D * FF; gain = S.n1 + (size_t)l * D; dst = (bf16*)(dA + W_1CAT); ldw = FF; sc0 = 128 * pn + 32 * (i8 & 3); }
    else if (r < CI_IN) { r -= CI_D1; kb = r / 32; nb = r % 32; src = S.wd1 + (size_t)l * FF * D; dst = (bf16*)(dA + W_D1); K = FF; sc0 = 32 * nb; }
    else if (r < CI_B) { r -= CI_IN; kb = r / 160; nb = r % 160; src = S.win + (size_t)l * D * NIN; gain = S.nm + (size_t)l * D; dst = (bf16*)(dA + W_IN); ldw = NIN; sc0 = 32 * nb; rperm = (nb < 48) && !(nb & 1); }
    else if (r < CI_D2) { r -= CI_B; kb = r / 176; nb = r % 176; const int pn = nb >> 3, i8 = nb & 7; src = (i8 < 4 ? S.wg2 : S.wu2) + (size_t)l * D * FF; gain = S.n2 + (size_t)l * D; dst = (bf16*)(dB + W_2CAT); ldw = FF; sc0 = 128 * pn + 32 * (i8 & 3); }
    else if (r < CI_PD) { r -= CI_D2; kb = r / 32; nb = r % 32; src = S.wd2 + (size_t)l * FF * D; dst = (bf16*)(dB + W_D2); K = FF; sc0 = 32 * nb; }
    else if (r < CI_PS) { r -= CI_PD; kb = r / 32; nb = r % 32; src = S.wpd + (size_t)l * 256 * D; dst = (bf16*)(dB + W_PD); K = 256; sc0 = 32 * nb; }
    else if (r < CI_OUT) { r -= CI_PS; kb = r / 32; nb = r % 32; src = S.wps + (size_t)l * 256 * D; dst = (bf16*)(dB + W_PS); K = 256; sc0 = 32 * nb; }
    else { r -= CI_OUT; kb = r / 32; nb = r % 32; src = S.wout + (size_t)l * D * D; dst = (bf16*)(dB + W_OUT); sc0 = 32 * nb; }
    const int c4 = lane & 7, kr = lane >> 3, k0 = 64 * kb;
    ConvItem I; I.wp = src + (size_t)(k0 + kr) * ldw + sc0 + 4 * c4; I.gp = gain ? gain + k0 + kr : nullptr; I.dp = dst + (size_t)(32 * nb) * K + k0; I.ldw = ldw; I.K = K; I.rperm = rperm;
    return I;
}
__device__ __forceinline__ void conv_load(f32x4 (&v)[8], const ConvItem& I) {
#pragma unroll
    for (int i = 0; i < 8; ++i) v[i] = *(const f32x4*)(I.wp + (size_t)(8 * i) * I.ldw);
}
__device__ __forceinline__ void conv_finish(f32x4 (&v)[8], const ConvItem& I, LAS float* scr, int lane) {
    const int c4 = lane & 7, kr = lane >> 3;
    if (I.gp) {
#pragma unroll
        for (int i = 0; i < 8; ++i) v[i] *= I.gp[8 * i];
    }
    int p[4];
#pragma unroll
    for (int e = 0; e < 4; ++e) { const int sc = 4 * c4 + e; p[e] = (I.rperm && sc < 16) ? (sc < 8 ? 2 * sc : 2 * (sc - 8) + 1) : sc; }
#pragma unroll
    for (int i = 0; i < 8; ++i)
#pragma unroll
        for (int e = 0; e < 4; ++e) scr[(kr + 8 * i) * 33 + p[e]] = v[i][e];
    LDS_WAIT();
    const int c = lane & 7;
#pragma unroll
    for (int jj = 0; jj < 4; ++jj) { const int n = (lane >> 3) + 8 * jj; const LAS float* s = scr + (8 * c) * 33 + n;
        u32x4 o; o.x = pk2(s[0 * 33], s[1 * 33]); o.y = pk2(s[2 * 33], s[3 * 33]); o.z = pk2(s[4 * 33], s[5 * 33]); o.w = pk2(s[6 * 33], s[7 * 33]);
        *(u32x4*)(I.dp + (size_t)n * I.K + 8 * c) = o; }
    LDS_WAIT();
}
__device__ __forceinline__ void conv_items(const ConvSrc& S, int l, int lo, int hi, unsigned char* dA, unsigned char* dB, LAS unsigned char* lds, int widx, int nw, int wave, int lane) {
    LAS float* scr = (LAS float*)(lds + wave * 8704);
    int it = lo + widx; if (it >= hi) return;
    ConvItem cur = conv_decode(S, l, __builtin_amdgcn_readfirstlane(it), dA, dB, lane); f32x4 v[8]; conv_load(v, cur);
    for (;;) {
        const int itn = it + nw; const bool more = itn < hi;
        ConvItem nxt = cur; f32x4 vn[8];
        if (more) { nxt = conv_decode(S, l, __builtin_amdgcn_readfirstlane(itn), dA, dB, lane); conv_load(vn, nxt); }
        conv_finish(v, cur, scr, lane);
        if (!more) break;
        cur = nxt; it = itn;
#pragma unroll
        for (int i = 0; i < 8; ++i) v[i] = vn[i];
    }
}
__device__ __forceinline__ void conv_phase(const float* Px, const ConvSrc& S, unsigned char* Pws, int l, LAS unsigned char* lds, int gw, int NGW, int wave, int lane) {
    unsigned char* wsw = Pws + WS_W;
    conv_items(S, l, 0, CI_END, wsw, wsw, lds, gw, NGW, wave, lane);
    if (l == 0) {
        const float* x = Px; bf16* xb = (bf16*)(Pws + WS_XB); float* ssqp = (float*)(Pws + WS_SSQ);
        for (int m = gw; m < M; m += NGW) {
            const f32x4* xr = (const f32x4*)(x + (size_t)m * D) + 2 * lane; f32x4 v[4]; float s = 0.f;
#pragma unroll
            for (int j = 0; j < 2; ++j) { v[2 * j] = xr[128 * j]; v[2 * j + 1] = xr[128 * j + 1]; }
#pragma unroll
            for (int j = 0; j < 4; ++j) s += (v[j][0] * v[j][0] + v[j][1] * v[j][1]) + (v[j][2] * v[j][2] + v[j][3] * v[j][3]);
            s = wave_sum(s);
            u32x4* o = (u32x4*)(xb + (size_t)m * D) + lane;
#pragma unroll
            for (int j = 0; j < 2; ++j) { u32x4 w; w.x = pk2(v[2 * j][0], v[2 * j][1]); w.y = pk2(v[2 * j][2], v[2 * j][3]); w.z = pk2(v[2 * j + 1][0], v[2 * j + 1][1]); w.w = pk2(v[2 * j + 1][2], v[2 * j + 1][3]); o[64 * j] = w; }
            if (lane < 16) ssqp[(size_t)m * 16 + lane] = (lane == 0) ? s : 0.f;
        }
        float* rope = (float*)(Pws + WS_ROPE);
        for (int idx = gw * 64 + lane; idx < SEQ * 8; idx += NGW * 64) {
            const int t = idx >> 3, i = idx & 7;
            const float invf = (i == 0) ? 1.0f : (i == 1) ? 0.1939227432012558f : (i == 2) ? 0.03760603070259094f : (i == 3) ? 0.007292664609849453f : (i == 4) ? 0.0014142135623842478f
                             : (i == 5) ? 0.00027424818836152554f : (i == 6) ? 5.3182957344688475e-05f : 1.0313385246263351e-05f;
            const float angf = (float)t * invf; const double a = (double)angf;
            const double kq = __builtin_rint(a * 0.63661977236758134308);
            double rr = __builtin_fma(-kq, 1.57079632679489655800, a); rr = __builtin_fma(-kq, 6.12323399573676603587e-17, rr);
            const int qd = ((int)kq) & 3; const float rf = (float)rr, r2 = rf * rf;
            const float sn = rf + rf * r2 * (-1.0f / 6 + r2 * (1.0f / 120 + r2 * (-1.0f / 5040 + r2 * (1.0f / 362880))));
            const float cn = 1.0f + r2 * (-0.5f + r2 * (1.0f / 24 + r2 * (-1.0f / 720 + r2 * (1.0f / 40320 + r2 * (-1.0f / 3628800)))));
            const float c = (qd == 0) ? cn : (qd == 1) ? -sn : (qd == 2) ? -cn : sn;
            const float s = (qd == 0) ? sn : (qd == 1) ? cn : (qd == 2) ? -sn : -cn;
            rope[2 * idx] = c; rope[2 * idx + 1] = s;
        }
    }
}

__device__ __forceinline__ int crow(int r, int hi) { return (r & 3) + 8 * (r >> 2) + 4 * hi; }
struct F2 { float a, b; };
__device__ __forceinline__ F2 pair32(float v) { const auto rr = __builtin_amdgcn_permlane32_swap(__float_as_uint(v), __float_as_uint(v), false, false); return F2{__uint_as_float(rr[0]), __uint_as_float(rr[1])}; }
__device__ __forceinline__ void ld_frag4(bf16x8 (&f)[4], const bf16* ubase, unsigned rowstride, int lane) {
    const unsigned off = (unsigned)(lane & 31) * rowstride + (unsigned)(lane >> 5) * 8u;
#pragma unroll
    for (int d0 = 0; d0 < 4; ++d0) f[d0] = *(const bf16x8*)(ubase + (off + d0 * 16));
}
__device__ __forceinline__ f32x16 qk_tile(const bf16x8 (&kf)[4], const bf16x8 (&qf)[4]) {
    f32x16 s = {};
#pragma unroll
    for (int d0 = 0; d0 < 4; ++d0) s = __builtin_amdgcn_mfma_f32_32x32x16_bf16(kf[d0], qf[d0], s, 0, 0, 0);
    return s;
}
__device__ __forceinline__ void v_load(u32x4 (&vr)[4], const bf16* ubase, unsigned rowstride, int lane) {
#pragma unroll
    for (int i = 0; i < 4; ++i) { const unsigned c = lane + 64 * i; vr[i] = *(const u32x4*)(ubase + ((c >> 3) * rowstride + (c & 7) * 8u)); }
}
__device__ __forceinline__ void v_stage(LAS unsigned char* vb, const u32x4 (&vr)[4], int lane) {
#pragma unroll
    for (int i = 0; i < 4; ++i) { const int c = lane + 64 * i, key = c >> 3, ch = c & 7; *(LAS u32x4*)(vb + key * 128 + ((ch * 16) ^ (((key >> 1) & 1) << 6))) = vr[i]; }
}
__device__ __forceinline__ void pv_tile(f32x16 (&o)[2], LAS unsigned char* vb, const f32x16& p, int lane) {
    const int hi = lane >> 5, g1 = (lane >> 4) & 1, q4 = (lane & 15) >> 2, pp = lane & 3;
    bf16x8 pf[2];
#pragma unroll
    for (int s = 0; s < 2; ++s) { u32x4 w; w.x = pk2(p[8 * s + 0], p[8 * s + 1]); w.y = pk2(p[8 * s + 2], p[8 * s + 3]); w.z = pk2(p[8 * s + 4], p[8 * s + 5]); w.w = pk2(p[8 * s + 6], p[8 * s + 7]);
        pf[s] = __builtin_bit_cast(bf16x8, w); }
    const int swz = ((q4 >> 1) & 1) << 6;
#pragma unroll
    for (int dblk = 0; dblk < 2; ++dblk)
#pragma unroll
        for (int s = 0; s < 2; ++s) {
            const int colb = (dblk * 64 + g1 * 32 + pp * 8) ^ swz;
            const int row0 = 16 * s + 4 * hi + q4;
            const s16x4 t0 = __builtin_bit_cast(s16x4, __builtin_amdgcn_ds_read_tr16_b64_v4i16((LAS s16x4*)(vb + row0 * 128 + colb)));
            const s16x4 t1 = __builtin_bit_cast(s16x4, __builtin_amdgcn_ds_read_tr16_b64_v4i16((LAS s16x4*)(vb + (row0 + 8) * 128 + colb)));
            const bf16x8 a = (bf16x8){t0[0], t0[1], t0[2], t0[3], t1[0], t1[1], t1[2], t1[3]};
            o[dblk] = __builtin_amdgcn_mfma_f32_32x32x16_bf16(a, pf[s], o[dblk], 0, 0, 0);
        }
}
__device__ __forceinline__ void store_ot(bf16* rowp, const f32x16 (&o)[2], float sc, int hi) {
#pragma unroll
    for (int dblk = 0; dblk < 2; ++dblk)
#pragma unroll
        for (int p = 0; p < 2; ++p) {
            const unsigned x0 = pk2(o[dblk][8 * p] * sc, o[dblk][8 * p + 1] * sc), x1 = pk2(o[dblk][8 * p + 2] * sc, o[dblk][8 * p + 3] * sc);
            const unsigned y0 = pk2(o[dblk][8 * p + 4] * sc, o[dblk][8 * p + 5] * sc), y1 = pk2(o[dblk][8 * p + 6] * sc, o[dblk][8 * p + 7] * sc);
            const auto s0 = __builtin_amdgcn_permlane32_swap(x0, y0, false, false), s1 = __builtin_amdgcn_permlane32_swap(x1, y1, false, false);
            u32x4 w; w.x = s0[0]; w.y = s1[0]; w.z = s0[1]; w.w = s1[1];
            *(u32x4*)(rowp + dblk * 32 + 16 * p + 8 * hi) = w; }
}
struct DilGeo { size_t rowb, kstride; int h12, dil, r, i0; };
__device__ __forceinline__ DilGeo dil_geo(int item) {
    DilGeo g; const int b = item / 1536, rem = item % 1536, ch = rem & 127; g.h12 = rem >> 7;
    const int gg = g.h12 >> 2, ncl = 7 - 2 * gg; g.dil = 1 << (2 * gg); g.r = ch >> ncl; g.i0 = 32 * (ch & ((1 << ncl) - 1));
    g.rowb = (size_t)b * SEQ; g.kstride = (size_t)g.dil * 64; return g;
}
__device__ __forceinline__ void dil_load_qk(const bf16* QKV, const DilGeo& g, bf16x8 (&qf)[4], bf16x8 (&kf)[5][4], int lane) {
    const int q = lane & 31, hi = lane >> 5;
    ld_frag4(qf, QKV + ((size_t)g.h12 * M + g.rowb + (size_t)g.i0 * g.dil + g.r) * 64, (unsigned)g.kstride, lane);
#pragma unroll
    for (int kt = 0; kt < 5; ++kt) { const int ib = g.i0 - 128 + 32 * kt, ibc = ib < 0 ? 0 : ib; ld_frag4(kf[kt], QKV + ((size_t)(12 + g.h12) * M + g.rowb + (size_t)ibc * g.dil + g.r) * 64, (unsigned)g.kstride, lane); }
}
__device__ __forceinline__ void dil_vload(const bf16* QKV, const DilGeo& g, u32x4 (&vr)[4], int kt, int lane) {
    const int ib = g.i0 - 128 + 32 * kt, ibc = ib < 0 ? 0 : ib;
    v_load(vr, QKV + ((size_t)(24 + g.h12) * M + g.rowb + g.r) * 64 + (size_t)ibc * g.kstride, (unsigned)g.kstride, lane);
}
__device__ __forceinline__ void pv_tile_p(f32x16 (&o)[2], LAS unsigned char* vb, const bf16x8 (&pf)[2], int lane) {
    const int hi = lane >> 5, g1 = (lane >> 4) & 1, q4 = (lane & 15) >> 2, pp = lane & 3;
    const int swz = ((q4 >> 1) & 1) << 6;
#pragma unroll
    for (int dblk = 0; dblk < 2; ++dblk)
#pragma unroll
        for (int s = 0; s < 2; ++s) {
            const int colb = (dblk * 64 + g1 * 32 + pp * 8) ^ swz;
            const int row0 = 16 * s + 4 * hi + q4;
            const s16x4 t0 = __builtin_bit_cast(s16x4, __builtin_amdgcn_ds_read_tr16_b64_v4i16((LAS s16x4*)(vb + row0 * 128 + colb)));
            const s16x4 t1 = __builtin_bit_cast(s16x4, __builtin_amdgcn_ds_read_tr16_b64_v4i16((LAS s16x4*)(vb + (row0 + 8) * 128 + colb)));
            const bf16x8 a = (bf16x8){t0[0], t0[1], t0[2], t0[3], t1[0], t1[1], t1[2], t1[3]};
            o[dblk] = __builtin_amdgcn_mfma_f32_32x32x16_bf16(a, pf[s], o[dblk], 0, 0, 0);
        }
}
__device__ __forceinline__ void dil_items(const bf16* QKV, bf16* OD3, float* LSE, LAS unsigned char* vb, int first, int stride, int lane) {
    int it = first; if (it >= 6144) return;
    const int q = lane & 31, hi = lane >> 5;
    DilGeo g = dil_geo(__builtin_amdgcn_readfirstlane(it));
    for (;;) {
        bf16x8 qf[4], kf[5][4];
        dil_load_qk(QKV, g, qf, kf, lane);
        u32x4 vr[5][4];
#pragma unroll
        for (int kt = 0; kt < 5; ++kt) dil_vload(QKV, g, vr[kt], kt, lane);
        bf16x8 pf[5][2]; float mx = -INFINITY, l = 0.f;
        {
            f32x16 s[5];
#pragma unroll
            for (int kt = 0; kt < 5; ++kt) {
                s[kt] = qk_tile(kf[kt], qf);
                if (g.i0 - 128 + 32 * kt < 0) {
#pragma unroll
                    for (int rr = 0; rr < 16; ++rr) s[kt][rr] = -INFINITY;
                }
            }
#pragma unroll
            for (int rr = 0; rr < 16; ++rr) { const int kk = crow(rr, hi); if (kk < q) s[0][rr] = -INFINITY; if (kk > q) s[4][rr] = -INFINITY; }
#pragma unroll
            for (int kt = 0; kt < 5; ++kt)
#pragma unroll
                for (int rr = 0; rr < 16; ++rr) mx = fmaxf(mx, s[kt][rr]);
            { const F2 t = pair32(mx); mx = fmaxf(t.a, t.b); }
            const float mb = mx * LOG2E;
#pragma unroll
            for (int kt = 0; kt < 5; ++kt) {
#pragma unroll
                for (int rr = 0; rr < 16; ++rr) { const float p = __builtin_amdgcn_exp2f(__builtin_fmaf(s[kt][rr], LOG2E, -mb)); s[kt][rr] = p; l += p; }
#pragma unroll
                for (int h2 = 0; h2 < 2; ++h2) { u32x4 w; w.x = pk2(s[kt][8 * h2 + 0], s[kt][8 * h2 + 1]); w.y = pk2(s[kt][8 * h2 + 2], s[kt][8 * h2 + 3]); w.z = pk2(s[kt][8 * h2 + 4], s[kt][8 * h2 + 5]); w.w = pk2(s[kt][8 * h2 + 6], s[kt][8 * h2 + 7]);
                    pf[kt][h2] = __builtin_bit_cast(bf16x8, w); }
            }
            { const F2 t = pair32(l); l = t.a + t.b; }
        }
        const int itn = it + stride; const bool more = itn < 6144;
        const DilGeo gn = dil_geo(__builtin_amdgcn_readfirstlane(more ? itn : it));
        f32x16 o[2]; o[0] = f32x16{}; o[1] = f32x16{};
#pragma unroll
        for (int kt = 0; kt < 5; ++kt) {
            LDS_WAIT();
            v_stage(vb, vr[kt], lane);
            LDS_WAIT();
            pv_tile_p(o, vb, pf[kt], lane);
        }
        const float inv = 1.0f / l;
        const size_t tok = g.rowb + (size_t)(g.i0 + q) * g.dil + g.r;
        store_ot(OD3 + (g.rowb + (size_t)g.i0 * g.dil + g.r) * 768 + g.h12 * 64 + (unsigned)q * (unsigned)(g.dil * 768), o, inv, hi);
        if (hi == 0) LSE[tok * 12 + g.h12] = mx + __logf(l);
        if (!more) break;
        it = itn; g = gn;
    }
}
__device__ __forceinline__ void sb_step(f32x16 (&o)[2], float& R, const bf16x8 (&kf)[4], const bf16x8 (&qf)[4], const u32x4 (&vr)[4], LAS unsigned char* vb, int dq, int lane) {
    const int hi = lane >> 5;
    f32x16 z = qk_tile(kf, qf);
    float gp[4];
#pragma unroll
    for (int c4 = 0; c4 < 4; ++c4) {
        float be[4], ke[4];
#pragma unroll
        for (int i = 0; i < 4; ++i) { const float zz = z[4 * c4 + i]; const float e = __builtin_amdgcn_exp2f(-fabsf(zz) * LOG2E); const float rr = __builtin_amdgcn_rcpf(1.0f + e), sm = e * rr;
            const bool pos = zz >= 0.f; const bool past = (8 * c4 + 4 * hi + i) < dq;
            be[i] = past ? (pos ? rr : sm) : 0.f; ke[i] = past ? (pos ? sm : rr) : 1.f; }
        const float e2 = ke[3], e1 = e2 * ke[2], e0 = e1 * ke[1];
        gp[c4] = e0 * ke[0];
        z[4 * c4 + 3] = be[3]; z[4 * c4 + 2] = be[2] * e2; z[4 * c4 + 1] = be[1] * e1; z[4 * c4 + 0] = be[0] * e0;
    }
    float U = R;
#pragma unroll
    for (int c4 = 3; c4 >= 0; --c4) {
        const F2 t = pair32(gp[c4]);
        const float T = (hi == 0) ? U * t.b : U;
#pragma unroll
        for (int i = 0; i < 4; ++i) z[4 * c4 + i] *= T;
        U *= t.a * t.b;
    }
    R = U;
    LDS_WAIT();
    v_stage(vb, vr, lane);
    LDS_WAIT();
    pv_tile(o, vb, z, lane);
}
__device__ __forceinline__ void sb_item(const bf16* QKV, bf16* OS, LAS unsigned char* vb, int bh, int c, int lane) {
    const int b = bh >> 2, h = bh & 3, q = lane & 31, hi = lane >> 5;
    const size_t rowb = (size_t)b * SEQ;
    const bf16* Qp = QKV + ((size_t)(36 + h) * M + rowb + 32 * c) * 64;
    const bf16* Kb = QKV + ((size_t)(40 + h) * M + rowb) * 64;
    const bf16* Vb = QKV + ((size_t)(44 + h) * M + rowb) * 64;
    bf16x8 qf[4]; ld_frag4(qf, Qp, 64, lane);
    f32x16 o[2]; o[0] = f32x16{}; o[1] = f32x16{};
    float R = 1.0f;
    bf16x8 kf[3][4]; u32x4 vr[3][4];
#pragma unroll
    for (int j = 0; j < 3; ++j) { const int t = (c - j) < 0 ? 0 : (c - j); ld_frag4(kf[j], Kb + (size_t)(32 * t) * 64, 64, lane); v_load(vr[j], Vb + (size_t)(32 * t) * 64, 64, lane); }
#if SB_EARLY_EXIT
#define SB_DONE() (__all(R < 1e-20f))
#else
#define SB_DONE() (false)
#endif
#define SB_STEP(j, kt_) do { sb_step(o, R, kf[j], qf, vr[j], vb, 32 * (c - (kt_)) + q, lane); \
        { const int t = (kt_) - 3 < 0 ? 0 : (kt_) - 3; ld_frag4(kf[j], Kb + (size_t)(32 * t) * 64, 64, lane); v_load(vr[j], Vb + (size_t)(32 * t) * 64, 64, lane); } } while (0)
    for (int kt = c; kt >= 0; kt -= 3) {
        SB_STEP(0, kt); if (kt - 1 < 0 || SB_DONE()) break;
        SB_STEP(1, kt - 1); if (kt - 2 < 0 || SB_DONE()) break;
        SB_STEP(2, kt - 2); if (SB_DONE()) break;
    }
#undef SB_STEP
#undef SB_DONE
    store_ot(OS + (rowb + 32 * c) * 256 + h * 64 + (unsigned)q * 256u, o, 1.0f, hi);
}
__device__ __forceinline__ void attn_phase(unsigned char* Pws, unsigned char* Pscr, LAS unsigned char* lds, int G, int wg, int NGW, int wave, int lane) {
    LAS unsigned char* vb = lds + wave * 4096;
    const bf16* QKV = (const bf16*)(Pws + WS_R);
    const int v = (G % 8 == 0) ? (wg % 8) * (G / 8) + wg / 8 : wg;
    const int base = v * NWAVES + wave;
    for (int it = base; it < 2048; it += NGW) { const int itu = __builtin_amdgcn_readfirstlane(it);
#if SB_EARLY_EXIT
        sb_item(QKV, (bf16*)(Pws + WS_OS), vb, itu >> 7, itu & 127, lane);
#else
        sb_item(QKV, (bf16*)(Pws + WS_OS), vb, itu >> 7, ((itu & 127) + 16 * (itu >> 8)) & 127, lane);
#endif
    }
    dil_items(QKV, (bf16*)(Pscr + OUT_OD3), (float*)(Pws + WS_LSE), vb, base, NGW, lane);
}
__device__ __forceinline__ void merge_phase(unsigned char* Pws, unsigned char* Pscr, int idx_lo, int idx_hi, int first, int stride) {
    const bf16* OD3 = (const bf16*)(Pscr + OUT_OD3); bf16* OD = (bf16*)(Pscr + OUT_OD); const float* LSE = (const float*)(Pws + WS_LSE);
    const __amdgpu_buffer_rsrc_t odr = __builtin_amdgcn_make_buffer_rsrc(OD, 0, M * 256 * 2, 0x00020000);
    for (int idx = idx_lo + first; idx < idx_hi; idx += stride) {
        const int t = idx >> 5, hh = (idx >> 3) & 3, ch = idx & 7;
        const float l0 = LSE[(size_t)t * 12 + hh], l1 = LSE[(size_t)t * 12 + 4 + hh], l2 = LSE[(size_t)t * 12 + 8 + hh];
        const float mx = fmaxf(l0, fmaxf(l1, l2)); float e0 = __expf(l0 - mx), e1 = __expf(l1 - mx), e2 = __expf(l2 - mx); const float inv = 1.0f / (e0 + e1 + e2);
        e0 *= inv; e1 *= inv; e2 *= inv;
        const u32x4 a = *(const u32x4*)(OD3 + (size_t)t * 768 + hh * 64 + ch * 8), bq = *(const u32x4*)(OD3 + (size_t)t * 768 + (4 + hh) * 64 + ch * 8), cq = *(const u32x4*)(OD3 + (size_t)t * 768 + (8 + hh) * 64 + ch * 8);
        u32x4 o;
#pragma unroll
        for (int k = 0; k < 4; ++k) {
            const float lo = e0 * __uint_as_float(a[k] << 16) + e1 * __uint_as_float(bq[k] << 16) + e2 * __uint_as_float(cq[k] << 16);
            const float hi = e0 * __uint_as_float(a[k] & 0xffff0000u) + e1 * __uint_as_float(bq[k] & 0xffff0000u) + e2 * __uint_as_float(cq[k] & 0xffff0000u);
            o[k] = pk2(lo, hi);
        }
        __builtin_amdgcn_raw_buffer_store_b128(o, odr, (unsigned)(t * 256 + hh * 64 + ch * 8) * 2u, 0,   16);
    }
}
__device__ __forceinline__ void merge_quarter(unsigned char* Pws, unsigned char* Pscr, int idx_lo, int tid) {
    const bf16* OD3 = (const bf16*)(Pscr + OUT_OD3); bf16* OD = (bf16*)(Pscr + OUT_OD); const float* LSE = (const float*)(Pws + WS_LSE);
    const __amdgpu_buffer_rsrc_t odr = __builtin_amdgcn_make_buffer_rsrc(OD, 0, M * 256 * 2, 0x00020000);
    float ls[4][3]; u32x4 v[4][3];
#pragma unroll
    for (int j = 0; j < 4; ++j) { const unsigned idx = (unsigned)(idx_lo + tid + 512 * j), t = idx >> 5, hh = (idx >> 3) & 3, ch = idx & 7;
#pragma unroll
        for (int g = 0; g < 3; ++g) { ls[j][g] = LSE[t * 12u + 4u * g + hh]; v[j][g] = *(const u32x4*)(OD3 + (t * 768u + (4u * g + hh) * 64u + ch * 8u)); } }
#pragma unroll
    for (int j = 0; j < 4; ++j) { const unsigned idx = (unsigned)(idx_lo + tid + 512 * j), t = idx >> 5, hh = (idx >> 3) & 3, ch = idx & 7;
        const float mx = fmaxf(ls[j][0], fmaxf(ls[j][1], ls[j][2])); float e0 = __expf(ls[j][0] - mx), e1 = __expf(ls[j][1] - mx), e2 = __expf(ls[j][2] - mx); const float inv = 1.0f / (e0 + e1 + e2);
        e0 *= inv; e1 *= inv; e2 *= inv;
        u32x4 o;
#pragma unroll
        for (int k = 0; k < 4; ++k) {
            const float lo = e0 * __uint_as_float(v[j][0][k] << 16) + e1 * __uint_as_float(v[j][1][k] << 16) + e2 * __uint_as_float(v[j][2][k] << 16);
            const float hi = e0 * __uint_as_float(v[j][0][k] & 0xffff0000u) + e1 * __uint_as_float(v[j][1][k] & 0xffff0000u) + e2 * __uint_as_float(v[j][2][k] & 0xffff0000u);
            o[k] = pk2(lo, hi);
        }
        __builtin_amdgcn_raw_buffer_store_b128(o, odr, (t * 256u + hh * 64u + ch * 8u) * 2u, 0,   16); }
}
__device__ __forceinline__ void panel_arrive(unsigned* cnt, int pm, int wave, int lane) {
    asm volatile("s_waitcnt vmcnt(0)" ::: "memory");
    __syncthreads();
    if (wave == 0 && lane == 0) __hip_atomic_fetch_add(cnt + 64 * pm, 1u, __ATOMIC_RELAXED, __HIP_MEMORY_SCOPE_AGENT);
}
__device__ __forceinline__ void panel_sync(unsigned* cnt, int pm, int wave, int lane) {
    asm volatile("s_waitcnt vmcnt(0)" ::: "memory");
    __syncthreads();
    if (wave == 0) {
        if (lane == 0) __hip_atomic_fetch_add(cnt + 64 * pm, 1u, __ATOMIC_RELAXED, __HIP_MEMORY_SCOPE_AGENT);
        unsigned spins = 0;
        while ((unsigned)__builtin_amdgcn_readfirstlane(__hip_atomic_load(cnt + 64 * pm, __ATOMIC_RELAXED, __HIP_MEMORY_SCOPE_AGENT)) < 4u) { __builtin_amdgcn_s_sleep(1); if (++spins > (1u << 20)) break; }
        __builtin_amdgcn_fence(__ATOMIC_ACQUIRE, "agent"); }
    asm volatile("s_waitcnt vmcnt(0) lgkmcnt(0)" ::: "memory"); __syncthreads();
}
__device__ __forceinline__ void final_phase(unsigned char* Pws, float* Pout, const float* Pnf, int gw, int NGW, int lane) {
    const float* ssqp = (const float*)(Pws + WS_SSQ); const f32x4* gf = (const f32x4*)Pnf + 2 * lane; const bf16* xb = (const bf16*)(Pws + WS_XB);
    for (int m = gw; m < M; m += NGW) {
        const float rs = pg8::row_rstd(ssqp, m);
        const u32x4* xr = (const u32x4*)(xb + (size_t)m * D) + lane; f32x4* orow = (f32x4*)(Pout + (size_t)m * D) + 2 * lane;
#pragma unroll
        for (int j = 0; j < 2; ++j) { const u32x4 w = xr[64 * j];
            const f32x4 v0 = {__uint_as_float(w.x << 16), __uint_as_float(w.x & 0xffff0000u), __uint_as_float(w.y << 16), __uint_as_float(w.y & 0xffff0000u)};
            const f32x4 v1 = {__uint_as_float(w.z << 16), __uint_as_float(w.z & 0xffff0000u), __uint_as_float(w.w << 16), __uint_as_float(w.w & 0xffff0000u)};
            orow[128 * j] = v0 * rs * gf[128 * j]; orow[128 * j + 1] = v1 * rs * gf[128 * j + 1]; }
    }
}

struct Args { const float* in[15]; float* out; unsigned char* ws; int ph_lo, ph_hi; };
constexpr int N_PHASES = 10 * DEPTH + 1;
__global__ void __launch_bounds__(NWAVES * 64, 2) fwd_megakernel(Args args) {
    extern __shared__ __attribute__((aligned(16))) unsigned char lds_raw[];
    LAS unsigned char* lds = (LAS unsigned char*)lds_raw;
    cg::grid_group grid = cg::this_grid();
    volatile LAS unsigned* bst = (volatile LAS unsigned*)(lds + 131072);
    if (threadIdx.x < 2) bst[threadIdx.x] = 0u;
    __syncthreads();
    (void)xcd_barrier_post((unsigned*)(args.ws + WS_BAR), bst);
    for (int ph = args.ph_lo; ph < args.ph_hi; ++ph) {
        const __attribute__((address_space(4))) unsigned char* ka = (const __attribute__((address_space(4))) unsigned char*)__builtin_amdgcn_kernarg_segment_ptr();
        asm volatile("" : "+s"(ka));
#define KARG(i) (*(const float* const __attribute__((address_space(4)))*)(ka + 8 * (i)))
        const float* Px = KARG(0); float* Pout = (float*)KARG(15); unsigned char* ws = (unsigned char*)KARG(16);
        int tid = threadIdx.x, G = gridDim.x, wg = blockIdx.x; asm volatile("" : "+v"(tid), "+s"(G), "+s"(wg));
        const int lane = tid & 63, wave = __builtin_amdgcn_readfirstlane(tid >> 6);
        const int gw = wave * G + wg, NGW = G * NWAVES;
        const int gtid = wg * (NWAVES * 64) + tid, NT = G * NWAVES * 64;
        unsigned char* wsw = ws + WS_W;
        float* ssqp = (float*)(ws + WS_SSQ);
        bf16* XB = (bf16*)(ws + WS_XB); bf16* H = (bf16*)(ws + WS_R); bf16* QKV = (bf16*)(ws + WS_R); bf16* GATE = (bf16*)(ws + WS_GATE);
        const int l = ph / 10, k = (ph == N_PHASES - 1) ? 10 : ph % 10;
        const bool fuse_final = (G == 256);
        if (k == 10 && fuse_final) continue;
        const bool chain = (G == 256);
        if ((k == 6 || k == 7) && chain) continue;
        if (k == 0 && l > 0) continue;
        unsigned char* dA1 = (unsigned char*)Pout + 32 * MiB;
        unsigned char* wA = (l == 0) ? wsw : dA1;
        if (k == 0) {
            { const ConvSrc CS{KARG(1), KARG(2), KARG(3), KARG(4), KARG(5), KARG(6), KARG(7), KARG(8), KARG(9), KARG(10), KARG(11), KARG(12), KARG(13)}; conv_phase(Px, CS, ws, l, lds, gw, NGW, wave, lane); }
        }
        else if (k == 1 || k == 8) {
            pg8::Gemm g{XB, (const bf16*)(k == 1 ? wA + W_1CAT : wsw + W_2CAT), M, 2 * FF, D}; pg8::StaticOrder S; S.init(M, 2 * FF, G, wg);
            { const LAS float* rsl_c = (const LAS float*)(lds + RSL_OFF); LAS float* rsl_w = (LAS float*)(lds + RSL_OFF); pg8::Unit uu;
#pragma unroll 1
              for (int i = 0; i < pg8::RSL_UNITS; ++i) if (S.next(i, uu) && tid < 256) rsl_w[i * 256 + tid] = pg8::row_rstd(ssqp, uu.pm * 256 + tid);
              __syncthreads(); (void)rsl_c; }
            pg8::EpiSwiglu E{H, ssqp, (const LAS float*)(lds + RSL_OFF)};
            pg8::gemm_phase<pg8::EpiSwiglu, pg8::StaticOrder, true, true>(lds, g, S, E);
            if ((l == 0) || (k == 1)) {
                const int rem = ((M / 256) * (2 * FF / 256)) % G; const bool idle = (rem == 0) || (wg >= rem);
                if (idle) {
                    const int nidle = (rem == 0) ? G : G - rem, iw = (rem == 0) ? wg : wg - rem;
                    const ConvSrc CS{KARG(1), KARG(2), KARG(3), KARG(4), KARG(5), KARG(6), KARG(7), KARG(8), KARG(9), KARG(10), KARG(11), KARG(12), KARG(13)};
                    const int lo = (l == 0) ? (k == 1 ? 0 : CI_IN) : CI_B, hi = (l == 0) ? (k == 1 ? CI_IN : CI_B) : CI_END;
                    conv_items(CS, 1, lo, hi, dA1, wsw, lds, wave * nidle + iw, nidle * NWAVES, wave, lane);
                }
            }
        } else if (k == 2 || k == 9) {
            pg8::Gemm g{H, (const bf16*)(k == 2 ? wA + W_D1 : wsw + W_D2), M, D, FF}; pg8::StaticOrder S; S.init(M, D, G, wg);
            if (ph == 2) { pg8::EpiResid<true> E{Px, XB, ssqp, 0.5f}; pg8::gemm_phase<pg8::EpiResid<true>, pg8::StaticOrder, true, true>(lds, g, S, E); }
            else if (ph == N_PHASES - 2 && fuse_final) { pg8::EpiResidFinal E{XB, Pout, KARG(14), (unsigned*)(ws + WS_XSLOT), (unsigned*)(ws + WS_CNT), 0.5f};
                pg8::gemm_phase<pg8::EpiResidFinal, pg8::StaticOrder, true, true>(lds, g, S, E); }
            else { pg8::EpiResid<false> E{nullptr, XB, ssqp, 0.5f}; pg8::gemm_phase<pg8::EpiResid<false>, pg8::StaticOrder, true, true>(lds, g, S, E); }
        } else if (k == 3) {
            pg8::Gemm g{XB, (const bf16*)(wA + W_IN), M, NIN, D}; pg8::StaticOrder S; S.init(M, NIN, G, wg);
            { const LAS float* rsl_c = (const LAS float*)(lds + RSL_OFF); LAS float* rsl_w = (LAS float*)(lds + RSL_OFF); pg8::Unit uu;
#pragma unroll 1
              for (int i = 0; i < pg8::RSL_UNITS; ++i) if (S.next(i, uu) && tid < 256) rsl_w[i * 256 + tid] = pg8::row_rstd(ssqp, uu.pm * 256 + tid);
              __syncthreads(); (void)rsl_c; }
            pg8::EpiWin E{QKV, GATE, ssqp, (const float*)(ws + WS_ROPE), (const LAS float*)(lds + RSL_OFF)};
            pg8::gemm_phase<pg8::EpiWin, pg8::StaticOrder, true, true>(lds, g, S, E);
        } else if (k == 4) {
            attn_phase(ws, (unsigned char*)Pout, lds, G, wg, NGW, wave, lane);
        }
        else if (k == 5) {
            pg8::Unit pu; { pg8::StaticOrder S; S.init(M, D, G, wg); S.next(0, pu); }
            unsigned* pcnt = (unsigned*)(ws + WS_PCNT) + (size_t)l * 2 * 4096;
            if (chain) { const int r0 = pu.pm * 256 + pu.pn * 64; merge_quarter(ws, (unsigned char*)Pout, r0 * 32, tid); panel_arrive(pcnt, pu.pm, wave, lane); }
            else merge_phase(ws, (unsigned char*)Pout, 0, M * 32, gtid, NT);
            if (chain) {
                int K256 = 256; asm volatile("" : "+s"(K256));
                { pg8::Gemm g{(const bf16*)(ws + WS_OS), (const bf16*)(wsw + W_PS), M, D, K256, (const bf16*)((unsigned char*)Pout + OUT_OD), (const bf16*)(wsw + W_PD)}; pg8::PairOrder S; S.init(M, D, G, wg); S.cnt = pcnt;
                  pg8::EpiGate2 E{GATE, (bf16*)(ws + WS_Y1), (bf16*)(ws + WS_Y)};
                  pg8::gemm_phase<pg8::EpiGate2, pg8::PairOrder, true, true>(lds, g, S, E); }
                panel_sync(pcnt + 4096, pu.pm, wave, lane);
                { pg8::Gemm g{(const bf16*)(ws + WS_Y), (const bf16*)(wsw + W_OUT), M, D, D}; pg8::StaticOrder S; S.init(M, D, G, wg);
                  pg8::EpiResid<false> E{nullptr, XB, ssqp, 1.0f};
                  pg8::gemm_phase<pg8::EpiResid<false>, pg8::StaticOrder, true, true>(lds, g, S, E); }
            }
        }
        else if (k == 6) {
            int K256 = 256; asm volatile("" : "+s"(K256));
            { pg8::Gemm g{(const bf16*)((unsigned char*)Pout + OUT_OD), (const bf16*)(wsw + W_PD), M, D, K256}; pg8::StaticOrder S; S.init(M, D, G, wg);
              pg8::EpiGate<false> E{GATE, (bf16*)(ws + WS_Y1), (bf16*)(ws + WS_Y)};
              pg8::gemm_phase<pg8::EpiGate<false>, pg8::StaticOrder, true, true>(lds, g, S, E); }
            { pg8::Gemm g{(const bf16*)(ws + WS_OS), (const bf16*)(wsw + W_PS), M, D, K256}; pg8::StaticOrder S; S.init(M, D, G, wg);
              pg8::EpiGate<true> E{GATE + 1024, (bf16*)(ws + WS_Y1), (bf16*)(ws + WS_Y)};
              pg8::gemm_phase<pg8::EpiGate<true>, pg8::StaticOrder, true, true>(lds, g, S, E); }
        } else if (k == 7) {
            pg8::Gemm g{(const bf16*)(ws + WS_Y), (const bf16*)(wsw + W_OUT), M, D, D}; pg8::StaticOrder S; S.init(M, D, G, wg);
            pg8::EpiResid<false> E{nullptr, XB, ssqp, 1.0f};
            pg8::gemm_phase<pg8::EpiResid<false>, pg8::StaticOrder, true, true>(lds, g, S, E);
        } else final_phase(ws, Pout, KARG(14), gw, NGW, lane);
        if (ph + 1 < args.ph_hi && !(fuse_final && ph == N_PHASES - 2)) {
            unsigned* barw = (unsigned*)(ws + WS_BAR);
            if (args.ph_hi > 1000) grid.sync();
            { XcdBarrier bar; bar.bar = barw; bar.x = xb_xcc_id(); bar.st = bst; xcd_barrier(bar);
            }
        }
    }
}

extern "C" void kernel_launch(void* const* d_in, const int* in_sizes, int n_in, void* d_out, int out_size, void* d_ws, size_t ws_size, hipStream_t stream) {
    static int grid = 0;
    if (grid == 0) {
        if (n_in != 15 || in_sizes[0] != M * D || out_size != M * D || ws_size < WS_END) { fprintf(stderr, "kernel_launch: unexpected shapes (n_in %d, in0 %d, out %d, ws %zu)\n", n_in, n_in > 0 ? in_sizes[0] : -1, out_size, ws_size); grid = -1; return; }
        int dev = 0, cus = 0, per_cu = 0;
        if (hipGetDevice(&dev) != hipSuccess || hipDeviceGetAttribute(&cus, hipDeviceAttributeMultiprocessorCount, dev) != hipSuccess) { grid = -1; return; }
        if (hipFuncSetAttribute((const void*)fwd_megakernel, hipFuncAttributeMaxDynamicSharedMemorySize, LDS_BYTES) != hipSuccess) { fprintf(stderr, "kernel_launch: hipFuncSetAttribute failed\n"); grid = -1; return; }
        if (hipOccupancyMaxActiveBlocksPerMultiprocessor(&per_cu, (const void*)fwd_megakernel, NWAVES * 64, LDS_BYTES) != hipSuccess || per_cu < 1) { fprintf(stderr, "kernel_launch: occupancy query says %d\n", per_cu); per_cu = 1; }
        (void)hipGetLastError();
        grid = cus;
        if (grid < 176) { fprintf(stderr, "kernel_launch: %d CUs: the per-workgroup rstd table holds 8 units per GEMM phase (needs >= 176 workgroups)\n", grid); grid = -1; return; }
    }
    if (grid < 0) return;
    Args a{};
    for (int i = 0; i < 15; ++i) a.in[i] = (const float*)d_in[i];
    a.out = (float*)d_out; a.ws = (unsigned char*)d_ws;
#if N_LAUNCH_MODE == 0
    a.ph_lo = 0; a.ph_hi = N_PHASES;
    if (hipMemsetAsync((char*)d_ws + WS_BAR, 0, WS_ZERO_BYTES, stream) != hipSuccess) { fprintf(stderr, "kernel_launch: memset of the barrier words failed\n"); return; }
    void* kargs[] = {&a};
    const hipError_t e = hipLaunchCooperativeKernel((const void*)fwd_megakernel, dim3(grid), dim3(NWAVES * 64), kargs, LDS_BYTES, stream);
    if (e != hipSuccess) fprintf(stderr, "kernel_launch: cooperative launch failed: %s (grid %d)\n", hipGetErrorString(e), grid);
#else
    for (int ph = 0; ph < N_PHASES; ++ph) {
        a.ph_lo = ph; a.ph_hi = ph + 1;
        hipLaunchKernelGGL(fwd_megakernel, dim3(grid), dim3(NWAVES * 64), LDS_BYTES, stream, a);
    }
#endif
}
```

```cpp
#include <hip/hip_runtime.h>
#include <hip/hip_cooperative_groups.h>
#include <cstdio>
#include <cstdint>
namespace cg = cooperative_groups;
namespace pg8 {
#define PG8_LAS __attribute__((address_space(3)))
typedef unsigned short bf16_t;
typedef short bf16x8 __attribute__((ext_vector_type(8)));
typedef float f32x4 __attribute__((ext_vector_type(4)));
typedef unsigned u32x4 __attribute__((ext_vector_type(4)));
constexpr int BM = 256, BK = 64, HALF = 128, HTB = HALF * BK * 2  , STAGE_BYTES = 8 * HTB, NXCD = 8, WGM = 8;

__host__ __device__ __forceinline__ int lds_byte(int r, int c) { const int st = (r >> 4) * 2 + (c >> 5), rr = r & 15, cc = c & 31, ob = rr * 64 + cc * 2; return st * 1024 + (ob ^ (((ob >> 9) & 1) << 5)); }
__host__ __device__ __forceinline__ void stage_rc(int b, int& R, int& C) { const int st = b / 1024, sb = b % 1024, swz = sb ^ (((sb >> 9) & 1) << 5); R = (st >> 1) * 16 + swz / 64; C = (st & 1) * 32 + (swz % 64) / 2; }
__host__ __device__ __forceinline__ int perm32(int rho) { const int n = rho >> 4, i = rho & 15; return 8 * (i >> 2) + 4 * n + (i & 3); }

struct Unit { int pm, pn, ui, sel; };
struct Gemm { const bf16_t* A; const bf16_t* Bt; int M, N, K; const bf16_t* A2 = nullptr; const bf16_t* Bt2 = nullptr; };

struct StaticOrder {
    int nM, nN, nwg, G, c;
    __host__ __device__ void init(int M, int N, int G_, int c_) { nM = M / BM; nN = N / BM; nwg = nM * nN; G = G_; c = c_; }
    __host__ __device__ bool next(int i, Unit& u) const {
        const long L = (long)i * G + c; if (L >= nwg) return false;
        int wgid = (int)L; { const int q = nwg / NXCD, r = nwg % NXCD, xcd = wgid % NXCD, off = wgid / NXCD; wgid = (xcd < r ? xcd * (q + 1) : r * (q + 1) + (xcd - r) * q) + off; }
        const int nig = WGM * nN, gid = wgid / nig, fm = gid * WGM, gsz = (nM - fm) < WGM ? (nM - fm) : WGM;
        u.pm = fm + ((wgid % nig) % gsz); u.pn = (wgid % nig) / gsz; u.ui = i; u.sel = 0; return true;
    }
    __device__ __forceinline__ void a_ready(const Unit&) const {}
    __device__ __forceinline__ void done(const Unit&) const {}
};
struct PairOrder : StaticOrder {
    unsigned* cnt;
    __host__ __device__ bool next(int i, Unit& u) const { if (i >= 2) return false; if (!StaticOrder::next(0, u)) return false; u.ui = i; u.sel = i; return true; }
    __device__ __forceinline__ void a_ready(const Unit& u) const {
        if (u.sel == 1 && cnt != nullptr) {
            if (threadIdx.x < 64) { unsigned spins = 0;
                while ((unsigned)__builtin_amdgcn_readfirstlane(__hip_atomic_load(cnt + 64 * u.pm, __ATOMIC_RELAXED, __HIP_MEMORY_SCOPE_AGENT)) < 4u) { __builtin_amdgcn_s_sleep(1); if (++spins > (1u << 20)) break; }
                __builtin_amdgcn_fence(__ATOMIC_ACQUIRE, "agent");
                asm volatile("s_waitcnt vmcnt(0)" ::: "memory"); }
            asm volatile("" ::: "memory"); __builtin_amdgcn_s_barrier(); asm volatile("" ::: "memory");
        }
    }
};

typedef float f32x2_cv __attribute__((ext_vector_type(2))); typedef __bf16 bf16x2_cv __attribute__((ext_vector_type(2)));
__device__ __forceinline__ unsigned cvt_pk_bf16(float lo, float hi) { const f32x2_cv v = {lo, hi}; const bf16x2_cv b = __builtin_convertvector(v, bf16x2_cv); return __builtin_bit_cast(unsigned, b); }
typedef unsigned u32x2 __attribute__((ext_vector_type(2)));
constexpr float LOG2E = 1.4426950408889634f;
constexpr int RSL_UNITS = 8;
__device__ __forceinline__ float row_rstd(const float* ssqp, int r) {
    const f32x4* p = (const f32x4*)(ssqp + (size_t)r * 16);
    const f32x4 a = p[0], b = p[1], c = p[2], d = p[3];
    const float s = (((a[0] + a[1]) + (a[2] + a[3])) + ((b[0] + b[1]) + (b[2] + b[3]))) + (((c[0] + c[1]) + (c[2] + c[3])) + ((d[0] + d[1]) + (d[2] + d[3])));
    return __builtin_amdgcn_rsqf(s * (1.0f / 1024.0f) + 1e-6f);
}
__device__ __forceinline__ float bf2f(unsigned short b) { return __uint_as_float(((unsigned)b) << 16); }
struct EpiSwiglu {
    static constexpr bool PERM = true, AFTER_DRAIN = false, HAS_INIT = false;
    bf16_t* H; const float* ssqp; const PG8_LAS float* rsl;
    __device__ __forceinline__ void operator()(const f32x4 (&acc)[2][2][4][2], const Unit& u, int wr, int wc, int fr, int fq) const {
        const int row0 = u.pm * BM + wr * 64 + fr, col0 = u.pn * 128 + wc * 32 + 8 * fq;
#pragma unroll
        for (int ai = 0; ai < 2; ++ai)
#pragma unroll
            for (int m = 0; m < 4; ++m) {
                const int r = row0 + ai * HALF + m * 16; const float rs = rsl[u.ui * 256 + ai * HALF + wr * 64 + m * 16 + fr];
                const float nrl = -rs * LOG2E, rs2 = rs * rs; f32x4 hq[2];
#pragma unroll
                for (int n = 0; n < 2; ++n) { const f32x4 ga = acc[ai][0][m][n], ua = acc[ai][1][m][n]; const f32x4 x = ga * nrl; f32x4 e;
                    e[0] = __builtin_amdgcn_exp2f(x[0]); e[1] = __builtin_amdgcn_exp2f(x[1]); e[2] = __builtin_amdgcn_exp2f(x[2]); e[3] = __builtin_amdgcn_exp2f(x[3]);
                    const f32x4 d = e + 1.0f; f32x4 rc; rc[0] = __builtin_amdgcn_rcpf(d[0]); rc[1] = __builtin_amdgcn_rcpf(d[1]); rc[2] = __builtin_amdgcn_rcpf(d[2]); rc[3] = __builtin_amdgcn_rcpf(d[3]);
                    hq[n] = (ga * ua) * (rc * rs2); }
                u32x4 w; w.x = cvt_pk_bf16(hq[0][0], hq[0][1]); w.y = cvt_pk_bf16(hq[0][2], hq[0][3]); w.z = cvt_pk_bf16(hq[1][0], hq[1][1]); w.w = cvt_pk_bf16(hq[1][2], hq[1][3]);
                *(u32x4*)(H + ((unsigned)r * 2816u + (unsigned)col0)) = w;
            }
    }
};
template <bool BASE32> struct EpiResid {
    static constexpr bool PERM = true, AFTER_DRAIN = false, HAS_INIT = true;
    const float* base32; bf16_t* xb; float* ssqp; float alpha;
    __device__ __forceinline__ void init(f32x4 (&acc)[2][2][4][2], const Unit& u, int wr, int wc, int fr, int fq) const {
        const unsigned row0 = u.pm * BM + wr * 64 + fr, col0 = u.pn * BM + wc * 32 + 8 * fq; const float ia = 1.0f / alpha;
#pragma unroll
        for (int ai = 0; ai < 2; ++ai)
#pragma unroll
            for (int m = 0; m < 4; ++m)
#pragma unroll
                for (int bj = 0; bj < 2; ++bj) { const unsigned off = (row0 + ai * HALF + m * 16) * 1024u + col0 + bj * HALF;
                    f32x4 b0, b1;
                    if (BASE32) { b0 = *(const f32x4*)(base32 + off); b1 = *(const f32x4*)(base32 + off + 4); }
                    else { const u32x4 bw = *(const u32x4*)(xb + off);
                        b0[0] = __uint_as_float(bw.x << 16); b0[1] = __uint_as_float(bw.x & 0xffff0000u); b0[2] = __uint_as_float(bw.y << 16); b0[3] = __uint_as_float(bw.y & 0xffff0000u);
                        b1[0] = __uint_as_float(bw.z << 16); b1[1] = __uint_as_float(bw.z & 0xffff0000u); b1[2] = __uint_as_float(bw.w << 16); b1[3] = __uint_as_float(bw.w & 0xffff0000u); }
                    acc[ai][bj][m][0] = b0 * ia; acc[ai][bj][m][1] = b1 * ia; }
    }
    __device__ __forceinline__ void operator()(const f32x4 (&acc)[2][2][4][2], const Unit& u, int wr, int wc, int fr, int fq) const {
        const unsigned row0 = u.pm * BM + wr * 64 + fr, col0 = u.pn * BM + wc * 32 + 8 * fq;
#pragma unroll
        for (int ai = 0; ai < 2; ++ai)
#pragma unroll
            for (int m = 0; m < 4; ++m) {
                const unsigned r = row0 + ai * HALF + m * 16; float s = 0.f;
#pragma unroll
                for (int bj = 0; bj < 2; ++bj) { const unsigned off = r * 1024u + col0 + bj * HALF;
                    const f32x4 o0 = acc[ai][bj][m][0] * alpha, o1 = acc[ai][bj][m][1] * alpha;
                    u32x4 w; w.x = cvt_pk_bf16(o0[0], o0[1]); w.y = cvt_pk_bf16(o0[2], o0[3]); w.z = cvt_pk_bf16(o1[0], o1[1]); w.w = cvt_pk_bf16(o1[2], o1[3]);
                    *(u32x4*)(xb + off) = w;
                    f32x4 q0, q1;
                    q0[0] = __uint_as_float(w.x << 16); q0[1] = __uint_as_float(w.x & 0xffff0000u); q0[2] = __uint_as_float(w.y << 16); q0[3] = __uint_as_float(w.y & 0xffff0000u);
                    q1[0] = __uint_as_float(w.z << 16); q1[1] = __uint_as_float(w.z & 0xffff0000u); q1[2] = __uint_as_float(w.w << 16); q1[3] = __uint_as_float(w.w & 0xffff0000u);
                    const f32x4 sq = q0 * q0 + q1 * q1; s += (sq[0] + sq[1]) + (sq[2] + sq[3]); }
                { const auto t16 = __builtin_amdgcn_permlane16_swap(__float_as_uint(s), __float_as_uint(s), false, false); s = __uint_as_float(t16[0]) + __uint_as_float(t16[1]);
                  const auto t32 = __builtin_amdgcn_permlane32_swap(__float_as_uint(s), __float_as_uint(s), false, false); s = __uint_as_float(t32[0]) + __uint_as_float(t32[1]); }
                if (fq == 0) ssqp[r * 16u + u.pn * 4 + wc] = s;
            }
    }
};
struct EpiResidFinal {
    static constexpr bool PERM = true, AFTER_DRAIN = true, HAS_INIT = true;
    const bf16_t* xb; float* out; const float* gain; unsigned* xslot; unsigned* cnt; float alpha;
    __device__ __forceinline__ void init(f32x4 (&acc)[2][2][4][2], const Unit& u, int wr, int wc, int fr, int fq) const {
        const unsigned row0 = u.pm * BM + wr * 64 + fr, col0 = u.pn * BM + wc * 32 + 8 * fq; const float ia = 1.0f / alpha;
#pragma unroll
        for (int ai = 0; ai < 2; ++ai)
#pragma unroll
            for (int m = 0; m < 4; ++m)
#pragma unroll
                for (int bj = 0; bj < 2; ++bj) { const unsigned off = (row0 + ai * HALF + m * 16) * 1024u + col0 + bj * HALF; const u32x4 bw = *(const u32x4*)(xb + off); f32x4 b0, b1;
                    b0[0] = __uint_as_float(bw.x << 16); b0[1] = __uint_as_float(bw.x & 0xffff0000u); b0[2] = __uint_as_float(bw.y << 16); b0[3] = __uint_as_float(bw.y & 0xffff0000u);
                    b1[0] = __uint_as_float(bw.z << 16); b1[1] = __uint_as_float(bw.z & 0xffff0000u); b1[2] = __uint_as_float(bw.w << 16); b1[3] = __uint_as_float(bw.w & 0xffff0000u);
                    acc[ai][bj][m][0] = b0 * ia; acc[ai][bj][m][1] = b1 * ia; }
    }
    __device__ __forceinline__ void fused(f32x4 (&acc)[2][2][4][2], const Unit& u, int wr, int wc, int fr, int fq, PG8_LAS unsigned char* lds, int wid, int lane) const {
        PG8_LAS float* P = (PG8_LAS float*)lds;
        PG8_LAS float* S = (PG8_LAS float*)(lds + 4096);
        const int tid = wid * 64 + lane;
#pragma unroll
        for (int ai = 0; ai < 2; ++ai)
#pragma unroll
            for (int m = 0; m < 4; ++m) { float s = 0.f;
#pragma unroll
                for (int bj = 0; bj < 2; ++bj)
#pragma unroll
                    for (int n = 0; n < 2; ++n) { const f32x4 o = acc[ai][bj][m][n] * alpha; acc[ai][bj][m][n] = o; const f32x4 q = o * o; s += (q[0] + q[1]) + (q[2] + q[3]); }
                { const auto t16 = __builtin_amdgcn_permlane16_swap(__float_as_uint(s), __float_as_uint(s), false, false); s = __uint_as_float(t16[0]) + __uint_as_float(t16[1]);
                  const auto t32 = __builtin_amdgcn_permlane32_swap(__float_as_uint(s), __float_as_uint(s), false, false); s = __uint_as_float(t32[0]) + __uint_as_float(t32[1]); }
                if (fq == 0) P[(ai * HALF + wr * 64 + m * 16 + fr) * 4 + wc] = s; }
        asm volatile("s_waitcnt lgkmcnt(0)" ::: "memory"); __builtin_amdgcn_s_barrier(); asm volatile("" ::: "memory");
        if (tid < 256) { const float t = (P[tid * 4 + 0] + P[tid * 4 + 1]) + (P[tid * 4 + 2] + P[tid * 4 + 3]);
            __hip_atomic_store(xslot + ((size_t)(u.pm * BM + tid) * 4 + u.pn), __float_as_uint(t), __ATOMIC_RELAXED, __HIP_MEMORY_SCOPE_AGENT); }
        asm volatile("s_waitcnt vmcnt(0)" ::: "memory");
        if (lane == 0) __hip_atomic_fetch_add(cnt + 64 * u.pm, 1u, __ATOMIC_RELAXED, __HIP_MEMORY_SCOPE_AGENT);
        if (wid == 0) { unsigned spins = 0;
            while ((unsigned)__builtin_amdgcn_readfirstlane(__hip_atomic_load(cnt + 64 * u.pm, __ATOMIC_RELAXED, __HIP_MEMORY_SCOPE_AGENT)) < 32u) { __builtin_amdgcn_s_sleep(2); if (++spins > (1u << 20)) break; }
            __builtin_amdgcn_fence(__ATOMIC_ACQUIRE, "agent"); }
        asm volatile("s_waitcnt vmcnt(0) lgkmcnt(0)" ::: "memory"); __builtin_amdgcn_s_barrier(); asm volatile("" ::: "memory");
        if (tid < 256) { const unsigned* sl = xslot + (size_t)(u.pm * BM + tid) * 4; float t = 0.f;
#pragma unroll
            for (int k = 0; k < 4; ++k) t += __uint_as_float(__hip_atomic_load(sl + k, __ATOMIC_RELAXED, __HIP_MEMORY_SCOPE_AGENT));
            S[tid] = __builtin_amdgcn_rsqf(t * (1.0f / 1024.0f) + 1e-6f); }
        asm volatile("s_waitcnt vmcnt(0) lgkmcnt(0)" ::: "memory"); __builtin_amdgcn_s_barrier(); asm volatile("" ::: "memory");
        const unsigned row0 = u.pm * BM + wr * 64 + fr, col0 = u.pn * BM + wc * 32 + 8 * fq;
        f32x4 gv[2][2];
#pragma unroll
        for (int bj = 0; bj < 2; ++bj) { gv[bj][0] = *(const f32x4*)(gain + col0 + bj * HALF); gv[bj][1] = *(const f32x4*)(gain + col0 + bj * HALF + 4); }
#pragma unroll
        for (int ai = 0; ai < 2; ++ai)
#pragma unroll
            for (int m = 0; m < 4; ++m) { const float rs = S[ai * HALF + wr * 64 + m * 16 + fr]; const unsigned r = row0 + ai * HALF + m * 16;
#pragma unroll
                for (int bj = 0; bj < 2; ++bj) { float* op = out + (r * 1024u + col0 + bj * HALF);
                    *(f32x4*)op = acc[ai][bj][m][0] * rs * gv[bj][0]; *(f32x4*)(op + 4) = acc[ai][bj][m][1] * rs * gv[bj][1]; } }
    }
};
struct EpiWin {
    static constexpr bool PERM = true, AFTER_DRAIN = false, HAS_INIT = false;
    bf16_t* QKV; bf16_t* GATE; const float* ssqp; const float* rope; const PG8_LAS float* rsl;
    __device__ __forceinline__ void operator()(const f32x4 (&acc)[2][2][4][2], const Unit& u, int wr, int wc, int fr, int fq) const {
        const int row0 = u.pm * BM + wr * 64 + fr; const int pn = u.pn; const bool isgate = pn >= 12;
        const bool dorope = (pn < 6) && ((wc & 1) == 0) && (fq < 2); const float qs = (pn < 3 || pn == 9) ? 0.125f : 1.0f;
#pragma unroll
        for (int ai = 0; ai < 2; ++ai)
#pragma unroll
            for (int m = 0; m < 4; ++m) {
                const int r = row0 + ai * HALF + m * 16; const float rs = rsl[u.ui * 256 + ai * HALF + wr * 64 + m * 16 + fr]; const int t = r & 4095;
#pragma unroll
                for (int bj = 0; bj < 2; ++bj) {
                    const int colt = bj * HALF + wc * 32 + 8 * fq; float v[8];
#pragma unroll
                    for (int n = 0; n < 2; ++n)
#pragma unroll
                        for (int j = 0; j < 4; ++j) v[n * 4 + j] = acc[ai][bj][m][n][j] * rs;
                    bf16_t* dst;
                    if (isgate) {
#pragma unroll
                        for (int i = 0; i < 8; ++i) v[i] = __builtin_amdgcn_rcpf(1.0f + __builtin_amdgcn_exp2f(-v[i] * LOG2E));
                        dst = GATE + ((unsigned)r * 2048u + (unsigned)((pn - 12) * 256 + colt));
                    } else {
                        if (dorope) {
                            const f32x4* cs = (const f32x4*)(rope + ((unsigned)t * 16u + 8u * (unsigned)fq));
                            const f32x4 c01 = cs[0], c23 = cs[1];
                            { const float x1 = v[0], x2 = v[1]; v[0] = x1 * c01[0] - x2 * c01[1]; v[1] = x2 * c01[0] + x1 * c01[1]; }
                            { const float x1 = v[2], x2 = v[3]; v[2] = x1 * c01[2] - x2 * c01[3]; v[3] = x2 * c01[2] + x1 * c01[3]; }
                            { const float x1 = v[4], x2 = v[5]; v[4] = x1 * c23[0] - x2 * c23[1]; v[5] = x2 * c23[0] + x1 * c23[1]; }
                            { const float x1 = v[6], x2 = v[7]; v[6] = x1 * c23[2] - x2 * c23[3]; v[7] = x2 * c23[2] + x1 * c23[3]; }
                        }
#pragma unroll
                        for (int i = 0; i < 8; ++i) v[i] *= qs;
                        { const unsigned cc = (unsigned)(pn * 256 + colt); dst = QKV + (((cc >> 6) * 16384u + (unsigned)r) * 64u + (cc & 63u)); }
                    }
                    u32x4 w; w.x = cvt_pk_bf16(v[0], v[1]); w.y = cvt_pk_bf16(v[2], v[3]); w.z = cvt_pk_bf16(v[4], v[5]); w.w = cvt_pk_bf16(v[6], v[7]);
                    *(u32x4*)dst = w;
                }
                asm volatile("" ::: "memory");
            }
    }
};
template <bool SECOND> struct EpiGate {
    static constexpr bool PERM = true, AFTER_DRAIN = false, HAS_INIT = false;
    const bf16_t* gate; bf16_t* Y1; bf16_t* Y;
    __device__ __forceinline__ void operator()(const f32x4 (&acc)[2][2][4][2], const Unit& u, int wr, int wc, int fr, int fq) const {
        const unsigned row0 = u.pm * BM + wr * 64 + fr, col0 = u.pn * BM + wc * 32 + 8 * fq;
#pragma unroll
        for (int ai = 0; ai < 2; ++ai)
#pragma unroll
            for (int m = 0; m < 4; ++m) {
                const unsigned r = row0 + ai * HALF + m * 16;
#pragma unroll
                for (int bj = 0; bj < 2; ++bj) {
                    const unsigned c = col0 + bj * HALF; const unsigned go = r * 2048u + c, yo = r * 1024u + c;
                    const u32x4 gw = *(const u32x4*)(gate + go);
                    f32x4 a0 = acc[ai][bj][m][0], a1 = acc[ai][bj][m][1];
                    a0[0] *= __uint_as_float(gw.x << 16); a0[1] *= __uint_as_float(gw.x & 0xffff0000u); a0[2] *= __uint_as_float(gw.y << 16); a0[3] *= __uint_as_float(gw.y & 0xffff0000u);
                    a1[0] *= __uint_as_float(gw.z << 16); a1[1] *= __uint_as_float(gw.z & 0xffff0000u); a1[2] *= __uint_as_float(gw.w << 16); a1[3] *= __uint_as_float(gw.w & 0xffff0000u);
                    if (!SECOND) { u32x4 w; w.x = cvt_pk_bf16(a0[0], a0[1]); w.y = cvt_pk_bf16(a0[2], a0[3]); w.z = cvt_pk_bf16(a1[0], a1[1]); w.w = cvt_pk_bf16(a1[2], a1[3]); *(u32x4*)(Y1 + yo) = w; }
                    else { const u32x4 yw = *(const u32x4*)(Y1 + yo);
                        a0[0] += __uint_as_float(yw.x << 16); a0[1] += __uint_as_float(yw.x & 0xffff0000u); a0[2] += __uint_as_float(yw.y << 16); a0[3] += __uint_as_float(yw.y & 0xffff0000u);
                        a1[0] += __uint_as_float(yw.z << 16); a1[1] += __uint_as_float(yw.z & 0xffff0000u); a1[2] += __uint_as_float(yw.w << 16); a1[3] += __uint_as_float(yw.w & 0xffff0000u);
                        u32x4 w; w.x = cvt_pk_bf16(a0[0], a0[1]); w.y = cvt_pk_bf16(a0[2], a0[3]); w.z = cvt_pk_bf16(a1[0], a1[1]); w.w = cvt_pk_bf16(a1[2], a1[3]);
                        __builtin_amdgcn_raw_buffer_store_b128(w, __builtin_amdgcn_make_buffer_rsrc(Y, 0, 16384 * 1024 * 2, 0x00020000), yo * 2u, 0,   16); }
                    asm volatile("" ::: "memory");
                }
            }
    }
};
struct EpiGate2 {
    static constexpr bool PERM = true, AFTER_DRAIN = false, HAS_INIT = false;
    const bf16_t* gate; bf16_t* Y1; bf16_t* Y;
    __device__ __forceinline__ void operator()(const f32x4 (&acc)[2][2][4][2], const Unit& u, int wr, int wc, int fr, int fq) const {
        const unsigned row0 = u.pm * BM + wr * 64 + fr, col0 = u.pn * BM + wc * 32 + 8 * fq; const bool second = u.sel != 0; const unsigned gofs = second ? 0u : 1024u;
#pragma unroll
        for (int ai = 0; ai < 2; ++ai)
#pragma unroll
            for (int m = 0; m < 4; ++m) {
                const unsigned r = row0 + ai * HALF + m * 16;
#pragma unroll
                for (int bj = 0; bj < 2; ++bj) {
                    const unsigned c = col0 + bj * HALF; const unsigned go = r * 2048u + gofs + c, yo = r * 1024u + c;
                    const u32x4 gw = *(const u32x4*)(gate + go);
                    f32x4 a0 = acc[ai][bj][m][0], a1 = acc[ai][bj][m][1];
                    a0[0] *= __uint_as_float(gw.x << 16); a0[1] *= __uint_as_float(gw.x & 0xffff0000u); a0[2] *= __uint_as_float(gw.y << 16); a0[3] *= __uint_as_float(gw.y & 0xffff0000u);
                    a1[0] *= __uint_as_float(gw.z << 16); a1[1] *= __uint_as_float(gw.z & 0xffff0000u); a1[2] *= __uint_as_float(gw.w << 16); a1[3] *= __uint_as_float(gw.w & 0xffff0000u);
                    if (second) { const u32x4 yw = *(const u32x4*)(Y1 + yo);
                        a0[0] += __uint_as_float(yw.x << 16); a0[1] += __uint_as_float(yw.x & 0xffff0000u); a0[2] += __uint_as_float(yw.y << 16); a0[3] += __uint_as_float(yw.y & 0xffff0000u);
                        a1[0] += __uint_as_float(yw.z << 16); a1[1] += __uint_as_float(yw.z & 0xffff0000u); a1[2] += __uint_as_float(yw.w << 16); a1[3] += __uint_as_float(yw.w & 0xffff0000u); }
                    u32x4 w; w.x = cvt_pk_bf16(a0[0], a0[1]); w.y = cvt_pk_bf16(a0[2], a0[3]); w.z = cvt_pk_bf16(a1[0], a1[1]); w.w = cvt_pk_bf16(a1[2], a1[3]);
                    if (second) __builtin_amdgcn_raw_buffer_store_b128(w, __builtin_amdgcn_make_buffer_rsrc(Y, 0, 16384 * 1024 * 2, 0x00020000), yo * 2u, 0,   16);
                    else *(u32x4*)(Y1 + yo) = w;
                    asm volatile("" ::: "memory");
                }
            }
    }
};

template <class Epi, class Sched, bool ALIGN_EPI = false, bool SP2 = false>
__device__ __forceinline__ void gemm_phase(PG8_LAS unsigned char* lds, const Gemm g, const Sched& S, const Epi& E) {
    int tid_ = threadIdx.x; asm volatile("" : "+v"(tid_));
    const int tid = tid_, wid = __builtin_amdgcn_readfirstlane(tid >> 6), lane = tid & 63, wr = wid >> 2, wc = wid & 3, fr = lane & 15, fq = lane >> 4;
    const int K = g.K, nt = K / BK;
    unsigned voffA[2], voffB[2];
#pragma unroll
    for (int i = 0; i < 2; ++i) { int R, C; stage_rc(tid * 16 + i * 8192, R, C); const int Rb = Epi::PERM ? ((R & ~31) + perm32(R & 31)) : R;
        voffA[i] = (unsigned)(R * K + C) * 2u; voffB[i] = (unsigned)(Rb * K + C) * 2u; }
    const size_t kstep = (size_t)(BK * 2);
    const size_t hstep = (size_t)HALF * K * 2;
    const size_t tstep = 2 * hstep;
    const unsigned ldsw = (unsigned)wid * 1024u;
    const int aoff = lds_byte(wr * 64 + fr, fq * 8), boff = lds_byte(wc * 32 + fr, fq * 8);
#define PG8_SA(b, h) (((b) * 2 + (h)) * HTB)
#define PG8_SB(b, h) ((4 + (b) * 2 + (h)) * HTB)
#define PG8_STAGE(bufoff, gbase, voff) do { _Pragma("unroll") for (int _i = 0; _i < 2; ++_i) \
        __builtin_amdgcn_global_load_lds((const unsigned*)((const char*)(gbase) + (voff)[_i]), (PG8_LAS unsigned*)(lds + (bufoff) + ldsw + _i * 8192), 16, 0, 0); } while (0)
#define PG8_LDA(dst, b, h) do { _Pragma("unroll") for (int m = 0; m < 4; ++m) _Pragma("unroll") for (int k = 0; k < 2; ++k) dst[m][k] = *(const PG8_LAS bf16x8*)(lds + PG8_SA(b, h) + aoff + m * 2048 + k * 1024); } while (0)
#define PG8_LDB(dst, b, h) do { _Pragma("unroll") for (int n = 0; n < 2; ++n) _Pragma("unroll") for (int k = 0; k < 2; ++k) dst[n][k] = *(const PG8_LAS bf16x8*)(lds + PG8_SB(b, h) + boff + n * 2048 + k * 1024); } while (0)
#define PG8_MMA(ai, bj, At, Bt) do { __builtin_amdgcn_s_setprio(1); _Pragma("unroll") for (int m = 0; m < 4; ++m) _Pragma("unroll") for (int n = 0; n < 2; ++n) _Pragma("unroll") for (int k = 0; k < 2; ++k) \
        acc[ai][bj][m][n] = __builtin_amdgcn_mfma_f32_16x16x32_bf16(Bt[n][k], At[m][k], acc[ai][bj][m][n], 0, 0, 0); __builtin_amdgcn_s_setprio(0); } while (0)
#define PG8_WAIT_V(n) asm volatile("s_waitcnt vmcnt(" #n ")" ::: "memory")
#define PG8_WAIT_L(n) asm volatile("s_waitcnt lgkmcnt(" #n ")" ::: "memory")
#define PG8_BAR __builtin_amdgcn_s_barrier()
#define PG8_SCHED __builtin_amdgcn_sched_barrier(0)
    Unit cur, nxt; int ui = 0;
    if (!S.next(0, cur)) return;
    f32x4 acc[2][2][4][2];
    if constexpr (Epi::HAS_INIT) E.init(acc, cur, wr, wc, fr, fq);
    else {
#pragma unroll
    for (int a = 0; a < 2; ++a)
#pragma unroll
        for (int b = 0; b < 2; ++b)
#pragma unroll
            for (int m = 0; m < 4; ++m)
#pragma unroll
                for (int n = 0; n < 2; ++n) acc[a][b][m][n] = (f32x4){0.f, 0.f, 0.f, 0.f};
    }
    bf16x8 At[4][2], B0[2][2], B1[2][2];
    const char* cA = (const char*)(cur.sel ? g.A2 : g.A) + (size_t)cur.pm * tstep; const char* cB = (const char*)(cur.sel ? g.Bt2 : g.Bt) + (size_t)cur.pn * tstep;
    S.a_ready(cur);
    if constexpr (SP2) {
        PG8_STAGE(PG8_SB(0, 0), cB, voffB); PG8_STAGE(PG8_SB(0, 1), cB + hstep, voffB); PG8_STAGE(PG8_SA(0, 0), cA, voffA); PG8_STAGE(PG8_SA(0, 1), cA + hstep, voffA);
        if (wr == 1) PG8_BAR;
        PG8_WAIT_V(2); PG8_BAR;
        PG8_STAGE(PG8_SB(1, 0), cB + kstep, voffB); PG8_STAGE(PG8_SA(1, 0), cA + kstep, voffA); PG8_STAGE(PG8_SB(1, 1), cB + hstep + kstep, voffB);
        PG8_WAIT_V(6); PG8_BAR;
    } else {
        PG8_STAGE(PG8_SB(0, 0), cB, voffB); PG8_STAGE(PG8_SA(0, 0), cA, voffA); PG8_STAGE(PG8_SB(0, 1), cB + hstep, voffB); PG8_STAGE(PG8_SA(0, 1), cA + hstep, voffA);
        if (wr == 1) PG8_BAR;
        PG8_WAIT_V(4); PG8_BAR;
        PG8_STAGE(PG8_SB(1, 0), cB + kstep, voffB); PG8_STAGE(PG8_SA(1, 0), cA + kstep, voffA); PG8_STAGE(PG8_SB(1, 1), cB + hstep + kstep, voffB);
        PG8_WAIT_V(6); PG8_BAR;
    }
    for (;;) {
        const bool has_next = S.next(ui + 1, nxt);
        const char* nA = has_next ? (const char*)(nxt.sel ? g.A2 : g.A) + (size_t)nxt.pm * tstep : cA; const char* nB = has_next ? (const char*)(nxt.sel ? g.Bt2 : g.Bt) + (size_t)nxt.pn * tstep : cB;
        for (int t = 0; t < nt; t += 2) {
            const bool last = (t == nt - 2);
            const char* a1 = cA + (size_t)(t + 1) * kstep;
            const char* a2 = last ? nA : cA + (size_t)(t + 2) * kstep; const char* b2 = last ? nB : cB + (size_t)(t + 2) * kstep;
            const char* a3 = a2 + kstep; const char* b3 = b2 + kstep;
            if (last && has_next) S.a_ready(nxt);
            if constexpr (SP2) {
            PG8_LDB(B0, 0, 0); PG8_LDB(B1, 0, 1); PG8_SCHED; PG8_LDA(At, 0, 0); PG8_STAGE(PG8_SA(1, 1), a1 + hstep, voffA);
            PG8_WAIT_V(8); PG8_WAIT_L(0); PG8_BAR; PG8_MMA(0, 0, At, B0); PG8_MMA(0, 1, At, B1); PG8_BAR; PG8_SCHED;
            PG8_LDA(At, 0, 1); PG8_STAGE(PG8_SB(0, 0), b2, voffB); PG8_STAGE(PG8_SB(0, 1), b2 + hstep, voffB); PG8_STAGE(PG8_SA(0, 0), a2, voffA);
            PG8_WAIT_V(8); PG8_WAIT_L(0); PG8_BAR; PG8_MMA(1, 0, At, B0); PG8_MMA(1, 1, At, B1); PG8_BAR; PG8_SCHED;
            PG8_LDB(B0, 1, 0); PG8_LDB(B1, 1, 1); PG8_SCHED; PG8_LDA(At, 1, 0); PG8_STAGE(PG8_SA(0, 1), a2 + hstep, voffA);
            PG8_WAIT_V(8); PG8_WAIT_L(0); PG8_BAR; PG8_MMA(0, 0, At, B0); PG8_MMA(0, 1, At, B1); PG8_BAR; PG8_SCHED;
            PG8_LDA(At, 1, 1); PG8_STAGE(PG8_SB(1, 0), b3, voffB); PG8_STAGE(PG8_SB(1, 1), b3 + hstep, voffB); PG8_STAGE(PG8_SA(1, 0), a3, voffA);
            PG8_WAIT_V(8); PG8_WAIT_L(0); PG8_BAR; PG8_MMA(1, 0, At, B0); PG8_MMA(1, 1, At, B1); PG8_BAR; PG8_SCHED;
            } else {
            PG8_LDB(B0, 0, 0); PG8_SCHED; PG8_LDA(At, 0, 0); PG8_STAGE(PG8_SA(1, 1), a1 + hstep, voffA);
            PG8_WAIT_L(8); PG8_BAR; PG8_WAIT_L(0); PG8_MMA(0, 0, At, B0); PG8_BAR; PG8_SCHED;
            PG8_LDB(B1, 0, 1); PG8_STAGE(PG8_SB(0, 0), b2, voffB);
            PG8_BAR; PG8_WAIT_L(0); PG8_MMA(0, 1, At, B1); PG8_BAR;
            PG8_LDA(At, 0, 1); PG8_STAGE(PG8_SA(0, 0), a2, voffA);
            PG8_BAR; PG8_WAIT_L(0); PG8_MMA(1, 0, At, B0); PG8_BAR; PG8_SCHED;
            PG8_STAGE(PG8_SB(0, 1), b2 + hstep, voffB);
            PG8_WAIT_V(6); PG8_BAR; PG8_MMA(1, 1, At, B1); PG8_BAR;
            PG8_LDB(B0, 1, 0); PG8_SCHED; PG8_LDA(At, 1, 0); PG8_STAGE(PG8_SA(0, 1), a2 + hstep, voffA);
            PG8_WAIT_L(8); PG8_BAR; PG8_WAIT_L(0); PG8_MMA(0, 0, At, B0); PG8_BAR; PG8_SCHED;
            PG8_LDB(B1, 1, 1); PG8_STAGE(PG8_SB(1, 0), b3, voffB);
            PG8_BAR; PG8_WAIT_L(0); PG8_MMA(0, 1, At, B1); PG8_BAR;
            PG8_LDA(At, 1, 1); PG8_STAGE(PG8_SA(1, 0), a3, voffA);
            PG8_BAR; PG8_WAIT_L(0); PG8_MMA(1, 0, At, B0); PG8_BAR; PG8_SCHED;
            PG8_STAGE(PG8_SB(1, 1), b3 + hstep, voffB);
            PG8_WAIT_V(6); PG8_BAR; PG8_MMA(1, 1, At, B1); PG8_BAR;
            }
        }
        if constexpr (ALIGN_EPI) { if (wr == 0) PG8_BAR; }
        if constexpr (!Epi::AFTER_DRAIN) { E(acc, cur, wr, wc, fr, fq); S.done(cur); }
        if (!has_next) break;
        if constexpr (Epi::HAS_INIT) E.init(acc, nxt, wr, wc, fr, fq);
        else {
#pragma unroll
        for (int a = 0; a < 2; ++a)
#pragma unroll
            for (int b = 0; b < 2; ++b)
#pragma unroll
                for (int m = 0; m < 4; ++m)
#pragma unroll
                    for (int n = 0; n < 2; ++n) acc[a][b][m][n] = (f32x4){0.f, 0.f, 0.f, 0.f};
        }
        cur = nxt; cA = nA; cB = nB; ++ui;
        if constexpr (ALIGN_EPI) { if (wr == 1) PG8_BAR; }
    }
    PG8_WAIT_V(0);
    if constexpr (!ALIGN_EPI) { if (wr == 0) PG8_BAR; }
    PG8_BAR;
    if constexpr (Epi::AFTER_DRAIN) { E.fused(acc, cur, wr, wc, fr, fq, lds, wid, lane); S.done(cur); }
#undef PG8_SA
#undef PG8_SB
#undef PG8_STAGE
#undef PG8_LDA
#undef PG8_LDB
#undef PG8_MMA
#undef PG8_WAIT_V
#undef PG8_WAIT_L
#undef PG8_BAR
#undef PG8_SCHED
}
}

#define LAS __attribute__((address_space(3)))
typedef unsigned short bf16;
typedef short bf16x8 __attribute__((ext_vector_type(8)));
typedef short s16x4 __attribute__((ext_vector_type(4)));
typedef float f32x4 __attribute__((ext_vector_type(4)));
typedef float f32x16 __attribute__((ext_vector_type(16)));
typedef unsigned u32x4 __attribute__((ext_vector_type(4)));
typedef unsigned u32x2 __attribute__((ext_vector_type(2)));
constexpr int NWAVES = 8;
constexpr int M = 16384, D = 1024, SEQ = 4096, FF = 2816, NIN = 5120, NQKV = 3072, NGATE = 2048, DEPTH = 2;
constexpr float LOG2E = 1.4426950408889634f;
#ifndef SB_EARLY_EXIT
#define SB_EARLY_EXIT 1
#endif
#ifndef N_LAUNCH_MODE
#define N_LAUNCH_MODE 0
#endif
constexpr size_t MiB = 1u << 20;
constexpr size_t WS_CNT = 16384, WS_PCNT = 32768, WS_ZERO_BYTES = 32768 + 4 * 16384;
constexpr size_t WS_XSLOT = 250 * MiB;
constexpr size_t WS_BAR = 0;
constexpr size_t WS_SSQ = 1 * MiB, WS_ROPE = 2 * MiB, WS_LSE = 3 * MiB;
constexpr size_t WS_W = 4 * MiB;
constexpr size_t W_1CAT = 0, W_D1 = W_1CAT + (size_t)2 * FF * D * 2, W_IN = W_D1 + (size_t)D * FF * 2, W_PD = W_IN + (size_t)NIN * D * 2, W_PS = W_PD + (size_t)D * 256 * 2,
                 W_OUT = W_PS + (size_t)D * 256 * 2, W_2CAT = W_OUT + (size_t)D * D * 2, W_D2 = W_2CAT + (size_t)2 * FF * D * 2, W_END = W_D2 + (size_t)D * FF * 2;
static_assert(W_END <= 46 * MiB, "weights");
constexpr size_t WS_XB = 50 * MiB;
constexpr size_t OUT_OD3 = 0, OUT_OD = 24 * MiB;
constexpr size_t WS_R = 82 * MiB;
constexpr size_t WS_Y1 = WS_R, WS_Y = WS_R + 64 * MiB;
constexpr size_t WS_GATE = 178 * MiB;
constexpr size_t WS_OS = 242 * MiB;
constexpr size_t WS_END = 251 * MiB;
constexpr int RSL_OFF = 131072 + 1024;
constexpr int LDS_BYTES = RSL_OFF + 8 * 256 * 4;

__device__ __forceinline__ float wave_sum(float v) {
#pragma unroll
    for (int o = 1; o < 64; o <<= 1) v += __shfl_xor(v, o);
    return v;
}
__device__ __forceinline__ unsigned pk2(float lo, float hi) { return pg8::cvt_pk_bf16(lo, hi); }
#define LDS_WAIT() asm volatile("s_waitcnt lgkmcnt(0)" ::: "memory")

typedef __attribute__((address_space(1))) unsigned gu32;
#define XB_TMO      128
#define XB_XCNT(j)  (256  + 64 * (j))
#define XB_XSUB(j)  (1280 + 64 * (j))
#define XB_XGEN(j)  (2304 + 64 * (j))
#define XB_TOP      3328
#define XB_TOPGEN   3392
#define XCD_BAR_WORDS 3456
#define XB_SPIN_CAP (1u << 18)

__device__ __forceinline__ unsigned xb_ld(unsigned* p)              { return __hip_atomic_load(p, __ATOMIC_RELAXED, __HIP_MEMORY_SCOPE_AGENT); }
__device__ __forceinline__ unsigned xb_add(unsigned* p, unsigned v) { return __hip_atomic_fetch_add(p, v, __ATOMIC_RELAXED, __HIP_MEMORY_SCOPE_AGENT); }
__device__ __forceinline__ unsigned xb_xcc_id() { return (unsigned)__builtin_amdgcn_s_getreg((3 << 11) | 20) & 0xFu; }
#define XB_SPIN(cond, bar) do { unsigned _sp = 0; while (cond) { __builtin_amdgcn_s_sleep(1); \
    if ((++_sp & 255u) == 0u) { if (xb_ld(&(bar)[XB_TMO])) break; if (_sp > XB_SPIN_CAP) { atomicAdd(&(bar)[XB_TMO], 1u); break; } } } } while (0)

struct XcdBarrier {
    unsigned* bar; unsigned x;
    volatile LAS unsigned* st;
};

__device__ __forceinline__ XcdBarrier xcd_barrier_post(unsigned* bar, volatile LAS unsigned* st) {
    XcdBarrier b; b.bar = bar; b.x = xb_xcc_id(); b.st = st;
    if (threadIdx.x == 0) (void)xb_add(&bar[XB_XCNT(b.x)], 1u);
    return b;
}
__device__ __forceinline__ void xcd_barrier_complete(unsigned* bar, unsigned x, unsigned& nloc, unsigned& nx) {
    const unsigned G = gridDim.x * gridDim.y * gridDim.z;
    unsigned sum, cnt, mine, sp = 0u;
    for (;;) {
        sum = 0u; cnt = 0u; mine = 0u;
#pragma unroll
        for (unsigned j = 0; j < 16; ++j) { const unsigned c = xb_ld(&bar[XB_XCNT(j)]); sum += c; cnt += (c > 0u) ? 1u : 0u; mine = (j == x) ? c : mine; }
        if (sum == G) break;
        __builtin_amdgcn_s_sleep(1);
        if ((++sp & 255u) == 0u) { if (xb_ld(&bar[XB_TMO])) break; if (sp > XB_SPIN_CAP) { atomicAdd(&bar[XB_TMO], 1u); break; } }
    }
    nloc = mine > 0u ? mine : 1u; nx = cnt > 0u ? cnt : 1u;
}

__device__ __forceinline__ void xcd_barrier(const XcdBarrier& b) {
    asm volatile("s_waitcnt vmcnt(0)" ::: "memory");
    __syncthreads();
    if (threadIdx.x == 0) {
        unsigned* bar = b.bar;
        __builtin_amdgcn_s_waitcnt(0);
        unsigned nloc = b.st[0], nx = b.st[1];
        if (nloc == 0u) { xcd_barrier_complete(bar, b.x, nloc, nx); b.st[0] = nloc; b.st[1] = nx; }
        const unsigned old = xb_add(&bar[XB_XSUB(b.x)], 1u);
        const unsigned gen = old / nloc;
        if (old + 1u == (gen + 1u) * nloc) {
            __builtin_amdgcn_fence(__ATOMIC_RELEASE, "agent");
            asm volatile("s_waitcnt vmcnt(0)" ::: "memory");
            const unsigned og = xb_add(&bar[XB_TOP], 1u);
            const unsigned tg = og / nx;
            if (og + 1u == (tg + 1u) * nx) xb_add(&bar[XB_TOPGEN], 1u);
            else XB_SPIN(xb_ld(&bar[XB_TOPGEN]) == tg, bar);
            __builtin_amdgcn_fence(__ATOMIC_ACQUIRE, "agent");
            xb_add(&bar[XB_XGEN(b.x)], 1u);
            asm volatile("s_waitcnt vmcnt(0)" ::: "memory");
        } else {
            XB_SPIN(xb_ld(&bar[XB_XGEN(b.x)]) == gen, bar);
            __builtin_amdgcn_fence(__ATOMIC_ACQUIRE, "agent");
            asm volatile("s_waitcnt vmcnt(0)" ::: "memory");
        }
    }
    __syncthreads();
}


constexpr int CI_D1 = 2816, CI_IN = 4224, CI_B = 6784, CI_D2 = 9600, CI_PD = 11008, CI_PS = 11136, CI_OUT = 11264, CI_END = 11776;
struct ConvItem { const float* wp; const float* gp; bf16* dp; int ldw, K; bool rperm; };
struct ConvSrc { const float *n1, *wg1, *wu1, *wd1, *nm, *win, *wpd, *wps, *wout, *n2, *wg2, *wu2, *wd2; };
__device__ __forceinline__ ConvItem conv_decode(const ConvSrc& S, int l, int r, unsigned char* dA, unsigned char* dB, int lane) {
    const float* src; const float* gain = nullptr; bf16* dst; int ldw = D, K = D, kb, nb, sc0; bool rperm = false;
    if (r < CI_D1) { kb = r / 176; nb = r % 176; const int pn = nb >> 3, i8 = nb & 7; src = (i8 < 4 ? S.wg1 : S.wu1) + (size_t)l * D * FF; gain = S.n1 + (size_t)l * D; dst = (bf16*)(dA + W_1CAT); ldw = FF; sc0 = 128 * pn + 32 * (i8 & 3); }
    else if (r < CI_IN) { r -= CI_D1; kb = r / 32; nb = r % 32; src = S.wd1 + (size_t)l * FF * D; dst = (bf16*)(dA + W_D1); K = FF; sc0 = 32 * nb; }
    else if (r < CI_B) { r -= CI_IN; kb = r / 160; nb = r % 160; src = S.win + (size_t)l * D * NIN; gain = S.nm + (size_t)l * D; dst = (bf16*)(dA + W_IN); ldw = NIN; sc0 = 32 * nb; rperm = (nb < 48) && !(nb & 1); }
    else if (r < CI_D2) { r -= CI_B; kb = r / 176; nb = r % 176; const int pn = nb >> 3, i8 = nb & 7; src = (i8 < 4 ? S.wg2 : S.wu2) + (size_t)l * D * FF; gain = S.n2 + (size_t)l * D; dst = (bf16*)(dB + W_2CAT); ldw = FF; sc0 = 128 * pn + 32 * (i8 & 3); }
    else if (r < CI_PD) { r -= CI_D2; kb = r / 32; nb = r % 32; src = S.wd2 + (size_t)l * FF * D; dst = (bf16*)(dB + W_D2); K = FF; sc0 = 32 * nb; }
    else if (r < CI_PS) { r -= CI_PD; kb = r / 32; nb = r % 32; src = S.wpd + (size_t)l * 256 * D; dst = (bf16*)(dB + W_PD); K = 256; sc0 = 32 * nb; }
    else if (r < CI_OUT) { r -= CI_PS; kb = r / 32; nb = r % 32; src = S.wps + (size_t)l * 256 * D; dst = (bf16*)(dB + W_PS); K = 256; sc0 = 32 * nb; }
    else { r -= CI_OUT; kb = r / 32; nb = r % 32; src = S.wout + (size_t)l * D * D; dst = (bf16*)(dB + W_OUT); sc0 = 32 * nb; }
    const int c4 = lane & 7, kr = lane >> 3, k0 = 64 * kb;
    ConvItem I; I.wp = src + (size_t)(k0 + kr) * ldw + sc0 + 4 * c4; I.gp = gain ? gain + k0 + kr : nullptr; I.dp = dst + (size_t)(32 * nb) * K + k0; I.ldw = ldw; I.K = K; I.rperm = rperm;
    return I;
}
__device__ __forceinline__ void conv_load(f32x4 (&v)[8], const ConvItem& I) {
#pragma unroll
    for (int i = 0; i < 8; ++i) v[i] = __builtin_nontemporal_load((const f32x4*)(I.wp + (size_t)(8 * i) * I.ldw));
}
__device__ __forceinline__ void conv_finish(f32x4 (&v)[8], const ConvItem& I, LAS float* scr, int lane) {
    const int c4 = lane & 7, kr = lane >> 3;
    if (I.gp) {
#pragma unroll
        for (int i = 0; i < 8; ++i) v[i] *= I.gp[8 * i];
    }
    int p[4];
#pragma unroll
    for (int e = 0; e < 4; ++e) { const int sc = 4 * c4 + e; p[e] = (I.rperm && sc < 16) ? (sc < 8 ? 2 * sc : 2 * (sc - 8) + 1) : sc; }
#pragma unroll
    for (int i = 0; i < 8; ++i)
#pragma unroll
        for (int e = 0; e < 4; ++e) scr[(kr + 8 * i) * 33 + p[e]] = v[i][e];
    LDS_WAIT();
    const int c = lane & 7;
#pragma unroll
    for (int jj = 0; jj < 4; ++jj) { const int n = (lane >> 3) + 8 * jj; const LAS float* s = scr + (8 * c) * 33 + n;
        u32x4 o; o.x = pk2(s[0 * 33], s[1 * 33]); o.y = pk2(s[2 * 33], s[3 * 33]); o.z = pk2(s[4 * 33], s[5 * 33]); o.w = pk2(s[6 * 33], s[7 * 33]);
        *(u32x4*)(I.dp + (size_t)n * I.K + 8 * c) = o; }
    LDS_WAIT();
}
__device__ __forceinline__ void conv_items(const ConvSrc& S, int l, int lo, int hi, unsigned char* dA, unsigned char* dB, LAS unsigned char* lds, int widx, int nw, int wave, int lane) {
    LAS float* scr = (LAS float*)(lds + wave * 8704);
    int it = lo + widx; if (it >= hi) return;
    ConvItem cur = conv_decode(S, l, __builtin_amdgcn_readfirstlane(it), dA, dB, lane); f32x4 v[8]; conv_load(v, cur);
    for (;;) {
        const int itn = it + nw; const bool more = itn < hi;
        ConvItem nxt = cur; f32x4 vn[8];
        if (more) { nxt = conv_decode(S, l, __builtin_amdgcn_readfirstlane(itn), dA, dB, lane); conv_load(vn, nxt); }
        conv_finish(v, cur, scr, lane);
        if (!more) break;
        cur = nxt; it = itn;
#pragma unroll
        for (int i = 0; i < 8; ++i) v[i] = vn[i];
    }
}
__device__ __forceinline__ void conv_phase(const float* Px, const ConvSrc& S, unsigned char* Pws, int l, LAS unsigned char* lds, int gw, int NGW, int wave, int lane) {
    unsigned char* wsw = Pws + WS_W;
    conv_items(S, l, 0, CI_END, wsw, wsw, lds, gw, NGW, wave, lane);
    if (l == 0) {
        const float* x = Px; bf16* xb = (bf16*)(Pws + WS_XB); float* ssqp = (float*)(Pws + WS_SSQ);
        for (int m = gw; m < M; m += NGW) {
            const f32x4* xr = (const f32x4*)(x + (size_t)m * D) + 2 * lane; f32x4 v[4]; float s = 0.f;
#pragma unroll
            for (int j = 0; j < 2; ++j) { v[2 * j] = __builtin_nontemporal_load(xr + 128 * j); v[2 * j + 1] = __builtin_nontemporal_load(xr + 128 * j + 1); }
#pragma unroll
            for (int j = 0; j < 4; ++j) s += (v[j][0] * v[j][0] + v[j][1] * v[j][1]) + (v[j][2] * v[j][2] + v[j][3] * v[j][3]);
            s = wave_sum(s);
            u32x4* o = (u32x4*)(xb + (size_t)m * D) + lane;
#pragma unroll
            for (int j = 0; j < 2; ++j) { u32x4 w; w.x = pk2(v[2 * j][0], v[2 * j][1]); w.y = pk2(v[2 * j][2], v[2 * j][3]); w.z = pk2(v[2 * j + 1][0], v[2 * j + 1][1]); w.w = pk2(v[2 * j + 1][2], v[2 * j + 1][3]); o[64 * j] = w; }
            if (lane < 16) ssqp[(size_t)m * 16 + lane] = (lane == 0) ? s : 0.f;
        }
        float* rope = (float*)(Pws + WS_ROPE);
        for (int idx = gw * 64 + lane; idx < SEQ * 8; idx += NGW * 64) {
            const int t = idx >> 3, i = idx & 7;
            const float invf = (i == 0) ? 1.0f : (i == 1) ? 0.1939227432012558f : (i == 2) ? 0.03760603070259094f : (i == 3) ? 0.007292664609849453f : (i == 4) ? 0.0014142135623842478f
                             : (i == 5) ? 0.00027424818836152554f : (i == 6) ? 5.3182957344688475e-05f : 1.0313385246263351e-05f;
            const float angf = (float)t * invf; const double a = (double)angf;
            const double kq = __builtin_rint(a * 0.63661977236758134308);
            double rr = __builtin_fma(-kq, 1.57079632679489655800, a); rr = __builtin_fma(-kq, 6.12323399573676603587e-17, rr);
            const int qd = ((int)kq) & 3; const float rf = (float)rr, r2 = rf * rf;
            const float sn = rf + rf * r2 * (-1.0f / 6 + r2 * (1.0f / 120 + r2 * (-1.0f / 5040 + r2 * (1.0f / 362880))));
            const float cn = 1.0f + r2 * (-0.5f + r2 * (1.0f / 24 + r2 * (-1.0f / 720 + r2 * (1.0f / 40320 + r2 * (-1.0f / 3628800)))));
            const float c = (qd == 0) ? cn : (qd == 1) ? -sn : (qd == 2) ? -cn : sn;
            const float s = (qd == 0) ? sn : (qd == 1) ? cn : (qd == 2) ? -sn : -cn;
            rope[2 * idx] = c; rope[2 * idx + 1] = s;
        }
    }
}

__device__ __forceinline__ int crow(int r, int hi) { return (r & 3) + 8 * (r >> 2) + 4 * hi; }
struct F2 { float a, b; };
__device__ __forceinline__ F2 pair32(float v) { const auto rr = __builtin_amdgcn_permlane32_swap(__float_as_uint(v), __float_as_uint(v), false, false); return F2{__uint_as_float(rr[0]), __uint_as_float(rr[1])}; }
__device__ __forceinline__ void ld_frag4(bf16x8 (&f)[4], const bf16* ubase, unsigned rowstride, int lane) {
    const unsigned off = (unsigned)(lane & 31) * rowstride + (unsigned)(lane >> 5) * 8u;
#pragma unroll
    for (int d0 = 0; d0 < 4; ++d0) f[d0] = *(const bf16x8*)(ubase + (off + d0 * 16));
}
__device__ __forceinline__ f32x16 qk_tile(const bf16x8 (&kf)[4], const bf16x8 (&qf)[4]) {
    f32x16 s = {};
#pragma unroll
    for (int d0 = 0; d0 < 4; ++d0) s = __builtin_amdgcn_mfma_f32_32x32x16_bf16(kf[d0], qf[d0], s, 0, 0, 0);
    return s;
}
__device__ __forceinline__ void v_load(u32x4 (&vr)[4], const bf16* ubase, unsigned rowstride, int lane) {
#pragma unroll
    for (int i = 0; i < 4; ++i) { const unsigned c = lane + 64 * i; vr[i] = *(const u32x4*)(ubase + ((c >> 3) * rowstride + (c & 7) * 8u)); }
}
__device__ __forceinline__ void v_stage(LAS unsigned char* vb, const u32x4 (&vr)[4], int lane) {
#pragma unroll
    for (int i = 0; i < 4; ++i) { const int c = lane + 64 * i, key = c >> 3, ch = c & 7; *(LAS u32x4*)(vb + key * 128 + ((ch * 16) ^ (((key >> 1) & 1) << 6))) = vr[i]; }
}
__device__ __forceinline__ void pv_tile(f32x16 (&o)[2], LAS unsigned char* vb, const f32x16& p, int lane) {
    const int hi = lane >> 5, g1 = (lane >> 4) & 1, q4 = (lane & 15) >> 2, pp = lane & 3;
    bf16x8 pf[2];
#pragma unroll
    for (int s = 0; s < 2; ++s) { u32x4 w; w.x = pk2(p[8 * s + 0], p[8 * s + 1]); w.y = pk2(p[8 * s + 2], p[8 * s + 3]); w.z = pk2(p[8 * s + 4], p[8 * s + 5]); w.w = pk2(p[8 * s + 6], p[8 * s + 7]);
        pf[s] = __builtin_bit_cast(bf16x8, w); }
    const int swz = ((q4 >> 1) & 1) << 6;
#pragma unroll
    for (int dblk = 0; dblk < 2; ++dblk)
#pragma unroll
        for (int s = 0; s < 2; ++s) {
            const int colb = (dblk * 64 + g1 * 32 + pp * 8) ^ swz;
            const int row0 = 16 * s + 4 * hi + q4;
            const s16x4 t0 = __builtin_bit_cast(s16x4, __builtin_amdgcn_ds_read_tr16_b64_v4i16((LAS s16x4*)(vb + row0 * 128 + colb)));
            const s16x4 t1 = __builtin_bit_cast(s16x4, __builtin_amdgcn_ds_read_tr16_b64_v4i16((LAS s16x4*)(vb + (row0 + 8) * 128 + colb)));
            const bf16x8 a = (bf16x8){t0[0], t0[1], t0[2], t0[3], t1[0], t1[1], t1[2], t1[3]};
            o[dblk] = __builtin_amdgcn_mfma_f32_32x32x16_bf16(a, pf[s], o[dblk], 0, 0, 0);
        }
}
__device__ __forceinline__ void store_ot(bf16* rowp, const f32x16 (&o)[2], float sc, int hi) {
#pragma unroll
    for (int dblk = 0; dblk < 2; ++dblk)
#pragma unroll
        for (int p = 0; p < 2; ++p) {
            const unsigned x0 = pk2(o[dblk][8 * p] * sc, o[dblk][8 * p + 1] * sc), x1 = pk2(o[dblk][8 * p + 2] * sc, o[dblk][8 * p + 3] * sc);
            const unsigned y0 = pk2(o[dblk][8 * p + 4] * sc, o[dblk][8 * p + 5] * sc), y1 = pk2(o[dblk][8 * p + 6] * sc, o[dblk][8 * p + 7] * sc);
            const auto s0 = __builtin_amdgcn_permlane32_swap(x0, y0, false, false), s1 = __builtin_amdgcn_permlane32_swap(x1, y1, false, false);
            u32x4 w; w.x = s0[0]; w.y = s1[0]; w.z = s0[1]; w.w = s1[1];
            *(u32x4*)(rowp + dblk * 32 + 16 * p + 8 * hi) = w; }
}
struct DilGeo { size_t rowb, kstride; int h12, dil, r, i0; };
__device__ __forceinline__ DilGeo dil_geo(int item) {
    DilGeo g; const int b = item / 1536, rem = item % 1536, ch = rem & 127; g.h12 = rem >> 7;
    const int gg = g.h12 >> 2, ncl = 7 - 2 * gg; g.dil = 1 << (2 * gg); g.r = ch >> ncl; g.i0 = 32 * (ch & ((1 << ncl) - 1));
    g.rowb = (size_t)b * SEQ; g.kstride = (size_t)g.dil * 64; return g;
}
__device__ __forceinline__ void dil_load_qk(const bf16* QKV, const DilGeo& g, bf16x8 (&qf)[4], bf16x8 (&kf)[5][4], int lane) {
    const int q = lane & 31, hi = lane >> 5;
    ld_frag4(qf, QKV + ((size_t)g.h12 * M + g.rowb + (size_t)g.i0 * g.dil + g.r) * 64, (unsigned)g.kstride, lane);
#pragma unroll
    for (int kt = 0; kt < 5; ++kt) { const int ib = g.i0 - 128 + 32 * kt, ibc = ib < 0 ? 0 : ib; ld_frag4(kf[kt], QKV + ((size_t)(12 + g.h12) * M + g.rowb + (size_t)ibc * g.dil + g.r) * 64, (unsigned)g.kstride, lane); }
}
__device__ __forceinline__ void dil_vload(const bf16* QKV, const DilGeo& g, u32x4 (&vr)[4], int kt, int lane) {
    const int ib = g.i0 - 128 + 32 * kt, ibc = ib < 0 ? 0 : ib;
    v_load(vr, QKV + ((size_t)(24 + g.h12) * M + g.rowb + g.r) * 64 + (size_t)ibc * g.kstride, (unsigned)g.kstride, lane);
}
__device__ __forceinline__ void pv_tile_p(f32x16 (&o)[2], LAS unsigned char* vb, const bf16x8 (&pf)[2], int lane) {
    const int hi = lane >> 5, g1 = (lane >> 4) & 1, q4 = (lane & 15) >> 2, pp = lane & 3;
    const int swz = ((q4 >> 1) & 1) << 6;
#pragma unroll
    for (int dblk = 0; dblk < 2; ++dblk)
#pragma unroll
        for (int s = 0; s < 2; ++s) {
            const int colb = (dblk * 64 + g1 * 32 + pp * 8) ^ swz;
            const int row0 = 16 * s + 4 * hi + q4;
            const s16x4 t0 = __builtin_bit_cast(s16x4, __builtin_amdgcn_ds_read_tr16_b64_v4i16((LAS s16x4*)(vb + row0 * 128 + colb)));
            const s16x4 t1 = __builtin_bit_cast(s16x4, __builtin_amdgcn_ds_read_tr16_b64_v4i16((LAS s16x4*)(vb + (row0 + 8) * 128 + colb)));
            const bf16x8 a = (bf16x8){t0[0], t0[1], t0[2], t0[3], t1[0], t1[1], t1[2], t1[3]};
            o[dblk] = __builtin_amdgcn_mfma_f32_32x32x16_bf16(a, pf[s], o[dblk], 0, 0, 0);
        }
}
__device__ __forceinline__ void dil_items(const bf16* QKV, bf16* OD3, float* LSE, LAS unsigned char* vb, int first, int stride, int lane) {
    int it = first; if (it >= 6144) return;
    const int q = lane & 31, hi = lane >> 5;
    DilGeo g = dil_geo(__builtin_amdgcn_readfirstlane(it));
    for (;;) {
        bf16x8 qf[4], kf[5][4];
        dil_load_qk(QKV, g, qf, kf, lane);
        u32x4 vr[5][4];
#pragma unroll
        for (int kt = 0; kt < 5; ++kt) dil_vload(QKV, g, vr[kt], kt, lane);
        bf16x8 pf[5][2]; float mx = -INFINITY, l = 0.f;
        {
            f32x16 s[5];
#pragma unroll
            for (int kt = 0; kt < 5; ++kt) {
                s[kt] = qk_tile(kf[kt], qf);
                if (g.i0 - 128 + 32 * kt < 0) {
#pragma unroll
                    for (int rr = 0; rr < 16; ++rr) s[kt][rr] = -INFINITY;
                }
            }
#pragma unroll
            for (int rr = 0; rr < 16; ++rr) { const int kk = crow(rr, hi); if (kk < q) s[0][rr] = -INFINITY; if (kk > q) s[4][rr] = -INFINITY; }
#pragma unroll
            for (int kt = 0; kt < 5; ++kt)
#pragma unroll
                for (int rr = 0; rr < 16; ++rr) mx = fmaxf(mx, s[kt][rr]);
            { const F2 t = pair32(mx); mx = fmaxf(t.a, t.b); }
            const float mb = mx * LOG2E;
#pragma unroll
            for (int kt = 0; kt < 5; ++kt) {
#pragma unroll
                for (int rr = 0; rr < 16; ++rr) { const float p = __builtin_amdgcn_exp2f(__builtin_fmaf(s[kt][rr], LOG2E, -mb)); s[kt][rr] = p; l += p; }
#pragma unroll
                for (int h2 = 0; h2 < 2; ++h2) { u32x4 w; w.x = pk2(s[kt][8 * h2 + 0], s[kt][8 * h2 + 1]); w.y = pk2(s[kt][8 * h2 + 2], s[kt][8 * h2 + 3]); w.z = pk2(s[kt][8 * h2 + 4], s[kt][8 * h2 + 5]); w.w = pk2(s[kt][8 * h2 + 6], s[kt][8 * h2 + 7]);
                    pf[kt][h2] = __builtin_bit_cast(bf16x8, w); }
            }
            { const F2 t = pair32(l); l = t.a + t.b; }
        }
        const int itn = it + stride; const bool more = itn < 6144;
        const DilGeo gn = dil_geo(__builtin_amdgcn_readfirstlane(more ? itn : it));
        f32x16 o[2]; o[0] = f32x16{}; o[1] = f32x16{};
#pragma unroll
        for (int kt = 0; kt < 5; ++kt) {
            LDS_WAIT();
            v_stage(vb, vr[kt], lane);
            LDS_WAIT();
            pv_tile_p(o, vb, pf[kt], lane);
        }
        const float inv = 1.0f / l;
        const size_t tok = g.rowb + (size_t)(g.i0 + q) * g.dil + g.r;
        store_ot(OD3 + (g.rowb + (size_t)g.i0 * g.dil + g.r) * 768 + g.h12 * 64 + (unsigned)q * (unsigned)(g.dil * 768), o, inv, hi);
        if (hi == 0) LSE[tok * 12 + g.h12] = mx + __logf(l);
        if (!more) break;
        it = itn; g = gn;
    }
}
__device__ __forceinline__ void sb_step(f32x16 (&o)[2], float& R, const bf16x8 (&kf)[4], const bf16x8 (&qf)[4], const u32x4 (&vr)[4], LAS unsigned char* vb, int dq, int lane) {
    const int hi = lane >> 5;
    f32x16 z = qk_tile(kf, qf);
    float gp[4];
#pragma unroll
    for (int c4 = 0; c4 < 4; ++c4) {
        float be[4], ke[4];
#pragma unroll
        for (int i = 0; i < 4; ++i) { const float zz = z[4 * c4 + i]; const float e = __builtin_amdgcn_exp2f(-fabsf(zz) * LOG2E); const float rr = __builtin_amdgcn_rcpf(1.0f + e), sm = e * rr;
            const bool pos = zz >= 0.f; const bool past = (8 * c4 + 4 * hi + i) < dq;
            be[i] = past ? (pos ? rr : sm) : 0.f; ke[i] = past ? (pos ? sm : rr) : 1.f; }
        const float e2 = ke[3], e1 = e2 * ke[2], e0 = e1 * ke[1];
        gp[c4] = e0 * ke[0];
        z[4 * c4 + 3] = be[3]; z[4 * c4 + 2] = be[2] * e2; z[4 * c4 + 1] = be[1] * e1; z[4 * c4 + 0] = be[0] * e0;
    }
    float U = R;
#pragma unroll
    for (int c4 = 3; c4 >= 0; --c4) {
        const F2 t = pair32(gp[c4]);
        const float T = (hi == 0) ? U * t.b : U;
#pragma unroll
        for (int i = 0; i < 4; ++i) z[4 * c4 + i] *= T;
        U *= t.a * t.b;
    }
    R = U;
    LDS_WAIT();
    v_stage(vb, vr, lane);
    LDS_WAIT();
    pv_tile(o, vb, z, lane);
}
__device__ __forceinline__ void sb_item(const bf16* QKV, bf16* OS, LAS unsigned char* vb, int bh, int c, int lane) {
    const int b = bh >> 2, h = bh & 3, q = lane & 31, hi = lane >> 5;
    const size_t rowb = (size_t)b * SEQ;
    const bf16* Qp = QKV + ((size_t)(36 + h) * M + rowb + 32 * c) * 64;
    const bf16* Kb = QKV + ((size_t)(40 + h) * M + rowb) * 64;
    const bf16* Vb = QKV + ((size_t)(44 + h) * M + rowb) * 64;
    bf16x8 qf[4]; ld_frag4(qf, Qp, 64, lane);
    f32x16 o[2]; o[0] = f32x16{}; o[1] = f32x16{};
    float R = 1.0f;
    bf16x8 kf[3][4]; u32x4 vr[3][4];
#pragma unroll
    for (int j = 0; j < 3; ++j) { const int t = (c - j) < 0 ? 0 : (c - j); ld_frag4(kf[j], Kb + (size_t)(32 * t) * 64, 64, lane); v_load(vr[j], Vb + (size_t)(32 * t) * 64, 64, lane); }
#if SB_EARLY_EXIT
#define SB_DONE() (__all(R < 1e-20f))
#else
#define SB_DONE() (false)
#endif
#define SB_STEP(j, kt_) do { sb_step(o, R, kf[j], qf, vr[j], vb, 32 * (c - (kt_)) + q, lane); \
        { const int t = (kt_) - 3 < 0 ? 0 : (kt_) - 3; ld_frag4(kf[j], Kb + (size_t)(32 * t) * 64, 64, lane); v_load(vr[j], Vb + (size_t)(32 * t) * 64, 64, lane); } } while (0)
    for (int kt = c; kt >= 0; kt -= 3) {
        SB_STEP(0, kt); if (kt - 1 < 0 || SB_DONE()) break;
        SB_STEP(1, kt - 1); if (kt - 2 < 0 || SB_DONE()) break;
        SB_STEP(2, kt - 2); if (SB_DONE()) break;
    }
#undef SB_STEP
#undef SB_DONE
    store_ot(OS + (rowb + 32 * c) * 256 + h * 64 + (unsigned)q * 256u, o, 1.0f, hi);
}
__device__ __forceinline__ void attn_phase(unsigned char* Pws, unsigned char* Pscr, LAS unsigned char* lds, int G, int wg, int NGW, int wave, int lane) {
    LAS unsigned char* vb = lds + wave * 4096;
    const bf16* QKV = (const bf16*)(Pws + WS_R);
    const int v = (G % 8 == 0) ? (wg % 8) * (G / 8) + wg / 8 : wg;
    const int base = v * NWAVES + wave;
    for (int it = base; it < 2048; it += NGW) { const int itu = __builtin_amdgcn_readfirstlane(it);
#if SB_EARLY_EXIT
        sb_item(QKV, (bf16*)(Pws + WS_OS), vb, itu >> 7, itu & 127, lane);
#else
        sb_item(QKV, (bf16*)(Pws + WS_OS), vb, itu >> 7, ((itu & 127) + 16 * (itu >> 8)) & 127, lane);
#endif
    }
    dil_items(QKV, (bf16*)(Pscr + OUT_OD3), (float*)(Pws + WS_LSE), vb, base, NGW, lane);
}
__device__ __forceinline__ void merge_phase(unsigned char* Pws, unsigned char* Pscr, int idx_lo, int idx_hi, int first, int stride) {
    const bf16* OD3 = (const bf16*)(Pscr + OUT_OD3); bf16* OD = (bf16*)(Pscr + OUT_OD); const float* LSE = (const float*)(Pws + WS_LSE);
    const __amdgpu_buffer_rsrc_t odr = __builtin_amdgcn_make_buffer_rsrc(OD, 0, M * 256 * 2, 0x00020000);
    for (int idx = idx_lo + first; idx < idx_hi; idx += stride) {
        const int t = idx >> 5, hh = (idx >> 3) & 3, ch = idx & 7;
        const float l0 = LSE[(size_t)t * 12 + hh], l1 = LSE[(size_t)t * 12 + 4 + hh], l2 = LSE[(size_t)t * 12 + 8 + hh];
        const float mx = fmaxf(l0, fmaxf(l1, l2)); float e0 = __expf(l0 - mx), e1 = __expf(l1 - mx), e2 = __expf(l2 - mx); const float inv = 1.0f / (e0 + e1 + e2);
        e0 *= inv; e1 *= inv; e2 *= inv;
        const u32x4 a = *(const u32x4*)(OD3 + (size_t)t * 768 + hh * 64 + ch * 8), bq = *(const u32x4*)(OD3 + (size_t)t * 768 + (4 + hh) * 64 + ch * 8), cq = *(const u32x4*)(OD3 + (size_t)t * 768 + (8 + hh) * 64 + ch * 8);
        u32x4 o;
#pragma unroll
        for (int k = 0; k < 4; ++k) {
            const float lo = e0 * __uint_as_float(a[k] << 16) + e1 * __uint_as_float(bq[k] << 16) + e2 * __uint_as_float(cq[k] << 16);
            const float hi = e0 * __uint_as_float(a[k] & 0xffff0000u) + e1 * __uint_as_float(bq[k] & 0xffff0000u) + e2 * __uint_as_float(cq[k] & 0xffff0000u);
            o[k] = pk2(lo, hi);
        }
        __builtin_amdgcn_raw_buffer_store_b128(o, odr, (unsigned)(t * 256 + hh * 64 + ch * 8) * 2u, 0,   16);
    }
}
__device__ __forceinline__ void merge_quarter(unsigned char* Pws, unsigned char* Pscr, int idx_lo, int tid) {
    const bf16* OD3 = (const bf16*)(Pscr + OUT_OD3); bf16* OD = (bf16*)(Pscr + OUT_OD); const float* LSE = (const float*)(Pws + WS_LSE);
    const __amdgpu_buffer_rsrc_t odr = __builtin_amdgcn_make_buffer_rsrc(OD, 0, M * 256 * 2, 0x00020000);
    float ls[4][3]; u32x4 v[4][3];
#pragma unroll
    for (int j = 0; j < 4; ++j) { const unsigned idx = (unsigned)(idx_lo + tid + 512 * j), t = idx >> 5, hh = (idx >> 3) & 3, ch = idx & 7;
#pragma unroll
        for (int g = 0; g < 3; ++g) { ls[j][g] = LSE[t * 12u + 4u * g + hh]; v[j][g] = *(const u32x4*)(OD3 + (t * 768u + (4u * g + hh) * 64u + ch * 8u)); } }
#pragma unroll
    for (int j = 0; j < 4; ++j) { const unsigned idx = (unsigned)(idx_lo + tid + 512 * j), t = idx >> 5, hh = (idx >> 3) & 3, ch = idx & 7;
        const float mx = fmaxf(ls[j][0], fmaxf(ls[j][1], ls[j][2])); float e0 = __expf(ls[j][0] - mx), e1 = __expf(ls[j][1] - mx), e2 = __expf(ls[j][2] - mx); const float inv = 1.0f / (e0 + e1 + e2);
        e0 *= inv; e1 *= inv; e2 *= inv;
        u32x4 o;
#pragma unroll
        for (int k = 0; k < 4; ++k) {
            const float lo = e0 * __uint_as_float(v[j][0][k] << 16) + e1 * __uint_as_float(v[j][1][k] << 16) + e2 * __uint_as_float(v[j][2][k] << 16);
            const float hi = e0 * __uint_as_float(v[j][0][k] & 0xffff0000u) + e1 * __uint_as_float(v[j][1][k] & 0xffff0000u) + e2 * __uint_as_float(v[j][2][k] & 0xffff0000u);
            o[k] = pk2(lo, hi);
        }
        __builtin_amdgcn_raw_buffer_store_b128(o, odr, (t * 256u + hh * 64u + ch * 8u) * 2u, 0,   16); }
}
__device__ __forceinline__ void panel_arrive(unsigned* cnt, int pm, int wave, int lane) {
    asm volatile("s_waitcnt vmcnt(0)" ::: "memory");
    __syncthreads();
    if (wave == 0 && lane == 0) __hip_atomic_fetch_add(cnt + 64 * pm, 1u, __ATOMIC_RELAXED, __HIP_MEMORY_SCOPE_AGENT);
}
__device__ __forceinline__ void panel_sync(unsigned* cnt, int pm, int wave, int lane) {
    asm volatile("s_waitcnt vmcnt(0)" ::: "memory");
    __syncthreads();
    if (wave == 0) {
        if (lane == 0) __hip_atomic_fetch_add(cnt + 64 * pm, 1u, __ATOMIC_RELAXED, __HIP_MEMORY_SCOPE_AGENT);
        unsigned spins = 0;
        while ((unsigned)__builtin_amdgcn_readfirstlane(__hip_atomic_load(cnt + 64 * pm, __ATOMIC_RELAXED, __HIP_MEMORY_SCOPE_AGENT)) < 4u) { __builtin_amdgcn_s_sleep(1); if (++spins > (1u << 20)) break; }
        __builtin_amdgcn_fence(__ATOMIC_ACQUIRE, "agent"); }
    asm volatile("s_waitcnt vmcnt(0) lgkmcnt(0)" ::: "memory"); __syncthreads();
}
__device__ __forceinline__ void final_phase(unsigned char* Pws, float* Pout, const float* Pnf, int gw, int NGW, int lane) {
    const float* ssqp = (const float*)(Pws + WS_SSQ); const f32x4* gf = (const f32x4*)Pnf + 2 * lane; const bf16* xb = (const bf16*)(Pws + WS_XB);
    for (int m = gw; m < M; m += NGW) {
        const float rs = pg8::row_rstd(ssqp, m);
        const u32x4* xr = (const u32x4*)(xb + (size_t)m * D) + lane; f32x4* orow = (f32x4*)(Pout + (size_t)m * D) + 2 * lane;
#pragma unroll
        for (int j = 0; j < 2; ++j) { const u32x4 w = xr[64 * j];
            const f32x4 v0 = {__uint_as_float(w.x << 16), __uint_as_float(w.x & 0xffff0000u), __uint_as_float(w.y << 16), __uint_as_float(w.y & 0xffff0000u)};
            const f32x4 v1 = {__uint_as_float(w.z << 16), __uint_as_float(w.z & 0xffff0000u), __uint_as_float(w.w << 16), __uint_as_float(w.w & 0xffff0000u)};
            orow[128 * j] = v0 * rs * gf[128 * j]; orow[128 * j + 1] = v1 * rs * gf[128 * j + 1]; }
    }
}

struct Args { const float* in[15]; float* out; unsigned char* ws; int ph_lo, ph_hi; };
constexpr int N_PHASES = 10 * DEPTH + 1;
__global__ void __launch_bounds__(NWAVES * 64, 2) fwd_megakernel(Args args) {
    extern __shared__ __attribute__((aligned(16))) unsigned char lds_raw[];
    LAS unsigned char* lds = (LAS unsigned char*)lds_raw;
    cg::grid_group grid = cg::this_grid();
    volatile LAS unsigned* bst = (volatile LAS unsigned*)(lds + 131072);
    if (threadIdx.x < 2) bst[threadIdx.x] = 0u;
    __syncthreads();
    (void)xcd_barrier_post((unsigned*)(args.ws + WS_BAR), bst);
    for (int ph = args.ph_lo; ph < args.ph_hi; ++ph) {
        const __attribute__((address_space(4))) unsigned char* ka = (const __attribute__((address_space(4))) unsigned char*)__builtin_amdgcn_kernarg_segment_ptr();
        asm volatile("" : "+s"(ka));
#define KARG(i) (*(const float* const __attribute__((address_space(4)))*)(ka + 8 * (i)))
        const float* Px = KARG(0); float* Pout = (float*)KARG(15); unsigned char* ws = (unsigned char*)KARG(16);
        int tid = threadIdx.x, G = gridDim.x, wg = blockIdx.x; asm volatile("" : "+v"(tid), "+s"(G), "+s"(wg));
        const int lane = tid & 63, wave = __builtin_amdgcn_readfirstlane(tid >> 6);
        const int gw = wave * G + wg, NGW = G * NWAVES;
        const int gtid = wg * (NWAVES * 64) + tid, NT = G * NWAVES * 64;
        unsigned char* wsw = ws + WS_W;
        float* ssqp = (float*)(ws + WS_SSQ);
        bf16* XB = (bf16*)(ws + WS_XB); bf16* H = (bf16*)(ws + WS_R); bf16* QKV = (bf16*)(ws + WS_R); bf16* GATE = (bf16*)(ws + WS_GATE);
        const int l = ph / 10, k = (ph == N_PHASES - 1) ? 10 : ph % 10;
        const bool fuse_final = (G == 256);
        if (k == 10 && fuse_final) continue;
        const bool chain = (G == 256);
        if ((k == 6 || k == 7) && chain) continue;
        if (k == 0 && l > 0) continue;
        unsigned char* dA1 = (unsigned char*)Pout + 32 * MiB;
        unsigned char* wA = (l == 0) ? wsw : dA1;
        if (k == 0) {
            { const ConvSrc CS{KARG(1), KARG(2), KARG(3), KARG(4), KARG(5), KARG(6), KARG(7), KARG(8), KARG(9), KARG(10), KARG(11), KARG(12), KARG(13)}; conv_phase(Px, CS, ws, l, lds, gw, NGW, wave, lane); }
        }
        else if (k == 1 || k == 8) {
            pg8::Gemm g{XB, (const bf16*)(k == 1 ? wA + W_1CAT : wsw + W_2CAT), M, 2 * FF, D}; pg8::StaticOrder S; S.init(M, 2 * FF, G, wg);
            { const LAS float* rsl_c = (const LAS float*)(lds + RSL_OFF); LAS float* rsl_w = (LAS float*)(lds + RSL_OFF); pg8::Unit uu;
#pragma unroll 1
              for (int i = 0; i < pg8::RSL_UNITS; ++i) if (S.next(i, uu) && tid < 256) rsl_w[i * 256 + tid] = pg8::row_rstd(ssqp, uu.pm * 256 + tid);
              __syncthreads(); (void)rsl_c; }
            pg8::EpiSwiglu E{H, ssqp, (const LAS float*)(lds + RSL_OFF)};
            pg8::gemm_phase<pg8::EpiSwiglu, pg8::StaticOrder, true, true>(lds, g, S, E);
            if ((l == 0) || (k == 1)) {
                const int rem = ((M / 256) * (2 * FF / 256)) % G; const bool idle = (rem == 0) || (wg >= rem);
                if (idle) {
                    const int nidle = (rem == 0) ? G : G - rem, iw = (rem == 0) ? wg : wg - rem;
                    const ConvSrc CS{KARG(1), KARG(2), KARG(3), KARG(4), KARG(5), KARG(6), KARG(7), KARG(8), KARG(9), KARG(10), KARG(11), KARG(12), KARG(13)};
                    const int lo = (l == 0) ? (k == 1 ? 0 : CI_IN) : CI_B, hi = (l == 0) ? (k == 1 ? CI_IN : CI_B) : CI_END;
                    conv_items(CS, 1, lo, hi, dA1, wsw, lds, wave * nidle + iw, nidle * NWAVES, wave, lane);
                }
            }
        } else if (k == 2 || k == 9) {
            pg8::Gemm g{H, (const bf16*)(k == 2 ? wA + W_D1 : wsw + W_D2), M, D, FF}; pg8::StaticOrder S; S.init(M, D, G, wg);
            if (ph == 2) { pg8::EpiResid<true> E{Px, XB, ssqp, 0.5f}; pg8::gemm_phase<pg8::EpiResid<true>, pg8::StaticOrder, true, true>(lds, g, S, E); }
            else if (ph == N_PHASES - 2 && fuse_final) { pg8::EpiResidFinal E{XB, Pout, KARG(14), (unsigned*)(ws + WS_XSLOT), (unsigned*)(ws + WS_CNT), 0.5f};
                pg8::gemm_phase<pg8::EpiResidFinal, pg8::StaticOrder, true, true>(lds, g, S, E); }
            else { pg8::EpiResid<false> E{nullptr, XB, ssqp, 0.5f}; pg8::gemm_phase<pg8::EpiResid<false>, pg8::StaticOrder, true, true>(lds, g, S, E); }
        } else if (k == 3) {
            pg8::Gemm g{XB, (const bf16*)(wA + W_IN), M, NIN, D}; pg8::StaticOrder S; S.init(M, NIN, G, wg);
            { const LAS float* rsl_c = (const LAS float*)(lds + RSL_OFF); LAS float* rsl_w = (LAS float*)(lds + RSL_OFF); pg8::Unit uu;
#pragma unroll 1
              for (int i = 0; i < pg8::RSL_UNITS; ++i) if (S.next(i, uu) && tid < 256) rsl_w[i * 256 + tid] = pg8::row_rstd(ssqp, uu.pm * 256 + tid);
              __syncthreads(); (void)rsl_c; }
            pg8::EpiWin E{QKV, GATE, ssqp, (const float*)(ws + WS_ROPE), (const LAS float*)(lds + RSL_OFF)};
            pg8::gemm_phase<pg8::EpiWin, pg8::StaticOrder, true, true>(lds, g, S, E);
        } else if (k == 4) {
            attn_phase(ws, (unsigned char*)Pout, lds, G, wg, NGW, wave, lane);
        }
        else if (k == 5) {
            pg8::Unit pu; { pg8::StaticOrder S; S.init(M, D, G, wg); S.next(0, pu); }
            unsigned* pcnt = (unsigned*)(ws + WS_PCNT) + (size_t)l * 2 * 4096;
            if (chain) { const int r0 = pu.pm * 256 + pu.pn * 64; merge_quarter(ws, (unsigned char*)Pout, r0 * 32, tid); panel_arrive(pcnt, pu.pm, wave, lane); }
            else merge_phase(ws, (unsigned char*)Pout, 0, M * 32, gtid, NT);
            if (chain) {
                int K256 = 256; asm volatile("" : "+s"(K256));
                { pg8::Gemm g{(const bf16*)(ws + WS_OS), (const bf16*)(wsw + W_PS), M, D, K256, (const bf16*)((unsigned char*)Pout + OUT_OD), (const bf16*)(wsw + W_PD)}; pg8::PairOrder S; S.init(M, D, G, wg); S.cnt = pcnt;
                  pg8::EpiGate2 E{GATE, (bf16*)(ws + WS_Y1), (bf16*)(ws + WS_Y)};
                  pg8::gemm_phase<pg8::EpiGate2, pg8::PairOrder, true, true>(lds, g, S, E); }
                panel_sync(pcnt + 4096, pu.pm, wave, lane);
                { pg8::Gemm g{(const bf16*)(ws + WS_Y), (const bf16*)(wsw + W_OUT), M, D, D}; pg8::StaticOrder S; S.init(M, D, G, wg);
                  pg8::EpiResid<false> E{nullptr, XB, ssqp, 1.0f};
                  pg8::gemm_phase<pg8::EpiResid<false>, pg8::StaticOrder, true, true>(lds, g, S, E); }
            }
        }
        else if (k == 6) {
            int K256 = 256; asm volatile("" : "+s"(K256));
            { pg8::Gemm g{(const bf16*)((unsigned char*)Pout + OUT_OD), (const bf16*)(wsw + W_PD), M, D, K256}; pg8::StaticOrder S; S.init(M, D, G, wg);
              pg8::EpiGate<false> E{GATE, (bf16*)(ws + WS_Y1), (bf16*)(ws + WS_Y)};
              pg8::gemm_phase<pg8::EpiGate<false>, pg8::StaticOrder, true, true>(lds, g, S, E); }
            { pg8::Gemm g{(const bf16*)(ws + WS_OS), (const bf16*)(wsw + W_PS), M, D, K256}; pg8::StaticOrder S; S.init(M, D, G, wg);
              pg8::EpiGate<true> E{GATE + 1024, (bf16*)(ws + WS_Y1), (bf16*)(ws + WS_Y)};
              pg8::gemm_phase<pg8::EpiGate<true>, pg8::StaticOrder, true, true>(lds, g, S, E); }
        } else if (k == 7) {
            pg8::Gemm g{(const bf16*)(ws + WS_Y), (const bf16*)(wsw + W_OUT), M, D, D}; pg8::StaticOrder S; S.init(M, D, G, wg);
            pg8::EpiResid<false> E{nullptr, XB, ssqp, 1.0f};
            pg8::gemm_phase<pg8::EpiResid<false>, pg8::StaticOrder, true, true>(lds, g, S, E);
        } else final_phase(ws, Pout, KARG(14), gw, NGW, lane);
        if (ph + 1 < args.ph_hi && !(fuse_final && ph == N_PHASES - 2)) {
            unsigned* barw = (unsigned*)(ws + WS_BAR);
            if (args.ph_hi > 1000) grid.sync();
            { XcdBarrier bar; bar.bar = barw; bar.x = xb_xcc_id(); bar.st = bst; xcd_barrier(bar);
            }
        }
    }
}

extern "C" void kernel_launch(void* const* d_in, const int* in_sizes, int n_in, void* d_out, int out_size, void* d_ws, size_t ws_size, hipStream_t stream) {
    static int grid = 0;
    if (grid == 0) {
        if (n_in != 15 || in_sizes[0] != M * D || out_size != M * D || ws_size < WS_END) { fprintf(stderr, "kernel_launch: unexpected shapes (n_in %d, in0 %d, out %d, ws %zu)\n", n_in, n_in > 0 ? in_sizes[0] : -1, out_size, ws_size); grid = -1; return; }
        int dev = 0, cus = 0, per_cu = 0;
        if (hipGetDevice(&dev) != hipSuccess || hipDeviceGetAttribute(&cus, hipDeviceAttributeMultiprocessorCount, dev) != hipSuccess) { grid = -1; return; }
        if (hipFuncSetAttribute((const void*)fwd_megakernel, hipFuncAttributeMaxDynamicSharedMemorySize, LDS_BYTES) != hipSuccess) { fprintf(stderr, "kernel_launch: hipFuncSetAttribute failed\n"); grid = -1; return; }
        if (hipOccupancyMaxActiveBlocksPerMultiprocessor(&per_cu, (const void*)fwd_megakernel, NWAVES * 64, LDS_BYTES) != hipSuccess || per_cu < 1) { fprintf(stderr, "kernel_launch: occupancy query says %d\n", per_cu); per_cu = 1; }
        (void)hipGetLastError();
        grid = cus;
        if (grid < 176) { fprintf(stderr, "kernel_launch: %d CUs: the per-workgroup rstd table holds 8 units per GEMM phase (needs >= 176 workgroups)\n", grid); grid = -1; return; }
    }
    if (grid < 0) return;
    Args a{};
    for (int i = 0; i < 15; ++i) a.in[i] = (const float*)d_in[i];
    a.out = (float*)d_out; a.ws = (unsigned char*)d_ws;
#if N_LAUNCH_MODE == 0
    a.ph_lo = 0; a.ph_hi = N_PHASES;
    if (hipMemsetAsync((char*)d_ws + WS_BAR, 0, WS_ZERO_BYTES, stream) != hipSuccess) { fprintf(stderr, "kernel_launch: memset of the barrier words failed\n"); return; }
    void* kargs[] = {&a};
    const hipError_t e = hipLaunchCooperativeKernel((const void*)fwd_megakernel, dim3(grid), dim3(NWAVES * 64), kargs, LDS_BYTES, stream);
    if (e != hipSuccess) fprintf(stderr, "kernel_launch: cooperative launch failed: %s (grid %d)\n", hipGetErrorString(e), grid);
#else
    for (int ph = 0; ph < N_PHASES; ++ph) {
        a.ph_lo = ph; a.ph_hi = ph + 1;
        hipLaunchKernelGGL(fwd_megakernel, dim3(grid), dim3(NWAVES * 64), LDS_BYTES, stream, a);
    }
#endif
}
```

```cpp
#include <hip/hip_runtime.h>
#include <hip/hip_cooperative_groups.h>
#include <cstdio>
#include <cstdint>
namespace cg = cooperative_groups;
namespace pg8 {
#define PG8_LAS __attribute__((address_space(3)))
typedef unsigned short bf16_t;
typedef short bf16x8 __attribute__((ext_vector_type(8)));
typedef float f32x4 __attribute__((ext_vector_type(4)));
typedef unsigned u32x4 __attribute__((ext_vector_type(4)));
constexpr int BM = 256, BK = 64, HALF = 128, HTB = HALF * BK * 2  , STAGE_BYTES = 8 * HTB, NXCD = 8, WGM = 8;

__host__ __device__ __forceinline__ int lds_byte(int r, int c) { const int st = (r >> 4) * 2 + (c >> 5), rr = r & 15, cc = c & 31, ob = rr * 64 + cc * 2; return st * 1024 + (ob ^ (((ob >> 9) & 1) << 5)); }
__host__ __device__ __forceinline__ void stage_rc(int b, int& R, int& C) { const int st = b / 1024, sb = b % 1024, swz = sb ^ (((sb >> 9) & 1) << 5); R = (st >> 1) * 16 + swz / 64; C = (st & 1) * 32 + (swz % 64) / 2; }
__host__ __device__ __forceinline__ int perm32(int rho) { const int n = rho >> 4, i = rho & 15; return 8 * (i >> 2) + 4 * n + (i & 3); }

struct Unit { int pm, pn, ui, sel; };
struct Gemm { const bf16_t* A; const bf16_t* Bt; int M, N, K; const bf16_t* A2 = nullptr; const bf16_t* Bt2 = nullptr; };

struct StaticOrder {
    int nM, nN, nwg, G, c;
    __host__ __device__ void init(int M, int N, int G_, int c_) { nM = M / BM; nN = N / BM; nwg = nM * nN; G = G_; c = c_; }
    __host__ __device__ bool next(int i, Unit& u) const {
        const long L = (long)i * G + c; if (L >= nwg) return false;
        int wgid = (int)L; { const int q = nwg / NXCD, r = nwg % NXCD, xcd = wgid % NXCD, off = wgid / NXCD; wgid = (xcd < r ? xcd * (q + 1) : r * (q + 1) + (xcd - r) * q) + off; }
        const int nig = WGM * nN, gid = wgid / nig, fm = gid * WGM, gsz = (nM - fm) < WGM ? (nM - fm) : WGM;
        u.pm = fm + ((wgid % nig) % gsz); u.pn = (wgid % nig) / gsz; u.ui = i; u.sel = 0; return true;
    }
    __device__ __forceinline__ void a_ready(const Unit&) const {}
    __device__ __forceinline__ void done(const Unit&) const {}
};
struct PairOrder : StaticOrder {
    unsigned* cnt;
    __host__ __device__ bool next(int i, Unit& u) const { if (i >= 2) return false; if (!StaticOrder::next(0, u)) return false; u.ui = i; u.sel = i; return true; }
    __device__ __forceinline__ void a_ready(const Unit& u) const {
        if (u.sel == 1 && cnt != nullptr) {
            if (threadIdx.x < 64) { unsigned spins = 0;
                while ((unsigned)__builtin_amdgcn_readfirstlane(__hip_atomic_load(cnt + 64 * u.pm, __ATOMIC_RELAXED, __HIP_MEMORY_SCOPE_AGENT)) < 4u) { __builtin_amdgcn_s_sleep(1); if (++spins > (1u << 20)) break; }
                __builtin_amdgcn_fence(__ATOMIC_ACQUIRE, "agent");
                asm volatile("s_waitcnt vmcnt(0)" ::: "memory"); }
            asm volatile("" ::: "memory"); __builtin_amdgcn_s_barrier(); asm volatile("" ::: "memory");
        }
    }
};

typedef float f32x2_cv __attribute__((ext_vector_type(2))); typedef __bf16 bf16x2_cv __attribute__((ext_vector_type(2)));
__device__ __forceinline__ unsigned cvt_pk_bf16(float lo, float hi) { const f32x2_cv v = {lo, hi}; const bf16x2_cv b = __builtin_convertvector(v, bf16x2_cv); return __builtin_bit_cast(unsigned, b); }
typedef unsigned u32x2 __attribute__((ext_vector_type(2)));
constexpr float LOG2E = 1.4426950408889634f;
constexpr int RSL_UNITS = 8;
__device__ __forceinline__ float row_rstd(const float* ssqp, int r) {
    const f32x4* p = (const f32x4*)(ssqp + (size_t)r * 16);
    const f32x4 a = p[0], b = p[1], c = p[2], d = p[3];
    const float s = (((a[0] + a[1]) + (a[2] + a[3])) + ((b[0] + b[1]) + (b[2] + b[3]))) + (((c[0] + c[1]) + (c[2] + c[3])) + ((d[0] + d[1]) + (d[2] + d[3])));
    return __builtin_amdgcn_rsqf(s * (1.0f / 1024.0f) + 1e-6f);
}
__device__ __forceinline__ float bf2f(unsigned short b) { return __uint_as_float(((unsigned)b) << 16); }
struct EpiSwiglu {
    static constexpr bool PERM = true, AFTER_DRAIN = false, HAS_INIT = false;
    bf16_t* H; const float* ssqp; const PG8_LAS float* rsl;
    __device__ __forceinline__ void operator()(const f32x4 (&acc)[2][2][4][2], const Unit& u, int wr, int wc, int fr, int fq) const {
        const int row0 = u.pm * BM + wr * 64 + fr, col0 = u.pn * 128 + wc * 32 + 8 * fq;
#pragma unroll
        for (int ai = 0; ai < 2; ++ai)
#pragma unroll
            for (int m = 0; m < 4; ++m) {
                const int r = row0 + ai * HALF + m * 16; const float rs = rsl[u.ui * 256 + ai * HALF + wr * 64 + m * 16 + fr];
                const float nrl = -rs * LOG2E, rs2 = rs * rs; f32x4 hq[2];
#pragma unroll
                for (int n = 0; n < 2; ++n) { const f32x4 ga = acc[ai][0][m][n], ua = acc[ai][1][m][n]; const f32x4 x = ga * nrl; f32x4 e;
                    e[0] = __builtin_amdgcn_exp2f(x[0]); e[1] = __builtin_amdgcn_exp2f(x[1]); e[2] = __builtin_amdgcn_exp2f(x[2]); e[3] = __builtin_amdgcn_exp2f(x[3]);
                    const f32x4 d = e + 1.0f; f32x4 rc; rc[0] = __builtin_amdgcn_rcpf(d[0]); rc[1] = __builtin_amdgcn_rcpf(d[1]); rc[2] = __builtin_amdgcn_rcpf(d[2]); rc[3] = __builtin_amdgcn_rcpf(d[3]);
                    hq[n] = (ga * ua) * (rc * rs2); }
                u32x4 w; w.x = cvt_pk_bf16(hq[0][0], hq[0][1]); w.y = cvt_pk_bf16(hq[0][2], hq[0][3]); w.z = cvt_pk_bf16(hq[1][0], hq[1][1]); w.w = cvt_pk_bf16(hq[1][2], hq[1][3]);
                *(u32x4*)(H + ((unsigned)r * 2816u + (unsigned)col0)) = w;
            }
    }
};
template <bool BASE32> struct EpiResid {
    static constexpr bool PERM = true, AFTER_DRAIN = false, HAS_INIT = true;
    const float* base32; bf16_t* xb; float* ssqp; float alpha;
    __device__ __forceinline__ void init(f32x4 (&acc)[2][2][4][2], const Unit& u, int wr, int wc, int fr, int fq) const {
        const unsigned row0 = u.pm * BM + wr * 64 + fr, col0 = u.pn * BM + wc * 32 + 8 * fq; const float ia = 1.0f / alpha;
#pragma unroll
        for (int ai = 0; ai < 2; ++ai)
#pragma unroll
            for (int m = 0; m < 4; ++m)
#pragma unroll
                for (int bj = 0; bj < 2; ++bj) { const unsigned off = (row0 + ai * HALF + m * 16) * 1024u + col0 + bj * HALF;
                    f32x4 b0, b1;
                    if (BASE32) { b0 = *(const f32x4*)(base32 + off); b1 = *(const f32x4*)(base32 + off + 4); }
                    else { const u32x4 bw = *(const u32x4*)(xb + off);
                        b0[0] = __uint_as_float(bw.x << 16); b0[1] = __uint_as_float(bw.x & 0xffff0000u); b0[2] = __uint_as_float(bw.y << 16); b0[3] = __uint_as_float(bw.y & 0xffff0000u);
                        b1[0] = __uint_as_float(bw.z << 16); b1[1] = __uint_as_float(bw.z & 0xffff0000u); b1[2] = __uint_as_float(bw.w << 16); b1[3] = __uint_as_float(bw.w & 0xffff0000u); }
                    acc[ai][bj][m][0] = b0 * ia; acc[ai][bj][m][1] = b1 * ia; }
    }
    __device__ __forceinline__ void operator()(const f32x4 (&acc)[2][2][4][2], const Unit& u, int wr, int wc, int fr, int fq) const {
        const unsigned row0 = u.pm * BM + wr * 64 + fr, col0 = u.pn * BM + wc * 32 + 8 * fq;
#pragma unroll
        for (int ai = 0; ai < 2; ++ai)
#pragma unroll
            for (int m = 0; m < 4; ++m) {
                const unsigned r = row0 + ai * HALF + m * 16; float s = 0.f;
#pragma unroll
                for (int bj = 0; bj < 2; ++bj) { const unsigned off = r * 1024u + col0 + bj * HALF;
                    const f32x4 o0 = acc[ai][bj][m][0] * alpha, o1 = acc[ai][bj][m][1] * alpha;
                    u32x4 w; w.x = cvt_pk_bf16(o0[0], o0[1]); w.y = cvt_pk_bf16(o0[2], o0[3]); w.z = cvt_pk_bf16(o1[0], o1[1]); w.w = cvt_pk_bf16(o1[2], o1[3]);
                    *(u32x4*)(xb + off) = w;
                    f32x4 q0, q1;
                    q0[0] = __uint_as_float(w.x << 16); q0[1] = __uint_as_float(w.x & 0xffff0000u); q0[2] = __uint_as_float(w.y << 16); q0[3] = __uint_as_float(w.y & 0xffff0000u);
                    q1[0] = __uint_as_float(w.z << 16); q1[1] = __uint_as_float(w.z & 0xffff0000u); q1[2] = __uint_as_float(w.w << 16); q1[3] = __uint_as_float(w.w & 0xffff0000u);
                    const f32x4 sq = q0 * q0 + q1 * q1; s += (sq[0] + sq[1]) + (sq[2] + sq[3]); }
                { const auto t16 = __builtin_amdgcn_permlane16_swap(__float_as_uint(s), __float_as_uint(s), false, false); s = __uint_as_float(t16[0]) + __uint_as_float(t16[1]);
                  const auto t32 = __builtin_amdgcn_permlane32_swap(__float_as_uint(s), __float_as_uint(s), false, false); s = __uint_as_float(t32[0]) + __uint_as_float(t32[1]); }
                if (fq == 0) ssqp[r * 16u + u.pn * 4 + wc] = s;
            }
    }
};
struct EpiResidFinal {
    static constexpr bool PERM = true, AFTER_DRAIN = true, HAS_INIT = true;
    const bf16_t* xb; float* out; const float* gain; unsigned* xslot; unsigned* cnt; float alpha;
    __device__ __forceinline__ void init(f32x4 (&acc)[2][2][4][2], const Unit& u, int wr, int wc, int fr, int fq) const {
        const unsigned row0 = u.pm * BM + wr * 64 + fr, col0 = u.pn * BM + wc * 32 + 8 * fq; const float ia = 1.0f / alpha;
#pragma unroll
        for (int ai = 0; ai < 2; ++ai)
#pragma unroll
            for (int m = 0; m < 4; ++m)
#pragma unroll
                for (int bj = 0; bj < 2; ++bj) { const unsigned off = (row0 + ai * HALF + m * 16) * 1024u + col0 + bj * HALF; const u32x4 bw = *(const u32x4*)(xb + off); f32x4 b0, b1;
                    b0[0] = __uint_as_float(bw.x << 16); b0[1] = __uint_as_float(bw.x & 0xffff0000u); b0[2] = __uint_as_float(bw.y << 16); b0[3] = __uint_as_float(bw.y & 0xffff0000u);
                    b1[0] = __uint_as_float(bw.z << 16); b1[1] = __uint_as_float(bw.z & 0xffff0000u); b1[2] = __uint_as_float(bw.w << 16); b1[3] = __uint_as_float(bw.w & 0xffff0000u);
                    acc[ai][bj][m][0] = b0 * ia; acc[ai][bj][m][1] = b1 * ia; }
    }
    __device__ __forceinline__ void fused(f32x4 (&acc)[2][2][4][2], const Unit& u, int wr, int wc, int fr, int fq, PG8_LAS unsigned char* lds, int wid, int lane) const {
        PG8_LAS float* P = (PG8_LAS float*)lds;
        PG8_LAS float* S = (PG8_LAS float*)(lds + 4096);
        const int tid = wid * 64 + lane;
#pragma unroll
        for (int ai = 0; ai < 2; ++ai)
#pragma unroll
            for (int m = 0; m < 4; ++m) { float s = 0.f;
#pragma unroll
                for (int bj = 0; bj < 2; ++bj)
#pragma unroll
                    for (int n = 0; n < 2; ++n) { const f32x4 o = acc[ai][bj][m][n] * alpha; acc[ai][bj][m][n] = o; const f32x4 q = o * o; s += (q[0] + q[1]) + (q[2] + q[3]); }
                { const auto t16 = __builtin_amdgcn_permlane16_swap(__float_as_uint(s), __float_as_uint(s), false, false); s = __uint_as_float(t16[0]) + __uint_as_float(t16[1]);
                  const auto t32 = __builtin_amdgcn_permlane32_swap(__float_as_uint(s), __float_as_uint(s), false, false); s = __uint_as_float(t32[0]) + __uint_as_float(t32[1]); }
                if (fq == 0) P[(ai * HALF + wr * 64 + m * 16 + fr) * 4 + wc] = s; }
        asm volatile("s_waitcnt lgkmcnt(0)" ::: "memory"); __builtin_amdgcn_s_barrier(); asm volatile("" ::: "memory");
        if (tid < 256) { const float t = (P[tid * 4 + 0] + P[tid * 4 + 1]) + (P[tid * 4 + 2] + P[tid * 4 + 3]);
            __hip_atomic_store(xslot + ((size_t)(u.pm * BM + tid) * 4 + u.pn), __float_as_uint(t), __ATOMIC_RELAXED, __HIP_MEMORY_SCOPE_AGENT); }
        asm volatile("s_waitcnt vmcnt(0)" ::: "memory");
        if (lane == 0) __hip_atomic_fetch_add(cnt + 64 * u.pm, 1u, __ATOMIC_RELAXED, __HIP_MEMORY_SCOPE_AGENT);
        if (wid == 0) { unsigned spins = 0;
            while ((unsigned)__builtin_amdgcn_readfirstlane(__hip_atomic_load(cnt + 64 * u.pm, __ATOMIC_RELAXED, __HIP_MEMORY_SCOPE_AGENT)) < 32u) { __builtin_amdgcn_s_sleep(2); if (++spins > (1u << 20)) break; }
            __builtin_amdgcn_fence(__ATOMIC_ACQUIRE, "agent"); }
        asm volatile("s_waitcnt vmcnt(0) lgkmcnt(0)" ::: "memory"); __builtin_amdgcn_s_barrier(); asm volatile("" ::: "memory");
        if (tid < 256) { const unsigned* sl = xslot + (size_t)(u.pm * BM + tid) * 4; float t = 0.f;
#pragma unroll
            for (int k = 0; k < 4; ++k) t += __uint_as_float(__hip_atomic_load(sl + k, __ATOMIC_RELAXED, __HIP_MEMORY_SCOPE_AGENT));
            S[tid] = __builtin_amdgcn_rsqf(t * (1.0f / 1024.0f) + 1e-6f); }
        asm volatile("s_waitcnt vmcnt(0) lgkmcnt(0)" ::: "memory"); __builtin_amdgcn_s_barrier(); asm volatile("" ::: "memory");
        const unsigned row0 = u.pm * BM + wr * 64 + fr, col0 = u.pn * BM + wc * 32 + 8 * fq;
        f32x4 gv[2][2];
#pragma unroll
        for (int bj = 0; bj < 2; ++bj) { gv[bj][0] = *(const f32x4*)(gain + col0 + bj * HALF); gv[bj][1] = *(const f32x4*)(gain + col0 + bj * HALF + 4); }
#pragma unroll
        for (int ai = 0; ai < 2; ++ai)
#pragma unroll
            for (int m = 0; m < 4; ++m) { const float rs = S[ai * HALF + wr * 64 + m * 16 + fr]; const unsigned r = row0 + ai * HALF + m * 16;
#pragma unroll
                for (int bj = 0; bj < 2; ++bj) { float* op = out + (r * 1024u + col0 + bj * HALF);
                    *(f32x4*)op = acc[ai][bj][m][0] * rs * gv[bj][0]; *(f32x4*)(op + 4) = acc[ai][bj][m][1] * rs * gv[bj][1]; } }
    }
};
struct EpiWin {
    static constexpr bool PERM = true, AFTER_DRAIN = false, HAS_INIT = false;
    bf16_t* QKV; bf16_t* GATE; const float* ssqp; const float* rope; const PG8_LAS float* rsl;
    __device__ __forceinline__ void operator()(const f32x4 (&acc)[2][2][4][2], const Unit& u, int wr, int wc, int fr, int fq) const {
        const int row0 = u.pm * BM + wr * 64 + fr; const int pn = u.pn; const bool isgate = pn >= 12;
        const bool dorope = (pn < 6) && ((wc & 1) == 0) && (fq < 2); const float qs = (pn < 3 || pn == 9) ? 0.125f : 1.0f;
#pragma unroll
        for (int ai = 0; ai < 2; ++ai)
#pragma unroll
            for (int m = 0; m < 4; ++m) {
                const int r = row0 + ai * HALF + m * 16; const float rs = rsl[u.ui * 256 + ai * HALF + wr * 64 + m * 16 + fr]; const int t = r & 4095;
#pragma unroll
                for (int bj = 0; bj < 2; ++bj) {
                    const int colt = bj * HALF + wc * 32 + 8 * fq; float v[8];
#pragma unroll
                    for (int n = 0; n < 2; ++n)
#pragma unroll
                        for (int j = 0; j < 4; ++j) v[n * 4 + j] = acc[ai][bj][m][n][j] * rs;
                    bf16_t* dst;
                    if (isgate) {
#pragma unroll
                        for (int i = 0; i < 8; ++i) v[i] = __builtin_amdgcn_rcpf(1.0f + __builtin_amdgcn_exp2f(-v[i] * LOG2E));
                        dst = GATE + ((unsigned)r * 2048u + (unsigned)((pn - 12) * 256 + colt));
                    } else {
                        if (dorope) {
                            const f32x4* cs = (const f32x4*)(rope + ((unsigned)t * 16u + 8u * (unsigned)fq));
                            const f32x4 c01 = cs[0], c23 = cs[1];
                            { const float x1 = v[0], x2 = v[1]; v[0] = x1 * c01[0] - x2 * c01[1]; v[1] = x2 * c01[0] + x1 * c01[1]; }
                            { const float x1 = v[2], x2 = v[3]; v[2] = x1 * c01[2] - x2 * c01[3]; v[3] = x2 * c01[2] + x1 * c01[3]; }
                            { const float x1 = v[4], x2 = v[5]; v[4] = x1 * c23[0] - x2 * c23[1]; v[5] = x2 * c23[0] + x1 * c23[1]; }
                            { const float x1 = v[6], x2 = v[7]; v[6] = x1 * c23[2] - x2 * c23[3]; v[7] = x2 * c23[2] + x1 * c23[3]; }
                        }
#pragma unroll
                        for (int i = 0; i < 8; ++i) v[i] *= qs;
                        { const unsigned cc = (unsigned)(pn * 256 + colt); dst = QKV + (((cc >> 6) * 16384u + (unsigned)r) * 64u + (cc & 63u)); }
                    }
                    u32x4 w; w.x = cvt_pk_bf16(v[0], v[1]); w.y = cvt_pk_bf16(v[2], v[3]); w.z = cvt_pk_bf16(v[4], v[5]); w.w = cvt_pk_bf16(v[6], v[7]);
                    *(u32x4*)dst = w;
                }
                asm volatile("" ::: "memory");
            }
    }
};
template <bool SECOND> struct EpiGate {
    static constexpr bool PERM = true, AFTER_DRAIN = false, HAS_INIT = false;
    const bf16_t* gate; bf16_t* Y1; bf16_t* Y;
    __device__ __forceinline__ void operator()(const f32x4 (&acc)[2][2][4][2], const Unit& u, int wr, int wc, int fr, int fq) const {
        const unsigned row0 = u.pm * BM + wr * 64 + fr, col0 = u.pn * BM + wc * 32 + 8 * fq;
#pragma unroll
        for (int ai = 0; ai < 2; ++ai)
#pragma unroll
            for (int m = 0; m < 4; ++m) {
                const unsigned r = row0 + ai * HALF + m * 16;
#pragma unroll
                for (int bj = 0; bj < 2; ++bj) {
                    const unsigned c = col0 + bj * HALF; const unsigned go = r * 2048u + c, yo = r * 1024u + c;
                    const u32x4 gw = *(const u32x4*)(gate + go);
                    f32x4 a0 = acc[ai][bj][m][0], a1 = acc[ai][bj][m][1];
                    a0[0] *= __uint_as_float(gw.x << 16); a0[1] *= __uint_as_float(gw.x & 0xffff0000u); a0[2] *= __uint_as_float(gw.y << 16); a0[3] *= __uint_as_float(gw.y & 0xffff0000u);
                    a1[0] *= __uint_as_float(gw.z << 16); a1[1] *= __uint_as_float(gw.z & 0xffff0000u); a1[2] *= __uint_as_float(gw.w << 16); a1[3] *= __uint_as_float(gw.w & 0xffff0000u);
                    if (!SECOND) { u32x4 w; w.x = cvt_pk_bf16(a0[0], a0[1]); w.y = cvt_pk_bf16(a0[2], a0[3]); w.z = cvt_pk_bf16(a1[0], a1[1]); w.w = cvt_pk_bf16(a1[2], a1[3]); *(u32x4*)(Y1 + yo) = w; }
                    else { const u32x4 yw = *(const u32x4*)(Y1 + yo);
                        a0[0] += __uint_as_float(yw.x << 16); a0[1] += __uint_as_float(yw.x & 0xffff0000u); a0[2] += __uint_as_float(yw.y << 16); a0[3] += __uint_as_float(yw.y & 0xffff0000u);
                        a1[0] += __uint_as_float(yw.z << 16); a1[1] += __uint_as_float(yw.z & 0xffff0000u); a1[2] += __uint_as_float(yw.w << 16); a1[3] += __uint_as_float(yw.w & 0xffff0000u);
                        u32x4 w; w.x = cvt_pk_bf16(a0[0], a0[1]); w.y = cvt_pk_bf16(a0[2], a0[3]); w.z = cvt_pk_bf16(a1[0], a1[1]); w.w = cvt_pk_bf16(a1[2], a1[3]);
                        __builtin_amdgcn_raw_buffer_store_b128(w, __builtin_amdgcn_make_buffer_rsrc(Y, 0, 16384 * 1024 * 2, 0x00020000), yo * 2u, 0,   16); }
                    asm volatile("" ::: "memory");
                }
            }
    }
};
struct EpiGate2 {
    static constexpr bool PERM = true, AFTER_DRAIN = false, HAS_INIT = false;
    const bf16_t* gate; bf16_t* Y1; bf16_t* Y;
    __device__ __forceinline__ void operator()(const f32x4 (&acc)[2][2][4][2], const Unit& u, int wr, int wc, int fr, int fq) const {
        const unsigned row0 = u.pm * BM + wr * 64 + fr, col0 = u.pn * BM + wc * 32 + 8 * fq; const bool second = u.sel != 0; const unsigned gofs = second ? 0u : 1024u;
#pragma unroll
        for (int ai = 0; ai < 2; ++ai)
#pragma unroll
            for (int m = 0; m < 4; ++m) {
                const unsigned r = row0 + ai * HALF + m * 16;
#pragma unroll
                for (int bj = 0; bj < 2; ++bj) {
                    const unsigned c = col0 + bj * HALF; const unsigned go = r * 2048u + gofs + c, yo = r * 1024u + c;
                    const u32x4 gw = __builtin_nontemporal_load((const u32x4*)(gate + go));
                    f32x4 a0 = acc[ai][bj][m][0], a1 = acc[ai][bj][m][1];
                    a0[0] *= __uint_as_float(gw.x << 16); a0[1] *= __uint_as_float(gw.x & 0xffff0000u); a0[2] *= __uint_as_float(gw.y << 16); a0[3] *= __uint_as_float(gw.y & 0xffff0000u);
                    a1[0] *= __uint_as_float(gw.z << 16); a1[1] *= __uint_as_float(gw.z & 0xffff0000u); a1[2] *= __uint_as_float(gw.w << 16); a1[3] *= __uint_as_float(gw.w & 0xffff0000u);
                    if (second) { const u32x4 yw = *(const u32x4*)(Y1 + yo);
                        a0[0] += __uint_as_float(yw.x << 16); a0[1] += __uint_as_float(yw.x & 0xffff0000u); a0[2] += __uint_as_float(yw.y << 16); a0[3] += __uint_as_float(yw.y & 0xffff0000u);
                        a1[0] += __uint_as_float(yw.z << 16); a1[1] += __uint_as_float(yw.z & 0xffff0000u); a1[2] += __uint_as_float(yw.w << 16); a1[3] += __uint_as_float(yw.w & 0xffff0000u); }
                    u32x4 w; w.x = cvt_pk_bf16(a0[0], a0[1]); w.y = cvt_pk_bf16(a0[2], a0[3]); w.z = cvt_pk_bf16(a1[0], a1[1]); w.w = cvt_pk_bf16(a1[2], a1[3]);
                    if (second) __builtin_amdgcn_raw_buffer_store_b128(w, __builtin_amdgcn_make_buffer_rsrc(Y, 0, 16384 * 1024 * 2, 0x00020000), yo * 2u, 0,   16);
                    else *(u32x4*)(Y1 + yo) = w;
                    asm volatile("" ::: "memory");
                }
            }
    }
};

template <class Epi, class Sched, bool ALIGN_EPI = false, bool SP2 = false>
__device__ __forceinline__ void gemm_phase(PG8_LAS unsigned char* lds, const Gemm g, const Sched& S, const Epi& E) {
    int tid_ = threadIdx.x; asm volatile("" : "+v"(tid_));
    const int tid = tid_, wid = __builtin_amdgcn_readfirstlane(tid >> 6), lane = tid & 63, wr = wid >> 2, wc = wid & 3, fr = lane & 15, fq = lane >> 4;
    const int K = g.K, nt = K / BK;
    unsigned voffA[2], voffB[2];
#pragma unroll
    for (int i = 0; i < 2; ++i) { int R, C; stage_rc(tid * 16 + i * 8192, R, C); const int Rb = Epi::PERM ? ((R & ~31) + perm32(R & 31)) : R;
        voffA[i] = (unsigned)(R * K + C) * 2u; voffB[i] = (unsigned)(Rb * K + C) * 2u; }
    const size_t kstep = (size_t)(BK * 2);
    const size_t hstep = (size_t)HALF * K * 2;
    const size_t tstep = 2 * hstep;
    const unsigned ldsw = (unsigned)wid * 1024u;
    const int aoff = lds_byte(wr * 64 + fr, fq * 8), boff = lds_byte(wc * 32 + fr, fq * 8);
#define PG8_SA(b, h) (((b) * 2 + (h)) * HTB)
#define PG8_SB(b, h) ((4 + (b) * 2 + (h)) * HTB)
#define PG8_STAGE(bufoff, gbase, voff) do { _Pragma("unroll") for (int _i = 0; _i < 2; ++_i) \
        __builtin_amdgcn_global_load_lds((const unsigned*)((const char*)(gbase) + (voff)[_i]), (PG8_LAS unsigned*)(lds + (bufoff) + ldsw + _i * 8192), 16, 0, 0); } while (0)
#define PG8_LDA(dst, b, h) do { _Pragma("unroll") for (int m = 0; m < 4; ++m) _Pragma("unroll") for (int k = 0; k < 2; ++k) dst[m][k] = *(const PG8_LAS bf16x8*)(lds + PG8_SA(b, h) + aoff + m * 2048 + k * 1024); } while (0)
#define PG8_LDB(dst, b, h) do { _Pragma("unroll") for (int n = 0; n < 2; ++n) _Pragma("unroll") for (int k = 0; k < 2; ++k) dst[n][k] = *(const PG8_LAS bf16x8*)(lds + PG8_SB(b, h) + boff + n * 2048 + k * 1024); } while (0)
#define PG8_MMA(ai, bj, At, Bt) do { __builtin_amdgcn_s_setprio(1); _Pragma("unroll") for (int m = 0; m < 4; ++m) _Pragma("unroll") for (int n = 0; n < 2; ++n) _Pragma("unroll") for (int k = 0; k < 2; ++k) \
        acc[ai][bj][m][n] = __builtin_amdgcn_mfma_f32_16x16x32_bf16(Bt[n][k], At[m][k], acc[ai][bj][m][n], 0, 0, 0); __builtin_amdgcn_s_setprio(0); } while (0)
#define PG8_WAIT_V(n) asm volatile("s_waitcnt vmcnt(" #n ")" ::: "memory")
#define PG8_WAIT_L(n) asm volatile("s_waitcnt lgkmcnt(" #n ")" ::: "memory")
#define PG8_BAR __builtin_amdgcn_s_barrier()
#define PG8_SCHED __builtin_amdgcn_sched_barrier(0)
    Unit cur, nxt; int ui = 0;
    if (!S.next(0, cur)) return;
    f32x4 acc[2][2][4][2];
    if constexpr (Epi::HAS_INIT) E.init(acc, cur, wr, wc, fr, fq);
    else {
#pragma unroll
    for (int a = 0; a < 2; ++a)
#pragma unroll
        for (int b = 0; b < 2; ++b)
#pragma unroll
            for (int m = 0; m < 4; ++m)
#pragma unroll
                for (int n = 0; n < 2; ++n) acc[a][b][m][n] = (f32x4){0.f, 0.f, 0.f, 0.f};
    }
    bf16x8 At[4][2], B0[2][2], B1[2][2];
    const char* cA = (const char*)(cur.sel ? g.A2 : g.A) + (size_t)cur.pm * tstep; const char* cB = (const char*)(cur.sel ? g.Bt2 : g.Bt) + (size_t)cur.pn * tstep;
    S.a_ready(cur);
    if constexpr (SP2) {
        PG8_STAGE(PG8_SB(0, 0), cB, voffB); PG8_STAGE(PG8_SB(0, 1), cB + hstep, voffB); PG8_STAGE(PG8_SA(0, 0), cA, voffA); PG8_STAGE(PG8_SA(0, 1), cA + hstep, voffA);
        if (wr == 1) PG8_BAR;
        PG8_WAIT_V(2); PG8_BAR;
        PG8_STAGE(PG8_SB(1, 0), cB + kstep, voffB); PG8_STAGE(PG8_SA(1, 0), cA + kstep, voffA); PG8_STAGE(PG8_SB(1, 1), cB + hstep + kstep, voffB);
        PG8_WAIT_V(6); PG8_BAR;
    } else {
        PG8_STAGE(PG8_SB(0, 0), cB, voffB); PG8_STAGE(PG8_SA(0, 0), cA, voffA); PG8_STAGE(PG8_SB(0, 1), cB + hstep, voffB); PG8_STAGE(PG8_SA(0, 1), cA + hstep, voffA);
        if (wr == 1) PG8_BAR;
        PG8_WAIT_V(4); PG8_BAR;
        PG8_STAGE(PG8_SB(1, 0), cB + kstep, voffB); PG8_STAGE(PG8_SA(1, 0), cA + kstep, voffA); PG8_STAGE(PG8_SB(1, 1), cB + hstep + kstep, voffB);
        PG8_WAIT_V(6); PG8_BAR;
    }
    for (;;) {
        const bool has_next = S.next(ui + 1, nxt);
        const char* nA = has_next ? (const char*)(nxt.sel ? g.A2 : g.A) + (size_t)nxt.pm * tstep : cA; const char* nB = has_next ? (const char*)(nxt.sel ? g.Bt2 : g.Bt) + (size_t)nxt.pn * tstep : cB;
        for (int t = 0; t < nt; t += 2) {
            const bool last = (t == nt - 2);
            const char* a1 = cA + (size_t)(t + 1) * kstep;
            const char* a2 = last ? nA : cA + (size_t)(t + 2) * kstep; const char* b2 = last ? nB : cB + (size_t)(t + 2) * kstep;
            const char* a3 = a2 + kstep; const char* b3 = b2 + kstep;
            if (last && has_next) S.a_ready(nxt);
            if constexpr (SP2) {
            PG8_LDB(B0, 0, 0); PG8_LDB(B1, 0, 1); PG8_SCHED; PG8_LDA(At, 0, 0); PG8_STAGE(PG8_SA(1, 1), a1 + hstep, voffA);
            PG8_WAIT_V(8); PG8_WAIT_L(0); PG8_BAR; PG8_MMA(0, 0, At, B0); PG8_MMA(0, 1, At, B1); PG8_BAR; PG8_SCHED;
            PG8_LDA(At, 0, 1); PG8_STAGE(PG8_SB(0, 0), b2, voffB); PG8_STAGE(PG8_SB(0, 1), b2 + hstep, voffB); PG8_STAGE(PG8_SA(0, 0), a2, voffA);
            PG8_WAIT_V(8); PG8_WAIT_L(0); PG8_BAR; PG8_MMA(1, 0, At, B0); PG8_MMA(1, 1, At, B1); PG8_BAR; PG8_SCHED;
            PG8_LDB(B0, 1, 0); PG8_LDB(B1, 1, 1); PG8_SCHED; PG8_LDA(At, 1, 0); PG8_STAGE(PG8_SA(0, 1), a2 + hstep, voffA);
            PG8_WAIT_V(8); PG8_WAIT_L(0); PG8_BAR; PG8_MMA(0, 0, At, B0); PG8_MMA(0, 1, At, B1); PG8_BAR; PG8_SCHED;
            PG8_LDA(At, 1, 1); PG8_STAGE(PG8_SB(1, 0), b3, voffB); PG8_STAGE(PG8_SB(1, 1), b3 + hstep, voffB); PG8_STAGE(PG8_SA(1, 0), a3, voffA);
            PG8_WAIT_V(8); PG8_WAIT_L(0); PG8_BAR; PG8_MMA(1, 0, At, B0); PG8_MMA(1, 1, At, B1); PG8_BAR; PG8_SCHED;
            } else {
            PG8_LDB(B0, 0, 0); PG8_SCHED; PG8_LDA(At, 0, 0); PG8_STAGE(PG8_SA(1, 1), a1 + hstep, voffA);
            PG8_WAIT_L(8); PG8_BAR; PG8_WAIT_L(0); PG8_MMA(0, 0, At, B0); PG8_BAR; PG8_SCHED;
            PG8_LDB(B1, 0, 1); PG8_STAGE(PG8_SB(0, 0), b2, voffB);
            PG8_BAR; PG8_WAIT_L(0); PG8_MMA(0, 1, At, B1); PG8_BAR;
            PG8_LDA(At, 0, 1); PG8_STAGE(PG8_SA(0, 0), a2, voffA);
            PG8_BAR; PG8_WAIT_L(0); PG8_MMA(1, 0, At, B0); PG8_BAR; PG8_SCHED;
            PG8_STAGE(PG8_SB(0, 1), b2 + hstep, voffB);
            PG8_WAIT_V(6); PG8_BAR; PG8_MMA(1, 1, At, B1); PG8_BAR;
            PG8_LDB(B0, 1, 0); PG8_SCHED; PG8_LDA(At, 1, 0); PG8_STAGE(PG8_SA(0, 1), a2 + hstep, voffA);
            PG8_WAIT_L(8); PG8_BAR; PG8_WAIT_L(0); PG8_MMA(0, 0, At, B0); PG8_BAR; PG8_SCHED;
            PG8_LDB(B1, 1, 1); PG8_STAGE(PG8_SB(1, 0), b3, voffB);
            PG8_BAR; PG8_WAIT_L(0); PG8_MMA(0, 1, At, B1); PG8_BAR;
            PG8_LDA(At, 1, 1); PG8_STAGE(PG8_SA(1, 0), a3, voffA);
            PG8_BAR; PG8_WAIT_L(0); PG8_MMA(1, 0, At, B0); PG8_BAR; PG8_SCHED;
            PG8_STAGE(PG8_SB(1, 1), b3 + hstep, voffB);
            PG8_WAIT_V(6); PG8_BAR; PG8_MMA(1, 1, At, B1); PG8_BAR;
            }
        }
        if constexpr (ALIGN_EPI) { if (wr == 0) PG8_BAR; }
        if constexpr (!Epi::AFTER_DRAIN) { E(acc, cur, wr, wc, fr, fq); S.done(cur); }
        if (!has_next) break;
        if constexpr (Epi::HAS_INIT) E.init(acc, nxt, wr, wc, fr, fq);
        else {
#pragma unroll
        for (int a = 0; a < 2; ++a)
#pragma unroll
            for (int b = 0; b < 2; ++b)
#pragma unroll
                for (int m = 0; m < 4; ++m)
#pragma unroll
                    for (int n = 0; n < 2; ++n) acc[a][b][m][n] = (f32x4){0.f, 0.f, 0.f, 0.f};
        }
        cur = nxt; cA = nA; cB = nB; ++ui;
        if constexpr (ALIGN_EPI) { if (wr == 1) PG8_BAR; }
    }
    PG8_WAIT_V(0);
    if constexpr (!ALIGN_EPI) { if (wr == 0) PG8_BAR; }
    PG8_BAR;
    if constexpr (Epi::AFTER_DRAIN) { E.fused(acc, cur, wr, wc, fr, fq, lds, wid, lane); S.done(cur); }
#undef PG8_SA
#undef PG8_SB
#undef PG8_STAGE
#undef PG8_LDA
#undef PG8_LDB
#undef PG8_MMA
#undef PG8_WAIT_V
#undef PG8_WAIT_L
#undef PG8_BAR
#undef PG8_SCHED
}
}

#define LAS __attribute__((address_space(3)))
typedef unsigned short bf16;
typedef short bf16x8 __attribute__((ext_vector_type(8)));
typedef short s16x4 __attribute__((ext_vector_type(4)));
typedef float f32x4 __attribute__((ext_vector_type(4)));
typedef float f32x16 __attribute__((ext_vector_type(16)));
typedef unsigned u32x4 __attribute__((ext_vector_type(4)));
typedef unsigned u32x2 __attribute__((ext_vector_type(2)));
constexpr int NWAVES = 8;
constexpr int M = 16384, D = 1024, SEQ = 4096, FF = 2816, NIN = 5120, NQKV = 3072, NGATE = 2048, DEPTH = 2;
constexpr float LOG2E = 1.4426950408889634f;
#ifndef SB_EARLY_EXIT
#define SB_EARLY_EXIT 1
#endif
#ifndef N_LAUNCH_MODE
#define N_LAUNCH_MODE 0
#endif
constexpr size_t MiB = 1u << 20;
constexpr size_t WS_CNT = 16384, WS_PCNT = 32768, WS_ZERO_BYTES = 32768 + 4 * 16384;
constexpr size_t WS_XSLOT = 250 * MiB;
constexpr size_t WS_BAR = 0;
constexpr size_t WS_SSQ = 1 * MiB, WS_ROPE = 2 * MiB, WS_LSE = 3 * MiB;
constexpr size_t WS_W = 4 * MiB;
constexpr size_t W_1CAT = 0, W_D1 = W_1CAT + (size_t)2 * FF * D * 2, W_IN = W_D1 + (size_t)D * FF * 2, W_PD = W_IN + (size_t)NIN * D * 2, W_PS = W_PD + (size_t)D * 256 * 2,
                 W_OUT = W_PS + (size_t)D * 256 * 2, W_2CAT = W_OUT + (size_t)D * D * 2, W_D2 = W_2CAT + (size_t)2 * FF * D * 2, W_END = W_D2 + (size_t)D * FF * 2;
static_assert(W_END <= 46 * MiB, "weights");
constexpr size_t WS_XB = 50 * MiB;
constexpr size_t OUT_OD3 = 0, OUT_OD = 24 * MiB;
constexpr size_t WS_R = 82 * MiB;
constexpr size_t WS_Y1 = WS_R, WS_Y = WS_R + 64 * MiB;
constexpr size_t WS_GATE = 178 * MiB;
constexpr size_t WS_OS = 242 * MiB;
constexpr size_t WS_END = 251 * MiB;
constexpr int RSL_OFF = 131072 + 1024;
constexpr int LDS_BYTES = RSL_OFF + 8 * 256 * 4;

__device__ __forceinline__ float wave_sum(float v) {
#pragma unroll
    for (int o = 1; o < 64; o <<= 1) v += __shfl_xor(v, o);
    return v;
}
__device__ __forceinline__ unsigned pk2(float lo, float hi) { return pg8::cvt_pk_bf16(lo, hi); }
#define LDS_WAIT() asm volatile("s_waitcnt lgkmcnt(0)" ::: "memory")

typedef __attribute__((address_space(1))) unsigned gu32;
#define XB_TMO      128
#define XB_XCNT(j)  (256  + 64 * (j))
#define XB_XSUB(j)  (1280 + 64 * (j))
#define XB_XGEN(j)  (2304 + 64 * (j))
#define XB_TOP      3328
#define XB_TOPGEN   3392
#define XCD_BAR_WORDS 3456
#define XB_SPIN_CAP (1u << 18)

__device__ __forceinline__ unsigned xb_ld(unsigned* p)              { return __hip_atomic_load(p, __ATOMIC_RELAXED, __HIP_MEMORY_SCOPE_AGENT); }
__device__ __forceinline__ unsigned xb_add(unsigned* p, unsigned v) { return __hip_atomic_fetch_add(p, v, __ATOMIC_RELAXED, __HIP_MEMORY_SCOPE_AGENT); }
__device__ __forceinline__ unsigned xb_xcc_id() { return (unsigned)__builtin_amdgcn_s_getreg((3 << 11) | 20) & 0xFu; }
#define XB_SPIN(cond, bar) do { unsigned _sp = 0; while (cond) { __builtin_amdgcn_s_sleep(1); \
    if ((++_sp & 255u) == 0u) { if (xb_ld(&(bar)[XB_TMO])) break; if (_sp > XB_SPIN_CAP) { atomicAdd(&(bar)[XB_TMO], 1u); break; } } } } while (0)

struct XcdBarrier {
    unsigned* bar; unsigned x;
    volatile LAS unsigned* st;
};

__device__ __forceinline__ XcdBarrier xcd_barrier_post(unsigned* bar, volatile LAS unsigned* st) {
    XcdBarrier b; b.bar = bar; b.x = xb_xcc_id(); b.st = st;
    if (threadIdx.x == 0) (void)xb_add(&bar[XB_XCNT(b.x)], 1u);
    return b;
}
__device__ __forceinline__ void xcd_barrier_complete(unsigned* bar, unsigned x, unsigned& nloc, unsigned& nx) {
    const unsigned G = gridDim.x * gridDim.y * gridDim.z;
    unsigned sum, cnt, mine, sp = 0u;
    for (;;) {
        sum = 0u; cnt = 0u; mine = 0u;
#pragma unroll
        for (unsigned j = 0; j < 16; ++j) { const unsigned c = xb_ld(&bar[XB_XCNT(j)]); sum += c; cnt += (c > 0u) ? 1u : 0u; mine = (j == x) ? c : mine; }
        if (sum == G) break;
        __builtin_amdgcn_s_sleep(1);
        if ((++sp & 255u) == 0u) { if (xb_ld(&bar[XB_TMO])) break; if (sp > XB_SPIN_CAP) { atomicAdd(&bar[XB_TMO], 1u); break; } }
    }
    nloc = mine > 0u ? mine : 1u; nx = cnt > 0u ? cnt : 1u;
}

__device__ __forceinline__ void xcd_barrier(const XcdBarrier& b) {
    asm volatile("s_waitcnt vmcnt(0)" ::: "memory");
    __syncthreads();
    if (threadIdx.x == 0) {
        unsigned* bar = b.bar;
        __builtin_amdgcn_s_waitcnt(0);
        unsigned nloc = b.st[0], nx = b.st[1];
        if (nloc == 0u) { xcd_barrier_complete(bar, b.x, nloc, nx); b.st[0] = nloc; b.st[1] = nx; }
        const unsigned old = xb_add(&bar[XB_XSUB(b.x)], 1u);
        const unsigned gen = old / nloc;
        if (old + 1u == (gen + 1u) * nloc) {
            __builtin_amdgcn_fence(__ATOMIC_RELEASE, "agent");
            asm volatile("s_waitcnt vmcnt(0)" ::: "memory");
            const unsigned og = xb_add(&bar[XB_TOP], 1u);
            const unsigned tg = og / nx;
            if (og + 1u == (tg + 1u) * nx) xb_add(&bar[XB_TOPGEN], 1u);
            else XB_SPIN(xb_ld(&bar[XB_TOPGEN]) == tg, bar);
            __builtin_amdgcn_fence(__ATOMIC_ACQUIRE, "agent");
            xb_add(&bar[XB_XGEN(b.x)], 1u);
            asm volatile("s_waitcnt vmcnt(0)" ::: "memory");
        } else {
            XB_SPIN(xb_ld(&bar[XB_XGEN(b.x)]) == gen, bar);
            __builtin_amdgcn_fence(__ATOMIC_ACQUIRE, "agent");
            asm volatile("s_waitcnt vmcnt(0)" ::: "memory");
        }
    }
    __syncthreads();
}


constexpr int CI_D1 = 2816, CI_IN = 4224, CI_B = 6784, CI_D2 = 9600, CI_PD = 11008, CI_PS = 11136, CI_OUT = 11264, CI_END = 11776;
struct ConvItem { const float* wp; const float* gp; bf16* dp; int ldw, K; bool rperm; };
struct ConvSrc { const float *n1, *wg1, *wu1, *wd1, *nm, *win, *wpd, *wps, *wout, *n2, *wg2, *wu2, *wd2; };
__device__ __forceinline__ ConvItem conv_decode(const ConvSrc& S, int l, int r, unsigned char* dA, unsigned char* dB, int lane) {
    const float* src; const float* gain = nullptr; bf16* dst; int ldw = D, K = D, kb, nb, sc0; bool rperm = false;
    if (r < CI_D1) { kb = r / 176; nb = r % 176; const int pn = nb >> 3, i8 = nb & 7; src = (i8 < 4 ? S.wg1 : S.wu1) + (size_t)l * D * FF; gain = S.n1 + (size_t)l * D; dst = (bf16*)(dA + W_1CAT); ldw = FF; sc0 = 128 * pn + 32 * (i8 & 3); }
    else if (r < CI_IN) { r -= CI_D1; kb = r / 32; nb = r % 32; src = S.wd1 + (size_t)l * FF * D; dst = (bf16*)(dA + W_D1); K = FF; sc0 = 32 * nb; }
    else if (r < CI_B) { r -= CI_IN; kb = r / 160; nb = r % 160; src = S.win + (size_t)l * D * NIN; gain = S.nm + (size_t)l * D; dst = (bf16*)(dA + W_IN); ldw = NIN; sc0 = 32 * nb; rperm = (nb < 48) && !(nb & 1); }
    else if (r < CI_D2) { r -= CI_B; kb = r / 176; nb = r % 176; const int pn = nb >> 3, i8 = nb & 7; src = (i8 < 4 ? S.wg2 : S.wu2) + (size_t)l * D * FF; gain = S.n2 + (size_t)l * D; dst = (bf16*)(dB + W_2CAT); ldw = FF; sc0 = 128 * pn + 32 * (i8 & 3); }
    else if (r < CI_PD) { r -= CI_D2; kb = r / 32; nb = r % 32; src = S.wd2 + (size_t)l * FF * D; dst = (bf16*)(dB + W_D2); K = FF; sc0 = 32 * nb; }
    else if (r < CI_PS) { r -= CI_PD; kb = r / 32; nb = r % 32; src = S.wpd + (size_t)l * 256 * D; dst = (bf16*)(dB + W_PD); K = 256; sc0 = 32 * nb; }
    else if (r < CI_OUT) { r -= CI_PS; kb = r / 32; nb = r % 32; src = S.wps + (size_t)l * 256 * D; dst = (bf16*)(dB + W_PS); K = 256; sc0 = 32 * nb; }
    else { r -= CI_OUT; kb = r / 32; nb = r % 32; src = S.wout + (size_t)l * D * D; dst = (bf16*)(dB + W_OUT); sc0 = 32 * nb; }
    const int c4 = lane & 7, kr = lane >> 3, k0 = 64 * kb;
    ConvItem I; I.wp = src + (size_t)(k0 + kr) * ldw + sc0 + 4 * c4; I.gp = gain ? gain + k0 + kr : nullptr; I.dp = dst + (size_t)(32 * nb) * K + k0; I.ldw = ldw; I.K = K; I.rperm = rperm;
    return I;
}
__device__ __forceinline__ void conv_load(f32x4 (&v)[8], const ConvItem& I) {
#pragma unroll
    for (int i = 0; i < 8; ++i) v[i] = __builtin_nontemporal_load((const f32x4*)(I.wp + (size_t)(8 * i) * I.ldw));
}
__device__ __forceinline__ void conv_finish(f32x4 (&v)[8], const ConvItem& I, LAS float* scr, int lane) {
    const int c4 = lane & 7, kr = lane >> 3;
    if (I.gp) {
#pragma unroll
        for (int i = 0; i < 8; ++i) v[i] *= I.gp[8 * i];
    }
    int p[4];
#pragma unroll
    for (int e = 0; e < 4; ++e) { const int sc = 4 * c4 + e; p[e] = (I.rperm && sc < 16) ? (sc < 8 ? 2 * sc : 2 * (sc - 8) + 1) : sc; }
#pragma unroll
    for (int i = 0; i < 8; ++i)
#pragma unroll
        for (int e = 0; e < 4; ++e) scr[(kr + 8 * i) * 33 + p[e]] = v[i][e];
    LDS_WAIT();
    const int c = lane & 7;
#pragma unroll
    for (int jj = 0; jj < 4; ++jj) { const int n = (lane >> 3) + 8 * jj; const LAS float* s = scr + (8 * c) * 33 + n;
        u32x4 o; o.x = pk2(s[0 * 33], s[1 * 33]); o.y = pk2(s[2 * 33], s[3 * 33]); o.z = pk2(s[4 * 33], s[5 * 33]); o.w = pk2(s[6 * 33], s[7 * 33]);
        *(u32x4*)(I.dp + (size_t)n * I.K + 8 * c) = o; }
    LDS_WAIT();
}
__device__ __forceinline__ void conv_items(const ConvSrc& S, int l, int lo, int hi, unsigned char* dA, unsigned char* dB, LAS unsigned char* lds, int widx, int nw, int wave, int lane) {
    LAS float* scr = (LAS float*)(lds + wave * 8704);
    int it = lo + widx; if (it >= hi) return;
    ConvItem cur = conv_decode(S, l, __builtin_amdgcn_readfirstlane(it), dA, dB, lane); f32x4 v[8]; conv_load(v, cur);
    for (;;) {
        const int itn = it + nw; const bool more = itn < hi;
        ConvItem nxt = cur; f32x4 vn[8];
        if (more) { nxt = conv_decode(S, l, __builtin_amdgcn_readfirstlane(itn), dA, dB, lane); conv_load(vn, nxt); }
        conv_finish(v, cur, scr, lane);
        if (!more) break;
        cur = nxt; it = itn;
#pragma unroll
        for (int i = 0; i < 8; ++i) v[i] = vn[i];
    }
}
__device__ __forceinline__ void conv_phase(const float* Px, const ConvSrc& S, unsigned char* Pws, int l, LAS unsigned char* lds, int gw, int NGW, int wave, int lane) {
    unsigned char* wsw = Pws + WS_W;
    conv_items(S, l, 0, CI_END, wsw, wsw, lds, gw, NGW, wave, lane);
    if (l == 0) {
        const float* x = Px; bf16* xb = (bf16*)(Pws + WS_XB); float* ssqp = (float*)(Pws + WS_SSQ);
        for (int m = gw; m < M; m += NGW) {
            const f32x4* xr = (const f32x4*)(x + (size_t)m * D) + 2 * lane; f32x4 v[4]; float s = 0.f;
#pragma unroll
            for (int j = 0; j < 2; ++j) { v[2 * j] = __builtin_nontemporal_load(xr + 128 * j); v[2 * j + 1] = __builtin_nontemporal_load(xr + 128 * j + 1); }
#pragma unroll
            for (int j = 0; j < 4; ++j) s += (v[j][0] * v[j][0] + v[j][1] * v[j][1]) + (v[j][2] * v[j][2] + v[j][3] * v[j][3]);
            s = wave_sum(s);
            u32x4* o = (u32x4*)(xb + (size_t)m * D) + lane;
#pragma unroll
            for (int j = 0; j < 2; ++j) { u32x4 w; w.x = pk2(v[2 * j][0], v[2 * j][1]); w.y = pk2(v[2 * j][2], v[2 * j][3]); w.z = pk2(v[2 * j + 1][0], v[2 * j + 1][1]); w.w = pk2(v[2 * j + 1][2], v[2 * j + 1][3]); o[64 * j] = w; }
            if (lane < 16) ssqp[(size_t)m * 16 + lane] = (lane == 0) ? s : 0.f;
        }
        float* rope = (float*)(Pws + WS_ROPE);
        for (int idx = gw * 64 + lane; idx < SEQ * 8; idx += NGW * 64) {
            const int t = idx >> 3, i = idx & 7;
            const float invf = (i == 0) ? 1.0f : (i == 1) ? 0.1939227432012558f : (i == 2) ? 0.03760603070259094f : (i == 3) ? 0.007292664609849453f : (i == 4) ? 0.0014142135623842478f
                             : (i == 5) ? 0.00027424818836152554f : (i == 6) ? 5.3182957344688475e-05f : 1.0313385246263351e-05f;
            const float angf = (float)t * invf; const double a = (double)angf;
            const double kq = __builtin_rint(a * 0.63661977236758134308);
            double rr = __builtin_fma(-kq, 1.57079632679489655800, a); rr = __builtin_fma(-kq, 6.12323399573676603587e-17, rr);
            const int qd = ((int)kq) & 3; const float rf = (float)rr, r2 = rf * rf;
            const float sn = rf + rf * r2 * (-1.0f / 6 + r2 * (1.0f / 120 + r2 * (-1.0f / 5040 + r2 * (1.0f / 362880))));
            const float cn = 1.0f + r2 * (-0.5f + r2 * (1.0f / 24 + r2 * (-1.0f / 720 + r2 * (1.0f / 40320 + r2 * (-1.0f / 3628800)))));
            const float c = (qd == 0) ? cn : (qd == 1) ? -sn : (qd == 2) ? -cn : sn;
            const float s = (qd == 0) ? sn : (qd == 1) ? cn : (qd == 2) ? -sn : -cn;
            rope[2 * idx] = c; rope[2 * idx + 1] = s;
        }
    }
}

__device__ __forceinline__ int crow(int r, int hi) { return (r & 3) + 8 * (r >> 2) + 4 * hi; }
struct F2 { float a, b; };
__device__ __forceinline__ F2 pair32(float v) { const auto rr = __builtin_amdgcn_permlane32_swap(__float_as_uint(v), __float_as_uint(v), false, false); return F2{__uint_as_float(rr[0]), __uint_as_float(rr[1])}; }
__device__ __forceinline__ void ld_frag4(bf16x8 (&f)[4], const bf16* ubase, unsigned rowstride, int lane) {
    const unsigned off = (unsigned)(lane & 31) * rowstride + (unsigned)(lane >> 5) * 8u;
#pragma unroll
    for (int d0 = 0; d0 < 4; ++d0) f[d0] = *(const bf16x8*)(ubase + (off + d0 * 16));
}
__device__ __forceinline__ f32x16 qk_tile(const bf16x8 (&kf)[4], const bf16x8 (&qf)[4]) {
    f32x16 s = {};
#pragma unroll
    for (int d0 = 0; d0 < 4; ++d0) s = __builtin_amdgcn_mfma_f32_32x32x16_bf16(kf[d0], qf[d0], s, 0, 0, 0);
    return s;
}
__device__ __forceinline__ void v_load(u32x4 (&vr)[4], const bf16* ubase, unsigned rowstride, int lane) {
#pragma unroll
    for (int i = 0; i < 4; ++i) { const unsigned c = lane + 64 * i; vr[i] = *(const u32x4*)(ubase + ((c >> 3) * rowstride + (c & 7) * 8u)); }
}
__device__ __forceinline__ void v_stage(LAS unsigned char* vb, const u32x4 (&vr)[4], int lane) {
#pragma unroll
    for (int i = 0; i < 4; ++i) { const int c = lane + 64 * i, key = c >> 3, ch = c & 7; *(LAS u32x4*)(vb + key * 128 + ((ch * 16) ^ (((key >> 1) & 1) << 6))) = vr[i]; }
}
__device__ __forceinline__ void pv_tile(f32x16 (&o)[2], LAS unsigned char* vb, const f32x16& p, int lane) {
    const int hi = lane >> 5, g1 = (lane >> 4) & 1, q4 = (lane & 15) >> 2, pp = lane & 3;
    bf16x8 pf[2];
#pragma unroll
    for (int s = 0; s < 2; ++s) { u32x4 w; w.x = pk2(p[8 * s + 0], p[8 * s + 1]); w.y = pk2(p[8 * s + 2], p[8 * s + 3]); w.z = pk2(p[8 * s + 4], p[8 * s + 5]); w.w = pk2(p[8 * s + 6], p[8 * s + 7]);
        pf[s] = __builtin_bit_cast(bf16x8, w); }
    const int swz = ((q4 >> 1) & 1) << 6;
#pragma unroll
    for (int dblk = 0; dblk < 2; ++dblk)
#pragma unroll
        for (int s = 0; s < 2; ++s) {
            const int colb = (dblk * 64 + g1 * 32 + pp * 8) ^ swz;
            const int row0 = 16 * s + 4 * hi + q4;
            const s16x4 t0 = __builtin_bit_cast(s16x4, __builtin_amdgcn_ds_read_tr16_b64_v4i16((LAS s16x4*)(vb + row0 * 128 + colb)));
            const s16x4 t1 = __builtin_bit_cast(s16x4, __builtin_amdgcn_ds_read_tr16_b64_v4i16((LAS s16x4*)(vb + (row0 + 8) * 128 + colb)));
            const bf16x8 a = (bf16x8){t0[0], t0[1], t0[2], t0[3], t1[0], t1[1], t1[2], t1[3]};
            o[dblk] = __builtin_amdgcn_mfma_f32_32x32x16_bf16(a, pf[s], o[dblk], 0, 0, 0);
        }
}
__device__ __forceinline__ void store_ot(bf16* rowp, const f32x16 (&o)[2], float sc, int hi) {
#pragma unroll
    for (int dblk = 0; dblk < 2; ++dblk)
#pragma unroll
        for (int p = 0; p < 2; ++p) {
            const unsigned x0 = pk2(o[dblk][8 * p] * sc, o[dblk][8 * p + 1] * sc), x1 = pk2(o[dblk][8 * p + 2] * sc, o[dblk][8 * p + 3] * sc);
            const unsigned y0 = pk2(o[dblk][8 * p + 4] * sc, o[dblk][8 * p + 5] * sc), y1 = pk2(o[dblk][8 * p + 6] * sc, o[dblk][8 * p + 7] * sc);
            const auto s0 = __builtin_amdgcn_permlane32_swap(x0, y0, false, false), s1 = __builtin_amdgcn_permlane32_swap(x1, y1, false, false);
            u32x4 w; w.x = s0[0]; w.y = s1[0]; w.z = s0[1]; w.w = s1[1];
            *(u32x4*)(rowp + dblk * 32 + 16 * p + 8 * hi) = w; }
}
struct DilGeo { size_t rowb, kstride; int h12, dil, r, i0; };
__device__ __forceinline__ DilGeo dil_geo(int item) {
    DilGeo g; const int b = item / 1536, rem = item % 1536, ch = rem & 127; g.h12 = rem >> 7;
    const int gg = g.h12 >> 2, ncl = 7 - 2 * gg; g.dil = 1 << (2 * gg); g.r = ch >> ncl; g.i0 = 32 * (ch & ((1 << ncl) - 1));
    g.rowb = (size_t)b * SEQ; g.kstride = (size_t)g.dil * 64; return g;
}
__device__ __forceinline__ void dil_load_qk(const bf16* QKV, const DilGeo& g, bf16x8 (&qf)[4], bf16x8 (&kf)[5][4], int lane) {
    const int q = lane & 31, hi = lane >> 5;
    ld_frag4(qf, QKV + ((size_t)g.h12 * M + g.rowb + (size_t)g.i0 * g.dil + g.r) * 64, (unsigned)g.kstride, lane);
#pragma unroll
    for (int kt = 0; kt < 5; ++kt) { const int ib = g.i0 - 128 + 32 * kt, ibc = ib < 0 ? 0 : ib; ld_frag4(kf[kt], QKV + ((size_t)(12 + g.h12) * M + g.rowb + (size_t)ibc * g.dil + g.r) * 64, (unsigned)g.kstride, lane); }
}
__device__ __forceinline__ void dil_vload(const bf16* QKV, const DilGeo& g, u32x4 (&vr)[4], int kt, int lane) {
    const int ib = g.i0 - 128 + 32 * kt, ibc = ib < 0 ? 0 : ib;
    v_load(vr, QKV + ((size_t)(24 + g.h12) * M + g.rowb + g.r) * 64 + (size_t)ibc * g.kstride, (unsigned)g.kstride, lane);
}
__device__ __forceinline__ void pv_tile_p(f32x16 (&o)[2], LAS unsigned char* vb, const bf16x8 (&pf)[2], int lane) {
    const int hi = lane >> 5, g1 = (lane >> 4) & 1, q4 = (lane & 15) >> 2, pp = lane & 3;
    const int swz = ((q4 >> 1) & 1) << 6;
#pragma unroll
    for (int dblk = 0; dblk < 2; ++dblk)
#pragma unroll
        for (int s = 0; s < 2; ++s) {
            const int colb = (dblk * 64 + g1 * 32 + pp * 8) ^ swz;
            const int row0 = 16 * s + 4 * hi + q4;
            const s16x4 t0 = __builtin_bit_cast(s16x4, __builtin_amdgcn_ds_read_tr16_b64_v4i16((LAS s16x4*)(vb + row0 * 128 + colb)));
            const s16x4 t1 = __builtin_bit_cast(s16x4, __builtin_amdgcn_ds_read_tr16_b64_v4i16((LAS s16x4*)(vb + (row0 + 8) * 128 + colb)));
            const bf16x8 a = (bf16x8){t0[0], t0[1], t0[2], t0[3], t1[0], t1[1], t1[2], t1[3]};
            o[dblk] = __builtin_amdgcn_mfma_f32_32x32x16_bf16(a, pf[s], o[dblk], 0, 0, 0);
        }
}
__device__ __forceinline__ void dil_items(const bf16* QKV, bf16* OD3, float* LSE, LAS unsigned char* vb, int first, int stride, int lane) {
    int it = first; if (it >= 6144) return;
    const int q = lane & 31, hi = lane >> 5;
    DilGeo g = dil_geo(__builtin_amdgcn_readfirstlane(it));
    for (;;) {
        bf16x8 qf[4], kf[5][4];
        dil_load_qk(QKV, g, qf, kf, lane);
        u32x4 vr[5][4];
#pragma unroll
        for (int kt = 0; kt < 5; ++kt) dil_vload(QKV, g, vr[kt], kt, lane);
        bf16x8 pf[5][2]; float mx = -INFINITY, l = 0.f;
        {
            f32x16 s[5];
#pragma unroll
            for (int kt = 0; kt < 5; ++kt) {
                s[kt] = qk_tile(kf[kt], qf);
                if (g.i0 - 128 + 32 * kt < 0) {
#pragma unroll
                    for (int rr = 0; rr < 16; ++rr) s[kt][rr] = -INFINITY;
                }
            }
#pragma unroll
            for (int rr = 0; rr < 16; ++rr) { const int kk = crow(rr, hi); if (kk < q) s[0][rr] = -INFINITY; if (kk > q) s[4][rr] = -INFINITY; }
#pragma unroll
            for (int kt = 0; kt < 5; ++kt)
#pragma unroll
                for (int rr = 0; rr < 16; ++rr) mx = fmaxf(mx, s[kt][rr]);
            { const F2 t = pair32(mx); mx = fmaxf(t.a, t.b); }
            const float mb = mx * LOG2E;
#pragma unroll
            for (int kt = 0; kt < 5; ++kt) {
#pragma unroll
                for (int rr = 0; rr < 16; ++rr) { const float p = __builtin_amdgcn_exp2f(__builtin_fmaf(s[kt][rr], LOG2E, -mb)); s[kt][rr] = p; l += p; }
#pragma unroll
                for (int h2 = 0; h2 < 2; ++h2) { u32x4 w; w.x = pk2(s[kt][8 * h2 + 0], s[kt][8 * h2 + 1]); w.y = pk2(s[kt][8 * h2 + 2], s[kt][8 * h2 + 3]); w.z = pk2(s[kt][8 * h2 + 4], s[kt][8 * h2 + 5]); w.w = pk2(s[kt][8 * h2 + 6], s[kt][8 * h2 + 7]);
                    pf[kt][h2] = __builtin_bit_cast(bf16x8, w); }
            }
            { const F2 t = pair32(l); l = t.a + t.b; }
        }
        const int itn = it + stride; const bool more = itn < 6144;
        const DilGeo gn = dil_geo(__builtin_amdgcn_readfirstlane(more ? itn : it));
        f32x16 o[2]; o[0] = f32x16{}; o[1] = f32x16{};
#pragma unroll
        for (int kt = 0; kt < 5; ++kt) {
            LDS_WAIT();
            v_stage(vb, vr[kt], lane);
            LDS_WAIT();
            pv_tile_p(o, vb, pf[kt], lane);
        }
        const float inv = 1.0f / l;
        const size_t tok = g.rowb + (size_t)(g.i0 + q) * g.dil + g.r;
        store_ot(OD3 + (g.rowb + (size_t)g.i0 * g.dil + g.r) * 768 + g.h12 * 64 + (unsigned)q * (unsigned)(g.dil * 768), o, inv, hi);
        if (hi == 0) LSE[tok * 12 + g.h12] = mx + __logf(l);
        if (!more) break;
        it = itn; g = gn;
    }
}
__device__ __forceinline__ void sb_step(f32x16 (&o)[2], float& R, const bf16x8 (&kf)[4], const bf16x8 (&qf)[4], const u32x4 (&vr)[4], LAS unsigned char* vb, int dq, int lane) {
    const int hi = lane >> 5;
    f32x16 z = qk_tile(kf, qf);
    float gp[4];
#pragma unroll
    for (int c4 = 0; c4 < 4; ++c4) {
        float be[4], ke[4];
#pragma unroll
        for (int i = 0; i < 4; ++i) { const float zz = z[4 * c4 + i]; const float e = __builtin_amdgcn_exp2f(-fabsf(zz) * LOG2E); const float rr = __builtin_amdgcn_rcpf(1.0f + e), sm = e * rr;
            const bool pos = zz >= 0.f; const bool past = (8 * c4 + 4 * hi + i) < dq;
            be[i] = past ? (pos ? rr : sm) : 0.f; ke[i] = past ? (pos ? sm : rr) : 1.f; }
        const float e2 = ke[3], e1 = e2 * ke[2], e0 = e1 * ke[1];
        gp[c4] = e0 * ke[0];
        z[4 * c4 + 3] = be[3]; z[4 * c4 + 2] = be[2] * e2; z[4 * c4 + 1] = be[1] * e1; z[4 * c4 + 0] = be[0] * e0;
    }
    float U = R;
#pragma unroll
    for (int c4 = 3; c4 >= 0; --c4) {
        const F2 t = pair32(gp[c4]);
        const float T = (hi == 0) ? U * t.b : U;
#pragma unroll
        for (int i = 0; i < 4; ++i) z[4 * c4 + i] *= T;
        U *= t.a * t.b;
    }
    R = U;
    LDS_WAIT();
    v_stage(vb, vr, lane);
    LDS_WAIT();
    pv_tile(o, vb, z, lane);
}
__device__ __forceinline__ void sb_item(const bf16* QKV, bf16* OS, LAS unsigned char* vb, int bh, int c, int lane) {
    const int b = bh >> 2, h = bh & 3, q = lane & 31, hi = lane >> 5;
    const size_t rowb = (size_t)b * SEQ;
    const bf16* Qp = QKV + ((size_t)(36 + h) * M + rowb + 32 * c) * 64;
    const bf16* Kb = QKV + ((size_t)(40 + h) * M + rowb) * 64;
    const bf16* Vb = QKV + ((size_t)(44 + h) * M + rowb) * 64;
    bf16x8 qf[4]; ld_frag4(qf, Qp, 64, lane);
    f32x16 o[2]; o[0] = f32x16{}; o[1] = f32x16{};
    float R = 1.0f;
    bf16x8 kf[3][4]; u32x4 vr[3][4];
#pragma unroll
    for (int j = 0; j < 3; ++j) { const int t = (c - j) < 0 ? 0 : (c - j); ld_frag4(kf[j], Kb + (size_t)(32 * t) * 64, 64, lane); v_load(vr[j], Vb + (size_t)(32 * t) * 64, 64, lane); }
#if SB_EARLY_EXIT
#define SB_DONE() (__all(R < 1e-20f))
#else
#define SB_DONE() (false)
#endif
#define SB_STEP(j, kt_) do { sb_step(o, R, kf[j], qf, vr[j], vb, 32 * (c - (kt_)) + q, lane); \
        { const int t = (kt_) - 3 < 0 ? 0 : (kt_) - 3; ld_frag4(kf[j], Kb + (size_t)(32 * t) * 64, 64, lane); v_load(vr[j], Vb + (size_t)(32 * t) * 64, 64, lane); } } while (0)
    for (int kt = c; kt >= 0; kt -= 3) {
        SB_STEP(0, kt); if (kt - 1 < 0 || SB_DONE()) break;
        SB_STEP(1, kt - 1); if (kt - 2 < 0 || SB_DONE()) break;
        SB_STEP(2, kt - 2); if (SB_DONE()) break;
    }
#undef SB_STEP
#undef SB_DONE
    store_ot(OS + (rowb + 32 * c) * 256 + h * 64 + (unsigned)q * 256u, o, 1.0f, hi);
}
__device__ __forceinline__ void attn_phase(unsigned char* Pws, unsigned char* Pscr, LAS unsigned char* lds, int G, int wg, int NGW, int wave, int lane) {
    LAS unsigned char* vb = lds + wave * 4096;
    const bf16* QKV = (const bf16*)(Pws + WS_R);
    const int v = (G % 8 == 0) ? (wg % 8) * (G / 8) + wg / 8 : wg;
    const int base = v * NWAVES + wave;
    for (int it = base; it < 2048; it += NGW) { const int itu = __builtin_amdgcn_readfirstlane(it);
#if SB_EARLY_EXIT
        sb_item(QKV, (bf16*)(Pws + WS_OS), vb, itu >> 7, itu & 127, lane);
#else
        sb_item(QKV, (bf16*)(Pws + WS_OS), vb, itu >> 7, ((itu & 127) + 16 * (itu >> 8)) & 127, lane);
#endif
    }
    dil_items(QKV, (bf16*)(Pscr + OUT_OD3), (float*)(Pws + WS_LSE), vb, base, NGW, lane);
}
__device__ __forceinline__ void merge_phase(unsigned char* Pws, unsigned char* Pscr, int idx_lo, int idx_hi, int first, int stride) {
    const bf16* OD3 = (const bf16*)(Pscr + OUT_OD3); bf16* OD = (bf16*)(Pscr + OUT_OD); const float* LSE = (const float*)(Pws + WS_LSE);
    const __amdgpu_buffer_rsrc_t odr = __builtin_amdgcn_make_buffer_rsrc(OD, 0, M * 256 * 2, 0x00020000);
    for (int idx = idx_lo + first; idx < idx_hi; idx += stride) {
        const int t = idx >> 5, hh = (idx >> 3) & 3, ch = idx & 7;
        const float l0 = LSE[(size_t)t * 12 + hh], l1 = LSE[(size_t)t * 12 + 4 + hh], l2 = LSE[(size_t)t * 12 + 8 + hh];
        const float mx = fmaxf(l0, fmaxf(l1, l2)); float e0 = __expf(l0 - mx), e1 = __expf(l1 - mx), e2 = __expf(l2 - mx); const float inv = 1.0f / (e0 + e1 + e2);
        e0 *= inv; e1 *= inv; e2 *= inv;
        const u32x4 a = *(const u32x4*)(OD3 + (size_t)t * 768 + hh * 64 + ch * 8), bq = *(const u32x4*)(OD3 + (size_t)t * 768 + (4 + hh) * 64 + ch * 8), cq = *(const u32x4*)(OD3 + (size_t)t * 768 + (8 + hh) * 64 + ch * 8);
        u32x4 o;
#pragma unroll
        for (int k = 0; k < 4; ++k) {
            const float lo = e0 * __uint_as_float(a[k] << 16) + e1 * __uint_as_float(bq[k] << 16) + e2 * __uint_as_float(cq[k] << 16);
            const float hi = e0 * __uint_as_float(a[k] & 0xffff0000u) + e1 * __uint_as_float(bq[k] & 0xffff0000u) + e2 * __uint_as_float(cq[k] & 0xffff0000u);
            o[k] = pk2(lo, hi);
        }
        __builtin_amdgcn_raw_buffer_store_b128(o, odr, (unsigned)(t * 256 + hh * 64 + ch * 8) * 2u, 0,   16);
    }
}
__device__ __forceinline__ void merge_quarter(unsigned char* Pws, unsigned char* Pscr, int idx_lo, int tid) {
    const bf16* OD3 = (const bf16*)(Pscr + OUT_OD3); bf16* OD = (bf16*)(Pscr + OUT_OD); const float* LSE = (const float*)(Pws + WS_LSE);
    const __amdgpu_buffer_rsrc_t odr = __builtin_amdgcn_make_buffer_rsrc(OD, 0, M * 256 * 2, 0x00020000);
    float ls[4][3]; u32x4 v[4][3];
#pragma unroll
    for (int j = 0; j < 4; ++j) { const unsigned idx = (unsigned)(idx_lo + tid + 512 * j), t = idx >> 5, hh = (idx >> 3) & 3, ch = idx & 7;
#pragma unroll
        for (int g = 0; g < 3; ++g) { ls[j][g] = __builtin_nontemporal_load(LSE + (t * 12u + 4u * g + hh)); v[j][g] = __builtin_nontemporal_load((const u32x4*)(OD3 + (t * 768u + (4u * g + hh) * 64u + ch * 8u))); } }
#pragma unroll
    for (int j = 0; j < 4; ++j) { const unsigned idx = (unsigned)(idx_lo + tid + 512 * j), t = idx >> 5, hh = (idx >> 3) & 3, ch = idx & 7;
        const float mx = fmaxf(ls[j][0], fmaxf(ls[j][1], ls[j][2])); float e0 = __expf(ls[j][0] - mx), e1 = __expf(ls[j][1] - mx), e2 = __expf(ls[j][2] - mx); const float inv = 1.0f / (e0 + e1 + e2);
        e0 *= inv; e1 *= inv; e2 *= inv;
        u32x4 o;
#pragma unroll
        for (int k = 0; k < 4; ++k) {
            const float lo = e0 * __uint_as_float(v[j][0][k] << 16) + e1 * __uint_as_float(v[j][1][k] << 16) + e2 * __uint_as_float(v[j][2][k] << 16);
            const float hi = e0 * __uint_as_float(v[j][0][k] & 0xffff0000u) + e1 * __uint_as_float(v[j][1][k] & 0xffff0000u) + e2 * __uint_as_float(v[j][2][k] & 0xffff0000u);
            o[k] = pk2(lo, hi);
        }
        __builtin_amdgcn_raw_buffer_store_b128(o, odr, (t * 256u + hh * 64u + ch * 8u) * 2u, 0,   16); }
}
__device__ __forceinline__ void panel_arrive(unsigned* cnt, int pm, int wave, int lane) {
    asm volatile("s_waitcnt vmcnt(0)" ::: "memory");
    __syncthreads();
    if (wave == 0 && lane == 0) __hip_atomic_fetch_add(cnt + 64 * pm, 1u, __ATOMIC_RELAXED, __HIP_MEMORY_SCOPE_AGENT);
}
__device__ __forceinline__ void panel_sync(unsigned* cnt, int pm, int wave, int lane) {
    asm volatile("s_waitcnt vmcnt(0)" ::: "memory");
    __syncthreads();
    if (wave == 0) {
        if (lane == 0) __hip_atomic_fetch_add(cnt + 64 * pm, 1u, __ATOMIC_RELAXED, __HIP_MEMORY_SCOPE_AGENT);
        unsigned spins = 0;
        while ((unsigned)__builtin_amdgcn_readfirstlane(__hip_atomic_load(cnt + 64 * pm, __ATOMIC_RELAXED, __HIP_MEMORY_SCOPE_AGENT)) < 4u) { __builtin_amdgcn_s_sleep(1); if (++spins > (1u << 20)) break; }
        __builtin_amdgcn_fence(__ATOMIC_ACQUIRE, "agent"); }
    asm volatile("s_waitcnt vmcnt(0) lgkmcnt(0)" ::: "memory"); __syncthreads();
}
__device__ __forceinline__ void final_phase(unsigned char* Pws, float* Pout, const float* Pnf, int gw, int NGW, int lane) {
    const float* ssqp = (const float*)(Pws + WS_SSQ); const f32x4* gf = (const f32x4*)Pnf + 2 * lane; const bf16* xb = (const bf16*)(Pws + WS_XB);
    for (int m = gw; m < M; m += NGW) {
        const float rs = pg8::row_rstd(ssqp, m);
        const u32x4* xr = (const u32x4*)(xb + (size_t)m * D) + lane; f32x4* orow = (f32x4*)(Pout + (size_t)m * D) + 2 * lane;
#pragma unroll
        for (int j = 0; j < 2; ++j) { const u32x4 w = xr[64 * j];
            const f32x4 v0 = {__uint_as_float(w.x << 16), __uint_as_float(w.x & 0xffff0000u), __uint_as_float(w.y << 16), __uint_as_float(w.y & 0xffff0000u)};
            const f32x4 v1 = {__uint_as_float(w.z << 16), __uint_as_float(w.z & 0xffff0000u), __uint_as_float(w.w << 16), __uint_as_float(w.w & 0xffff0000u)};
            orow[128 * j] = v0 * rs * gf[128 * j]; orow[128 * j + 1] = v1 * rs * gf[128 * j + 1]; }
    }
}

struct Args { const float* in[15]; float* out; unsigned char* ws; int ph_lo, ph_hi; };
constexpr int N_PHASES = 10 * DEPTH + 1;
__global__ void __launch_bounds__(NWAVES * 64, 2) fwd_megakernel(Args args) {
    extern __shared__ __attribute__((aligned(16))) unsigned char lds_raw[];
    LAS unsigned char* lds = (LAS unsigned char*)lds_raw;
    cg::grid_group grid = cg::this_grid();
    volatile LAS unsigned* bst = (volatile LAS unsigned*)(lds + 131072);
    if (threadIdx.x < 2) bst[threadIdx.x] = 0u;
    __syncthreads();
    (void)xcd_barrier_post((unsigned*)(args.ws + WS_BAR), bst);
    for (int ph = args.ph_lo; ph < args.ph_hi; ++ph) {
        const __attribute__((address_space(4))) unsigned char* ka = (const __attribute__((address_space(4))) unsigned char*)__builtin_amdgcn_kernarg_segment_ptr();
        asm volatile("" : "+s"(ka));
#define KARG(i) (*(const float* const __attribute__((address_space(4)))*)(ka + 8 * (i)))
        const float* Px = KARG(0); float* Pout = (float*)KARG(15); unsigned char* ws = (unsigned char*)KARG(16);
        int tid = threadIdx.x, G = gridDim.x, wg = blockIdx.x; asm volatile("" : "+v"(tid), "+s"(G), "+s"(wg));
        const int lane = tid & 63, wave = __builtin_amdgcn_readfirstlane(tid >> 6);
        const int gw = wave * G + wg, NGW = G * NWAVES;
        const int gtid = wg * (NWAVES * 64) + tid, NT = G * NWAVES * 64;
        unsigned char* wsw = ws + WS_W;
        float* ssqp = (float*)(ws + WS_SSQ);
        bf16* XB = (bf16*)(ws + WS_XB); bf16* H = (bf16*)(ws + WS_R); bf16* QKV = (bf16*)(ws + WS_R); bf16* GATE = (bf16*)(ws + WS_GATE);
        const int l = ph / 10, k = (ph == N_PHASES - 1) ? 10 : ph % 10;
        const bool fuse_final = (G == 256);
        if (k == 10 && fuse_final) continue;
        const bool chain = (G == 256);
        if ((k == 6 || k == 7) && chain) continue;
        if (k == 0 && l > 0) continue;
        unsigned char* dA1 = (unsigned char*)Pout + 32 * MiB;
        unsigned char* wA = (l == 0) ? wsw : dA1;
        if (k == 0) {
            { const ConvSrc CS{KARG(1), KARG(2), KARG(3), KARG(4), KARG(5), KARG(6), KARG(7), KARG(8), KARG(9), KARG(10), KARG(11), KARG(12), KARG(13)}; conv_phase(Px, CS, ws, l, lds, gw, NGW, wave, lane); }
        }
        else if (k == 1 || k == 8) {
            pg8::Gemm g{XB, (const bf16*)(k == 1 ? wA + W_1CAT : wsw + W_2CAT), M, 2 * FF, D}; pg8::StaticOrder S; S.init(M, 2 * FF, G, wg);
            { const LAS float* rsl_c = (const LAS float*)(lds + RSL_OFF); LAS float* rsl_w = (LAS float*)(lds + RSL_OFF); pg8::Unit uu;
#pragma unroll 1
              for (int i = 0; i < pg8::RSL_UNITS; ++i) if (S.next(i, uu) && tid < 256) rsl_w[i * 256 + tid] = pg8::row_rstd(ssqp, uu.pm * 256 + tid);
              __syncthreads(); (void)rsl_c; }
            pg8::EpiSwiglu E{H, ssqp, (const LAS float*)(lds + RSL_OFF)};
            pg8::gemm_phase<pg8::EpiSwiglu, pg8::StaticOrder, true, true>(lds, g, S, E);
            if ((l == 0) || (k == 1)) {
                const int rem = ((M / 256) * (2 * FF / 256)) % G; const bool idle = (rem == 0) || (wg >= rem);
                if (idle) {
                    const int nidle = (rem == 0) ? G : G - rem, iw = (rem == 0) ? wg : wg - rem;
                    const ConvSrc CS{KARG(1), KARG(2), KARG(3), KARG(4), KARG(5), KARG(6), KARG(7), KARG(8), KARG(9), KARG(10), KARG(11), KARG(12), KARG(13)};
                    const int lo = (l == 0) ? (k == 1 ? 0 : CI_IN) : CI_B, hi = (l == 0) ? (k == 1 ? CI_IN : CI_B) : CI_END;
                    conv_items(CS, 1, lo, hi, dA1, wsw, lds, wave * nidle + iw, nidle * NWAVES, wave, lane);
                }
            }
        } else if (k == 2 || k == 9) {
            pg8::Gemm g{H, (const bf16*)(k == 2 ? wA + W_D1 : wsw + W_D2), M, D, FF}; pg8::StaticOrder S; S.init(M, D, G, wg);
            if (ph == 2) { pg8::EpiResid<true> E{Px, XB, ssqp, 0.5f}; pg8::gemm_phase<pg8::EpiResid<true>, pg8::StaticOrder, true, true>(lds, g, S, E); }
            else if (ph == N_PHASES - 2 && fuse_final) { pg8::EpiResidFinal E{XB, Pout, KARG(14), (unsigned*)(ws + WS_XSLOT), (unsigned*)(ws + WS_CNT), 0.5f};
                pg8::gemm_phase<pg8::EpiResidFinal, pg8::StaticOrder, true, true>(lds, g, S, E); }
            else { pg8::EpiResid<false> E{nullptr, XB, ssqp, 0.5f}; pg8::gemm_phase<pg8::EpiResid<false>, pg8::StaticOrder, true, true>(lds, g, S, E); }
        } else if (k == 3) {
            pg8::Gemm g{XB, (const bf16*)(wA + W_IN), M, NIN, D}; pg8::StaticOrder S; S.init(M, NIN, G, wg);
            { const LAS float* rsl_c = (const LAS float*)(lds + RSL_OFF); LAS float* rsl_w = (LAS float*)(lds + RSL_OFF); pg8::Unit uu;
#pragma unroll 1
              for (int i = 0; i < pg8::RSL_UNITS; ++i) if (S.next(i, uu) && tid < 256) rsl_w[i * 256 + tid] = pg8::row_rstd(ssqp, uu.pm * 256 + tid);
              __syncthreads(); (void)rsl_c; }
            pg8::EpiWin E{QKV, GATE, ssqp, (const float*)(ws + WS_ROPE), (const LAS float*)(lds + RSL_OFF)};
            pg8::gemm_phase<pg8::EpiWin, pg8::StaticOrder, true, true>(lds, g, S, E);
        } else if (k == 4) {
            attn_phase(ws, (unsigned char*)Pout, lds, G, wg, NGW, wave, lane);
        }
        else if (k == 5) {
            pg8::Unit pu; { pg8::StaticOrder S; S.init(M, D, G, wg); S.next(0, pu); }
            unsigned* pcnt = (unsigned*)(ws + WS_PCNT) + (size_t)l * 2 * 4096;
            if (chain) { const int r0 = pu.pm * 256 + pu.pn * 64; merge_quarter(ws, (unsigned char*)Pout, r0 * 32, tid); panel_arrive(pcnt, pu.pm, wave, lane); }
            else merge_phase(ws, (unsigned char*)Pout, 0, M * 32, gtid, NT);
            if (chain) {
                int K256 = 256; asm volatile("" : "+s"(K256));
                { pg8::Gemm g{(const bf16*)(ws + WS_OS), (const bf16*)(wsw + W_PS), M, D, K256, (const bf16*)((unsigned char*)Pout + OUT_OD), (const bf16*)(wsw + W_PD)}; pg8::PairOrder S; S.init(M, D, G, wg); S.cnt = pcnt;
                  pg8::EpiGate2 E{GATE, (bf16*)(ws + WS_Y1), (bf16*)(ws + WS_Y)};
                  pg8::gemm_phase<pg8::EpiGate2, pg8::PairOrder, true, true>(lds, g, S, E); }
                panel_sync(pcnt + 4096, pu.pm, wave, lane);
                { pg8::Gemm g{(const bf16*)(ws + WS_Y), (const bf16*)(wsw + W_OUT), M, D, D}; pg8::StaticOrder S; S.init(M, D, G, wg);
                  pg8::EpiResid<false> E{nullptr, XB, ssqp, 1.0f};
                  pg8::gemm_phase<pg8::EpiResid<false>, pg8::StaticOrder, true, true>(lds, g, S, E); }
            }
        }
        else if (k == 6) {
            int K256 = 256; asm volatile("" : "+s"(K256));
            { pg8::Gemm g{(const bf16*)((unsigned char*)Pout + OUT_OD), (const bf16*)(wsw + W_PD), M, D, K256}; pg8::StaticOrder S; S.init(M, D, G, wg);
              pg8::EpiGate<false> E{GATE, (bf16*)(ws + WS_Y1), (bf16*)(ws + WS_Y)};
              pg8::gemm_phase<pg8::EpiGate<false>, pg8::StaticOrder, true, true>(lds, g, S, E); }
            { pg8::Gemm g{(const bf16*)(ws + WS_OS), (const bf16*)(wsw + W_PS), M, D, K256}; pg8::StaticOrder S; S.init(M, D, G, wg);
              pg8::EpiGate<true> E{GATE + 1024, (bf16*)(ws + WS_Y1), (bf16*)(ws + WS_Y)};
              pg8::gemm_phase<pg8::EpiGate<true>, pg8::StaticOrder, true, true>(lds, g, S, E); }
        } else if (k == 7) {
            pg8::Gemm g{(const bf16*)(ws + WS_Y), (const bf16*)(wsw + W_OUT), M, D, D}; pg8::StaticOrder S; S.init(M, D, G, wg);
            pg8::EpiResid<false> E{nullptr, XB, ssqp, 1.0f};
            pg8::gemm_phase<pg8::EpiResid<false>, pg8::StaticOrder, true, true>(lds, g, S, E);
        } else final_phase(ws, Pout, KARG(14), gw, NGW, lane);
        if (ph + 1 < args.ph_hi && !(fuse_final && ph == N_PHASES - 2)) {
            unsigned* barw = (unsigned*)(ws + WS_BAR);
            if (args.ph_hi > 1000) grid.sync();
            { XcdBarrier bar; bar.bar = barw; bar.x = xb_xcc_id(); bar.st = bst; xcd_barrier(bar);
            }
        }
    }
}

extern "C" void kernel_launch(void* const* d_in, const int* in_sizes, int n_in, void* d_out, int out_size, void* d_ws, size_t ws_size, hipStream_t stream) {
    static int grid = 0;
    if (grid == 0) {
        if (n_in != 15 || in_sizes[0] != M * D || out_size != M * D || ws_size < WS_END) { fprintf(stderr, "kernel_launch: unexpected shapes (n_in %d, in0 %d, out %d, ws %zu)\n", n_in, n_in > 0 ? in_sizes[0] : -1, out_size, ws_size); grid = -1; return; }
        int dev = 0, cus = 0, per_cu = 0;
        if (hipGetDevice(&dev) != hipSuccess || hipDeviceGetAttribute(&cus, hipDeviceAttributeMultiprocessorCount, dev) != hipSuccess) { grid = -1; return; }
        if (hipFuncSetAttribute((const void*)fwd_megakernel, hipFuncAttributeMaxDynamicSharedMemorySize, LDS_BYTES) != hipSuccess) { fprintf(stderr, "kernel_launch: hipFuncSetAttribute failed\n"); grid = -1; return; }
        if (hipOccupancyMaxActiveBlocksPerMultiprocessor(&per_cu, (const void*)fwd_megakernel, NWAVES * 64, LDS_BYTES) != hipSuccess || per_cu < 1) { fprintf(stderr, "kernel_launch: occupancy query says %d\n", per_cu); per_cu = 1; }
        (void)hipGetLastError();
        grid = cus;
        if (grid < 176) { fprintf(stderr, "kernel_launch: %d CUs: the per-workgroup rstd table holds 8 units per GEMM phase (needs >= 176 workgroups)\n", grid); grid = -1; return; }
    }
    if (grid < 0) return;
    Args a{};
    for (int i = 0; i < 15; ++i) a.in[i] = (const float*)d_in[i];
    a.out = (float*)d_out; a.ws = (unsigned char*)d_ws;
#if N_LAUNCH_MODE == 0
    a.ph_lo = 0; a.ph_hi = N_PHASES;
    if (hipMemsetAsync((char*)d_ws + WS_BAR, 0, WS_ZERO_BYTES, stream) != hipSuccess) { fprintf(stderr, "kernel_launch: memset of the barrier words failed\n"); return; }
    void* kargs[] = {&a};
    const hipError_t e = hipLaunchCooperativeKernel((const void*)fwd_megakernel, dim3(grid), dim3(NWAVES * 64), kargs, LDS_BYTES, stream);
    if (e != hipSuccess) fprintf(stderr, "kernel_launch: cooperative launch failed: %s (grid %d)\n", hipGetErrorString(e), grid);
#else
    for (int ph = 0; ph < N_PHASES; ++ph) {
        a.ph_lo = ph; a.ph_hi = ph + 1;
        hipLaunchKernelGGL(fwd_megakernel, dim3(grid), dim3(NWAVES * 64), LDS_BYTES, stream, a);
    }
#endif
}
```

```cpp
#include <hip/hip_runtime.h>
#include <hip/hip_cooperative_groups.h>
#include <cstdio>
#include <cstdint>
namespace cg = cooperative_groups;
namespace pg8 {
#define PG8_LAS __attribute__((address_space(3)))
typedef unsigned short bf16_t;
typedef short bf16x8 __attribute__((ext_vector_type(8)));
typedef float f32x4 __attribute__((ext_vector_type(4)));
typedef unsigned u32x4 __attribute__((ext_vector_type(4)));
constexpr int BM = 256, BK = 64, HALF = 128, HTB = HALF * BK * 2  , STAGE_BYTES = 8 * HTB, NXCD = 8, WGM = 8;

__host__ __device__ __forceinline__ int lds_byte(int r, int c) { const int st = (r >> 4) * 2 + (c >> 5), rr = r & 15, cc = c & 31, ob = rr * 64 + cc * 2; return st * 1024 + (ob ^ (((ob >> 9) & 1) << 5)); }
__host__ __device__ __forceinline__ void stage_rc(int b, int& R, int& C) { const int st = b / 1024, sb = b % 1024, swz = sb ^ (((sb >> 9) & 1) << 5); R = (st >> 1) * 16 + swz / 64; C = (st & 1) * 32 + (swz % 64) / 2; }
__host__ __device__ __forceinline__ int perm32(int rho) { const int n = rho >> 4, i = rho & 15; return 8 * (i >> 2) + 4 * n + (i & 3); }

struct Unit { int pm, pn, ui, sel; };
struct Gemm { const bf16_t* A; const bf16_t* Bt; int M, N, K; const bf16_t* A2 = nullptr; const bf16_t* Bt2 = nullptr; };

struct StaticOrder {
    int nM, nN, nwg, G, c;
    __host__ __device__ void init(int M, int N, int G_, int c_) { nM = M / BM; nN = N / BM; nwg = nM * nN; G = G_; c = c_; }
    __host__ __device__ bool next(int i, Unit& u) const {
        const long L = (long)i * G + c; if (L >= nwg) return false;
        int wgid = (int)L; { const int q = nwg / NXCD, r = nwg % NXCD, xcd = wgid % NXCD, off = wgid / NXCD; wgid = (xcd < r ? xcd * (q + 1) : r * (q + 1) + (xcd - r) * q) + off; }
        const int nig = WGM * nN, gid = wgid / nig, fm = gid * WGM, gsz = (nM - fm) < WGM ? (nM - fm) : WGM;
        u.pm = fm + ((wgid % nig) % gsz); u.pn = (wgid % nig) / gsz; u.ui = i; u.sel = 0; return true;
    }
    __device__ __forceinline__ void a_ready(const Unit&) const {}
    __device__ __forceinline__ void done(const Unit&) const {}
};
struct PairOrder : StaticOrder {
    unsigned* cnt;
    __host__ __device__ bool next(int i, Unit& u) const { if (i >= 2) return false; if (!StaticOrder::next(0, u)) return false; u.ui = i; u.sel = i; return true; }
    __device__ __forceinline__ void a_ready(const Unit& u) const {
        if (u.sel == 1 && cnt != nullptr) {
            if (threadIdx.x < 64) { unsigned spins = 0;
                while ((unsigned)__builtin_amdgcn_readfirstlane(__hip_atomic_load(cnt + 64 * u.pm, __ATOMIC_RELAXED, __HIP_MEMORY_SCOPE_AGENT)) < 4u) { __builtin_amdgcn_s_sleep(1); if (++spins > (1u << 20)) break; }
                __builtin_amdgcn_fence(__ATOMIC_ACQUIRE, "agent");
                asm volatile("s_waitcnt vmcnt(0)" ::: "memory"); }
            asm volatile("" ::: "memory"); __builtin_amdgcn_s_barrier(); asm volatile("" ::: "memory");
        }
    }
};

typedef float f32x2_cv __attribute__((ext_vector_type(2))); typedef __bf16 bf16x2_cv __attribute__((ext_vector_type(2)));
__device__ __forceinline__ unsigned cvt_pk_bf16(float lo, float hi) { const f32x2_cv v = {lo, hi}; const bf16x2_cv b = __builtin_convertvector(v, bf16x2_cv); return __builtin_bit_cast(unsigned, b); }
typedef unsigned u32x2 __attribute__((ext_vector_type(2)));
constexpr float LOG2E = 1.4426950408889634f;
constexpr int RSL_UNITS = 8;
__device__ __forceinline__ float row_rstd(const float* ssqp, int r) {
    const f32x4* p = (const f32x4*)(ssqp + (size_t)r * 16);
    const f32x4 a = p[0], b = p[1], c = p[2], d = p[3];
    const float s = (((a[0] + a[1]) + (a[2] + a[3])) + ((b[0] + b[1]) + (b[2] + b[3]))) + (((c[0] + c[1]) + (c[2] + c[3])) + ((d[0] + d[1]) + (d[2] + d[3])));
    return __builtin_amdgcn_rsqf(s * (1.0f / 1024.0f) + 1e-6f);
}
__device__ __forceinline__ float bf2f(unsigned short b) { return __uint_as_float(((unsigned)b) << 16); }
struct EpiSwiglu {
    static constexpr bool PERM = true, AFTER_DRAIN = false, HAS_INIT = false;
    bf16_t* H; const float* ssqp; const PG8_LAS float* rsl;
    __device__ __forceinline__ void operator()(const f32x4 (&acc)[2][2][4][2], const Unit& u, int wr, int wc, int fr, int fq) const {
        const int row0 = u.pm * BM + wr * 64 + fr, col0 = u.pn * 128 + wc * 32 + 8 * fq;
#pragma unroll
        for (int ai = 0; ai < 2; ++ai)
#pragma unroll
            for (int m = 0; m < 4; ++m) {
                const int r = row0 + ai * HALF + m * 16; const float rs = rsl[u.ui * 256 + ai * HALF + wr * 64 + m * 16 + fr];
                const float nrl = -rs * LOG2E, rs2 = rs * rs; f32x4 hq[2];
#pragma unroll
                for (int n = 0; n < 2; ++n) { const f32x4 ga = acc[ai][0][m][n], ua = acc[ai][1][m][n]; const f32x4 x = ga * nrl; f32x4 e;
                    e[0] = __builtin_amdgcn_exp2f(x[0]); e[1] = __builtin_amdgcn_exp2f(x[1]); e[2] = __builtin_amdgcn_exp2f(x[2]); e[3] = __builtin_amdgcn_exp2f(x[3]);
                    const f32x4 d = e + 1.0f; f32x4 rc; rc[0] = __builtin_amdgcn_rcpf(d[0]); rc[1] = __builtin_amdgcn_rcpf(d[1]); rc[2] = __builtin_amdgcn_rcpf(d[2]); rc[3] = __builtin_amdgcn_rcpf(d[3]);
                    hq[n] = (ga * ua) * (rc * rs2); }
                u32x4 w; w.x = cvt_pk_bf16(hq[0][0], hq[0][1]); w.y = cvt_pk_bf16(hq[0][2], hq[0][3]); w.z = cvt_pk_bf16(hq[1][0], hq[1][1]); w.w = cvt_pk_bf16(hq[1][2], hq[1][3]);
                *(u32x4*)(H + ((unsigned)r * 2816u + (unsigned)col0)) = w;
            }
    }
};
template <bool BASE32> struct EpiResid {
    static constexpr bool PERM = true, AFTER_DRAIN = false, HAS_INIT = true;
    const float* base32; bf16_t* xb; float* ssqp; float alpha;
    __device__ __forceinline__ void init(f32x4 (&acc)[2][2][4][2], const Unit& u, int wr, int wc, int fr, int fq) const {
        const unsigned row0 = u.pm * BM + wr * 64 + fr, col0 = u.pn * BM + wc * 32 + 8 * fq; const float ia = 1.0f / alpha;
#pragma unroll
        for (int ai = 0; ai < 2; ++ai)
#pragma unroll
            for (int m = 0; m < 4; ++m)
#pragma unroll
                for (int bj = 0; bj < 2; ++bj) { const unsigned off = (row0 + ai * HALF + m * 16) * 1024u + col0 + bj * HALF;
                    f32x4 b0, b1;
                    if (BASE32) { b0 = __builtin_nontemporal_load((const f32x4*)(base32 + off)); b1 = __builtin_nontemporal_load((const f32x4*)(base32 + off + 4)); }
                    else { const u32x4 bw = __builtin_nontemporal_load((const u32x4*)(xb + off));
                        b0[0] = __uint_as_float(bw.x << 16); b0[1] = __uint_as_float(bw.x & 0xffff0000u); b0[2] = __uint_as_float(bw.y << 16); b0[3] = __uint_as_float(bw.y & 0xffff0000u);
                        b1[0] = __uint_as_float(bw.z << 16); b1[1] = __uint_as_float(bw.z & 0xffff0000u); b1[2] = __uint_as_float(bw.w << 16); b1[3] = __uint_as_float(bw.w & 0xffff0000u); }
                    acc[ai][bj][m][0] = b0 * ia; acc[ai][bj][m][1] = b1 * ia; }
    }
    __device__ __forceinline__ void operator()(const f32x4 (&acc)[2][2][4][2], const Unit& u, int wr, int wc, int fr, int fq) const {
        const unsigned row0 = u.pm * BM + wr * 64 + fr, col0 = u.pn * BM + wc * 32 + 8 * fq;
#pragma unroll
        for (int ai = 0; ai < 2; ++ai)
#pragma unroll
            for (int m = 0; m < 4; ++m) {
                const unsigned r = row0 + ai * HALF + m * 16; float s = 0.f;
#pragma unroll
                for (int bj = 0; bj < 2; ++bj) { const unsigned off = r * 1024u + col0 + bj * HALF;
                    const f32x4 o0 = acc[ai][bj][m][0] * alpha, o1 = acc[ai][bj][m][1] * alpha;
                    u32x4 w; w.x = cvt_pk_bf16(o0[0], o0[1]); w.y = cvt_pk_bf16(o0[2], o0[3]); w.z = cvt_pk_bf16(o1[0], o1[1]); w.w = cvt_pk_bf16(o1[2], o1[3]);
                    *(u32x4*)(xb + off) = w;
                    f32x4 q0, q1;
                    q0[0] = __uint_as_float(w.x << 16); q0[1] = __uint_as_float(w.x & 0xffff0000u); q0[2] = __uint_as_float(w.y << 16); q0[3] = __uint_as_float(w.y & 0xffff0000u);
                    q1[0] = __uint_as_float(w.z << 16); q1[1] = __uint_as_float(w.z & 0xffff0000u); q1[2] = __uint_as_float(w.w << 16); q1[3] = __uint_as_float(w.w & 0xffff0000u);
                    const f32x4 sq = q0 * q0 + q1 * q1; s += (sq[0] + sq[1]) + (sq[2] + sq[3]); }
                { const auto t16 = __builtin_amdgcn_permlane16_swap(__float_as_uint(s), __float_as_uint(s), false, false); s = __uint_as_float(t16[0]) + __uint_as_float(t16[1]);
                  const auto t32 = __builtin_amdgcn_permlane32_swap(__float_as_uint(s), __float_as_uint(s), false, false); s = __uint_as_float(t32[0]) + __uint_as_float(t32[1]); }
                if (fq == 0) ssqp[r * 16u + u.pn * 4 + wc] = s;
            }
    }
};
struct EpiResidFinal {
    static constexpr bool PERM = true, AFTER_DRAIN = true, HAS_INIT = true;
    const bf16_t* xb; float* out; const float* gain; unsigned* xslot; unsigned* cnt; float alpha;
    __device__ __forceinline__ void init(f32x4 (&acc)[2][2][4][2], const Unit& u, int wr, int wc, int fr, int fq) const {
        const unsigned row0 = u.pm * BM + wr * 64 + fr, col0 = u.pn * BM + wc * 32 + 8 * fq; const float ia = 1.0f / alpha;
#pragma unroll
        for (int ai = 0; ai < 2; ++ai)
#pragma unroll
            for (int m = 0; m < 4; ++m)
#pragma unroll
                for (int bj = 0; bj < 2; ++bj) { const unsigned off = (row0 + ai * HALF + m * 16) * 1024u + col0 + bj * HALF; const u32x4 bw = __builtin_nontemporal_load((const u32x4*)(xb + off)); f32x4 b0, b1;
                    b0[0] = __uint_as_float(bw.x << 16); b0[1] = __uint_as_float(bw.x & 0xffff0000u); b0[2] = __uint_as_float(bw.y << 16); b0[3] = __uint_as_float(bw.y & 0xffff0000u);
                    b1[0] = __uint_as_float(bw.z << 16); b1[1] = __uint_as_float(bw.z & 0xffff0000u); b1[2] = __uint_as_float(bw.w << 16); b1[3] = __uint_as_float(bw.w & 0xffff0000u);
                    acc[ai][bj][m][0] = b0 * ia; acc[ai][bj][m][1] = b1 * ia; }
    }
    __device__ __forceinline__ void fused(f32x4 (&acc)[2][2][4][2], const Unit& u, int wr, int wc, int fr, int fq, PG8_LAS unsigned char* lds, int wid, int lane) const {
        PG8_LAS float* P = (PG8_LAS float*)lds;
        PG8_LAS float* S = (PG8_LAS float*)(lds + 4096);
        const int tid = wid * 64 + lane;
#pragma unroll
        for (int ai = 0; ai < 2; ++ai)
#pragma unroll
            for (int m = 0; m < 4; ++m) { float s = 0.f;
#pragma unroll
                for (int bj = 0; bj < 2; ++bj)
#pragma unroll
                    for (int n = 0; n < 2; ++n) { const f32x4 o = acc[ai][bj][m][n] * alpha; acc[ai][bj][m][n] = o; const f32x4 q = o * o; s += (q[0] + q[1]) + (q[2] + q[3]); }
                { const auto t16 = __builtin_amdgcn_permlane16_swap(__float_as_uint(s), __float_as_uint(s), false, false); s = __uint_as_float(t16[0]) + __uint_as_float(t16[1]);
                  const auto t32 = __builtin_amdgcn_permlane32_swap(__float_as_uint(s), __float_as_uint(s), false, false); s = __uint_as_float(t32[0]) + __uint_as_float(t32[1]); }
                if (fq == 0) P[(ai * HALF + wr * 64 + m * 16 + fr) * 4 + wc] = s; }
        asm volatile("s_waitcnt lgkmcnt(0)" ::: "memory"); __builtin_amdgcn_s_barrier(); asm volatile("" ::: "memory");
        if (tid < 256) { const float t = (P[tid * 4 + 0] + P[tid * 4 + 1]) + (P[tid * 4 + 2] + P[tid * 4 + 3]);
            __hip_atomic_store(xslot + ((size_t)(u.pm * BM + tid) * 4 + u.pn), __float_as_uint(t), __ATOMIC_RELAXED, __HIP_MEMORY_SCOPE_AGENT); }
        asm volatile("s_waitcnt vmcnt(0)" ::: "memory");
        if (lane == 0) __hip_atomic_fetch_add(cnt + 64 * u.pm, 1u, __ATOMIC_RELAXED, __HIP_MEMORY_SCOPE_AGENT);
        if (wid == 0) { unsigned spins = 0;
            while ((unsigned)__builtin_amdgcn_readfirstlane(__hip_atomic_load(cnt + 64 * u.pm, __ATOMIC_RELAXED, __HIP_MEMORY_SCOPE_AGENT)) < 32u) { __builtin_amdgcn_s_sleep(2); if (++spins > (1u << 20)) break; }
            __builtin_amdgcn_fence(__ATOMIC_ACQUIRE, "agent"); }
        asm volatile("s_waitcnt vmcnt(0) lgkmcnt(0)" ::: "memory"); __builtin_amdgcn_s_barrier(); asm volatile("" ::: "memory");
        if (tid < 256) { const unsigned* sl = xslot + (size_t)(u.pm * BM + tid) * 4; float t = 0.f;
#pragma unroll
            for (int k = 0; k < 4; ++k) t += __uint_as_float(__hip_atomic_load(sl + k, __ATOMIC_RELAXED, __HIP_MEMORY_SCOPE_AGENT));
            S[tid] = __builtin_amdgcn_rsqf(t * (1.0f / 1024.0f) + 1e-6f); }
        asm volatile("s_waitcnt vmcnt(0) lgkmcnt(0)" ::: "memory"); __builtin_amdgcn_s_barrier(); asm volatile("" ::: "memory");
        const unsigned row0 = u.pm * BM + wr * 64 + fr, col0 = u.pn * BM + wc * 32 + 8 * fq;
        f32x4 gv[2][2];
#pragma unroll
        for (int bj = 0; bj < 2; ++bj) { gv[bj][0] = *(const f32x4*)(gain + col0 + bj * HALF); gv[bj][1] = *(const f32x4*)(gain + col0 + bj * HALF + 4); }
#pragma unroll
        for (int ai = 0; ai < 2; ++ai)
#pragma unroll
            for (int m = 0; m < 4; ++m) { const float rs = S[ai * HALF + wr * 64 + m * 16 + fr]; const unsigned r = row0 + ai * HALF + m * 16;
#pragma unroll
                for (int bj = 0; bj < 2; ++bj) { float* op = out + (r * 1024u + col0 + bj * HALF);
                    *(f32x4*)op = acc[ai][bj][m][0] * rs * gv[bj][0]; *(f32x4*)(op + 4) = acc[ai][bj][m][1] * rs * gv[bj][1]; } }
    }
};
struct EpiWin {
    static constexpr bool PERM = true, AFTER_DRAIN = false, HAS_INIT = false;
    bf16_t* QKV; bf16_t* GATE; const float* ssqp; const float* rope; const PG8_LAS float* rsl;
    __device__ __forceinline__ void operator()(const f32x4 (&acc)[2][2][4][2], const Unit& u, int wr, int wc, int fr, int fq) const {
        const int row0 = u.pm * BM + wr * 64 + fr; const int pn = u.pn; const bool isgate = pn >= 12;
        const bool dorope = (pn < 6) && ((wc & 1) == 0) && (fq < 2); const float qs = (pn < 3 || pn == 9) ? 0.125f : 1.0f;
#pragma unroll
        for (int ai = 0; ai < 2; ++ai)
#pragma unroll
            for (int m = 0; m < 4; ++m) {
                const int r = row0 + ai * HALF + m * 16; const float rs = rsl[u.ui * 256 + ai * HALF + wr * 64 + m * 16 + fr]; const int t = r & 4095;
#pragma unroll
                for (int bj = 0; bj < 2; ++bj) {
                    const int colt = bj * HALF + wc * 32 + 8 * fq; float v[8];
#pragma unroll
                    for (int n = 0; n < 2; ++n)
#pragma unroll
                        for (int j = 0; j < 4; ++j) v[n * 4 + j] = acc[ai][bj][m][n][j] * rs;
                    bf16_t* dst;
                    if (isgate) {
#pragma unroll
                        for (int i = 0; i < 8; ++i) v[i] = __builtin_amdgcn_rcpf(1.0f + __builtin_amdgcn_exp2f(-v[i] * LOG2E));
                        dst = GATE + ((unsigned)r * 2048u + (unsigned)((pn - 12) * 256 + colt));
                    } else {
                        if (dorope) {
                            const f32x4* cs = (const f32x4*)(rope + ((unsigned)t * 16u + 8u * (unsigned)fq));
                            const f32x4 c01 = cs[0], c23 = cs[1];
                            { const float x1 = v[0], x2 = v[1]; v[0] = x1 * c01[0] - x2 * c01[1]; v[1] = x2 * c01[0] + x1 * c01[1]; }
                            { const float x1 = v[2], x2 = v[3]; v[2] = x1 * c01[2] - x2 * c01[3]; v[3] = x2 * c01[2] + x1 * c01[3]; }
                            { const float x1 = v[4], x2 = v[5]; v[4] = x1 * c23[0] - x2 * c23[1]; v[5] = x2 * c23[0] + x1 * c23[1]; }
                            { const float x1 = v[6], x2 = v[7]; v[6] = x1 * c23[2] - x2 * c23[3]; v[7] = x2 * c23[2] + x1 * c23[3]; }
                        }
#pragma unroll
                        for (int i = 0; i < 8; ++i) v[i] *= qs;
                        { const unsigned cc = (unsigned)(pn * 256 + colt); dst = QKV + (((cc >> 6) * 16384u + (unsigned)r) * 64u + (cc & 63u)); }
                    }
                    u32x4 w; w.x = cvt_pk_bf16(v[0], v[1]); w.y = cvt_pk_bf16(v[2], v[3]); w.z = cvt_pk_bf16(v[4], v[5]); w.w = cvt_pk_bf16(v[6], v[7]);
                    *(u32x4*)dst = w;
                }
                asm volatile("" ::: "memory");
            }
    }
};
template <bool SECOND> struct EpiGate {
    static constexpr bool PERM = true, AFTER_DRAIN = false, HAS_INIT = false;
    const bf16_t* gate; bf16_t* Y1; bf16_t* Y;
    __device__ __forceinline__ void operator()(const f32x4 (&acc)[2][2][4][2], const Unit& u, int wr, int wc, int fr, int fq) const {
        const unsigned row0 = u.pm * BM + wr * 64 + fr, col0 = u.pn * BM + wc * 32 + 8 * fq;
#pragma unroll
        for (int ai = 0; ai < 2; ++ai)
#pragma unroll
            for (int m = 0; m < 4; ++m) {
                const unsigned r = row0 + ai * HALF + m * 16;
#pragma unroll
                for (int bj = 0; bj < 2; ++bj) {
                    const unsigned c = col0 + bj * HALF; const unsigned go = r * 2048u + c, yo = r * 1024u + c;
                    const u32x4 gw = *(const u32x4*)(gate + go);
                    f32x4 a0 = acc[ai][bj][m][0], a1 = acc[ai][bj][m][1];
                    a0[0] *= __uint_as_float(gw.x << 16); a0[1] *= __uint_as_float(gw.x & 0xffff0000u); a0[2] *= __uint_as_float(gw.y << 16); a0[3] *= __uint_as_float(gw.y & 0xffff0000u);
                    a1[0] *= __uint_as_float(gw.z << 16); a1[1] *= __uint_as_float(gw.z & 0xffff0000u); a1[2] *= __uint_as_float(gw.w << 16); a1[3] *= __uint_as_float(gw.w & 0xffff0000u);
                    if (!SECOND) { u32x4 w; w.x = cvt_pk_bf16(a0[0], a0[1]); w.y = cvt_pk_bf16(a0[2], a0[3]); w.z = cvt_pk_bf16(a1[0], a1[1]); w.w = cvt_pk_bf16(a1[2], a1[3]); *(u32x4*)(Y1 + yo) = w; }
                    else { const u32x4 yw = *(const u32x4*)(Y1 + yo);
                        a0[0] += __uint_as_float(yw.x << 16); a0[1] += __uint_as_float(yw.x & 0xffff0000u); a0[2] += __uint_as_float(yw.y << 16); a0[3] += __uint_as_float(yw.y & 0xffff0000u);
                        a1[0] += __uint_as_float(yw.z << 16); a1[1] += __uint_as_float(yw.z & 0xffff0000u); a1[2] += __uint_as_float(yw.w << 16); a1[3] += __uint_as_float(yw.w & 0xffff0000u);
                        u32x4 w; w.x = cvt_pk_bf16(a0[0], a0[1]); w.y = cvt_pk_bf16(a0[2], a0[3]); w.z = cvt_pk_bf16(a1[0], a1[1]); w.w = cvt_pk_bf16(a1[2], a1[3]);
                        __builtin_amdgcn_raw_buffer_store_b128(w, __builtin_amdgcn_make_buffer_rsrc(Y, 0, 16384 * 1024 * 2, 0x00020000), yo * 2u, 0,   16); }
                    asm volatile("" ::: "memory");
                }
            }
    }
};
struct EpiGate2 {
    static constexpr bool PERM = true, AFTER_DRAIN = false, HAS_INIT = false;
    const bf16_t* gate; bf16_t* Y1; bf16_t* Y;
    __device__ __forceinline__ void operator()(const f32x4 (&acc)[2][2][4][2], const Unit& u, int wr, int wc, int fr, int fq) const {
        const unsigned row0 = u.pm * BM + wr * 64 + fr, col0 = u.pn * BM + wc * 32 + 8 * fq; const bool second = u.sel != 0; const unsigned gofs = second ? 0u : 1024u;
#pragma unroll
        for (int ai = 0; ai < 2; ++ai)
#pragma unroll
            for (int m = 0; m < 4; ++m) {
                const unsigned r = row0 + ai * HALF + m * 16;
#pragma unroll
                for (int bj = 0; bj < 2; ++bj) {
                    const unsigned c = col0 + bj * HALF; const unsigned go = r * 2048u + gofs + c, yo = r * 1024u + c;
                    const u32x4 gw = __builtin_nontemporal_load((const u32x4*)(gate + go));
                    f32x4 a0 = acc[ai][bj][m][0], a1 = acc[ai][bj][m][1];
                    a0[0] *= __uint_as_float(gw.x << 16); a0[1] *= __uint_as_float(gw.x & 0xffff0000u); a0[2] *= __uint_as_float(gw.y << 16); a0[3] *= __uint_as_float(gw.y & 0xffff0000u);
                    a1[0] *= __uint_as_float(gw.z << 16); a1[1] *= __uint_as_float(gw.z & 0xffff0000u); a1[2] *= __uint_as_float(gw.w << 16); a1[3] *= __uint_as_float(gw.w & 0xffff0000u);
                    if (second) { const u32x4 yw = *(const u32x4*)(Y1 + yo);
                        a0[0] += __uint_as_float(yw.x << 16); a0[1] += __uint_as_float(yw.x & 0xffff0000u); a0[2] += __uint_as_float(yw.y << 16); a0[3] += __uint_as_float(yw.y & 0xffff0000u);
                        a1[0] += __uint_as_float(yw.z << 16); a1[1] += __uint_as_float(yw.z & 0xffff0000u); a1[2] += __uint_as_float(yw.w << 16); a1[3] += __uint_as_float(yw.w & 0xffff0000u); }
                    u32x4 w; w.x = cvt_pk_bf16(a0[0], a0[1]); w.y = cvt_pk_bf16(a0[2], a0[3]); w.z = cvt_pk_bf16(a1[0], a1[1]); w.w = cvt_pk_bf16(a1[2], a1[3]);
                    if (second) __builtin_amdgcn_raw_buffer_store_b128(w, __builtin_amdgcn_make_buffer_rsrc(Y, 0, 16384 * 1024 * 2, 0x00020000), yo * 2u, 0,   16);
                    else *(u32x4*)(Y1 + yo) = w;
                    asm volatile("" ::: "memory");
                }
            }
    }
};

template <class Epi, class Sched, bool ALIGN_EPI = false, bool SP2 = false>
__device__ __forceinline__ void gemm_phase(PG8_LAS unsigned char* lds, const Gemm g, const Sched& S, const Epi& E) {
    int tid_ = threadIdx.x; asm volatile("" : "+v"(tid_));
    const int tid = tid_, wid = __builtin_amdgcn_readfirstlane(tid >> 6), lane = tid & 63, wr = wid >> 2, wc = wid & 3, fr = lane & 15, fq = lane >> 4;
    const int K = g.K, nt = K / BK;
    unsigned voffA[2], voffB[2];
#pragma unroll
    for (int i = 0; i < 2; ++i) { int R, C; stage_rc(tid * 16 + i * 8192, R, C); const int Rb = Epi::PERM ? ((R & ~31) + perm32(R & 31)) : R;
        voffA[i] = (unsigned)(R * K + C) * 2u; voffB[i] = (unsigned)(Rb * K + C) * 2u; }
    const size_t kstep = (size_t)(BK * 2);
    const size_t hstep = (size_t)HALF * K * 2;
    const size_t tstep = 2 * hstep;
    const unsigned ldsw = (unsigned)wid * 1024u;
    const int aoff = lds_byte(wr * 64 + fr, fq * 8), boff = lds_byte(wc * 32 + fr, fq * 8);
#define PG8_SA(b, h) (((b) * 2 + (h)) * HTB)
#define PG8_SB(b, h) ((4 + (b) * 2 + (h)) * HTB)
#define PG8_STAGE(bufoff, gbase, voff) do { _Pragma("unroll") for (int _i = 0; _i < 2; ++_i) \
        __builtin_amdgcn_global_load_lds((const unsigned*)((const char*)(gbase) + (voff)[_i]), (PG8_LAS unsigned*)(lds + (bufoff) + ldsw + _i * 8192), 16, 0, 0); } while (0)
#define PG8_LDA(dst, b, h) do { _Pragma("unroll") for (int m = 0; m < 4; ++m) _Pragma("unroll") for (int k = 0; k < 2; ++k) dst[m][k] = *(const PG8_LAS bf16x8*)(lds + PG8_SA(b, h) + aoff + m * 2048 + k * 1024); } while (0)
#define PG8_LDB(dst, b, h) do { _Pragma("unroll") for (int n = 0; n < 2; ++n) _Pragma("unroll") for (int k = 0; k < 2; ++k) dst[n][k] = *(const PG8_LAS bf16x8*)(lds + PG8_SB(b, h) + boff + n * 2048 + k * 1024); } while (0)
#define PG8_MMA(ai, bj, At, Bt) do { __builtin_amdgcn_s_setprio(1); _Pragma("unroll") for (int m = 0; m < 4; ++m) _Pragma("unroll") for (int n = 0; n < 2; ++n) _Pragma("unroll") for (int k = 0; k < 2; ++k) \
        acc[ai][bj][m][n] = __builtin_amdgcn_mfma_f32_16x16x32_bf16(Bt[n][k], At[m][k], acc[ai][bj][m][n], 0, 0, 0); __builtin_amdgcn_s_setprio(0); } while (0)
#define PG8_WAIT_V(n) asm volatile("s_waitcnt vmcnt(" #n ")" ::: "memory")
#define PG8_WAIT_L(n) asm volatile("s_waitcnt lgkmcnt(" #n ")" ::: "memory")
#define PG8_BAR __builtin_amdgcn_s_barrier()
#define PG8_SCHED __builtin_amdgcn_sched_barrier(0)
    Unit cur, nxt; int ui = 0;
    if (!S.next(0, cur)) return;
    f32x4 acc[2][2][4][2];
    if constexpr (Epi::HAS_INIT) E.init(acc, cur, wr, wc, fr, fq);
    else {
#pragma unroll
    for (int a = 0; a < 2; ++a)
#pragma unroll
        for (int b = 0; b < 2; ++b)
#pragma unroll
            for (int m = 0; m < 4; ++m)
#pragma unroll
                for (int n = 0; n < 2; ++n) acc[a][b][m][n] = (f32x4){0.f, 0.f, 0.f, 0.f};
    }
    bf16x8 At[4][2], B0[2][2], B1[2][2];
    const char* cA = (const char*)(cur.sel ? g.A2 : g.A) + (size_t)cur.pm * tstep; const char* cB = (const char*)(cur.sel ? g.Bt2 : g.Bt) + (size_t)cur.pn * tstep;
    S.a_ready(cur);
    if constexpr (SP2) {
        PG8_STAGE(PG8_SB(0, 0), cB, voffB); PG8_STAGE(PG8_SB(0, 1), cB + hstep, voffB); PG8_STAGE(PG8_SA(0, 0), cA, voffA); PG8_STAGE(PG8_SA(0, 1), cA + hstep, voffA);
        if (wr == 1) PG8_BAR;
        PG8_WAIT_V(2); PG8_BAR;
        PG8_STAGE(PG8_SB(1, 0), cB + kstep, voffB); PG8_STAGE(PG8_SA(1, 0), cA + kstep, voffA); PG8_STAGE(PG8_SB(1, 1), cB + hstep + kstep, voffB);
        PG8_WAIT_V(6); PG8_BAR;
    } else {
        PG8_STAGE(PG8_SB(0, 0), cB, voffB); PG8_STAGE(PG8_SA(0, 0), cA, voffA); PG8_STAGE(PG8_SB(0, 1), cB + hstep, voffB); PG8_STAGE(PG8_SA(0, 1), cA + hstep, voffA);
        if (wr == 1) PG8_BAR;
        PG8_WAIT_V(4); PG8_BAR;
        PG8_STAGE(PG8_SB(1, 0), cB + kstep, voffB); PG8_STAGE(PG8_SA(1, 0), cA + kstep, voffA); PG8_STAGE(PG8_SB(1, 1), cB + hstep + kstep, voffB);
        PG8_WAIT_V(6); PG8_BAR;
    }
    for (;;) {
        const bool has_next = S.next(ui + 1, nxt);
        const char* nA = has_next ? (const char*)(nxt.sel ? g.A2 : g.A) + (size_t)nxt.pm * tstep : cA; const char* nB = has_next ? (const char*)(nxt.sel ? g.Bt2 : g.Bt) + (size_t)nxt.pn * tstep : cB;
        for (int t = 0; t < nt; t += 2) {
            const bool last = (t == nt - 2);
            const char* a1 = cA + (size_t)(t + 1) * kstep;
            const char* a2 = last ? nA : cA + (size_t)(t + 2) * kstep; const char* b2 = last ? nB : cB + (size_t)(t + 2) * kstep;
            const char* a3 = a2 + kstep; const char* b3 = b2 + kstep;
            if (last && has_next) S.a_ready(nxt);
            if constexpr (SP2) {
            PG8_LDB(B0, 0, 0); PG8_LDB(B1, 0, 1); PG8_SCHED; PG8_LDA(At, 0, 0); PG8_STAGE(PG8_SA(1, 1), a1 + hstep, voffA);
            PG8_WAIT_V(8); PG8_WAIT_L(0); PG8_BAR; PG8_MMA(0, 0, At, B0); PG8_MMA(0, 1, At, B1); PG8_BAR; PG8_SCHED;
            PG8_LDA(At, 0, 1); PG8_STAGE(PG8_SB(0, 0), b2, voffB); PG8_STAGE(PG8_SB(0, 1), b2 + hstep, voffB); PG8_STAGE(PG8_SA(0, 0), a2, voffA);
            PG8_WAIT_V(8); PG8_WAIT_L(0); PG8_BAR; PG8_MMA(1, 0, At, B0); PG8_MMA(1, 1, At, B1); PG8_BAR; PG8_SCHED;
            PG8_LDB(B0, 1, 0); PG8_LDB(B1, 1, 1); PG8_SCHED; PG8_LDA(At, 1, 0); PG8_STAGE(PG8_SA(0, 1), a2 + hstep, voffA);
            PG8_WAIT_V(8); PG8_WAIT_L(0); PG8_BAR; PG8_MMA(0, 0, At, B0); PG8_MMA(0, 1, At, B1); PG8_BAR; PG8_SCHED;
            PG8_LDA(At, 1, 1); PG8_STAGE(PG8_SB(1, 0), b3, voffB); PG8_STAGE(PG8_SB(1, 1), b3 + hstep, voffB); PG8_STAGE(PG8_SA(1, 0), a3, voffA);
            PG8_WAIT_V(8); PG8_WAIT_L(0); PG8_BAR; PG8_MMA(1, 0, At, B0); PG8_MMA(1, 1, At, B1); PG8_BAR; PG8_SCHED;
            } else {
            PG8_LDB(B0, 0, 0); PG8_SCHED; PG8_LDA(At, 0, 0); PG8_STAGE(PG8_SA(1, 1), a1 + hstep, voffA);
            PG8_WAIT_L(8); PG8_BAR; PG8_WAIT_L(0); PG8_MMA(0, 0, At, B0); PG8_BAR; PG8_SCHED;
            PG8_LDB(B1, 0, 1); PG8_STAGE(PG8_SB(0, 0), b2, voffB);
            PG8_BAR; PG8_WAIT_L(0); PG8_MMA(0, 1, At, B1); PG8_BAR;
            PG8_LDA(At, 0, 1); PG8_STAGE(PG8_SA(0, 0), a2, voffA);
            PG8_BAR; PG8_WAIT_L(0); PG8_MMA(1, 0, At, B0); PG8_BAR; PG8_SCHED;
            PG8_STAGE(PG8_SB(0, 1), b2 + hstep, voffB);
            PG8_WAIT_V(6); PG8_BAR; PG8_MMA(1, 1, At, B1); PG8_BAR;
            PG8_LDB(B0, 1, 0); PG8_SCHED; PG8_LDA(At, 1, 0); PG8_STAGE(PG8_SA(0, 1), a2 + hstep, voffA);
            PG8_WAIT_L(8); PG8_BAR; PG8_WAIT_L(0); PG8_MMA(0, 0, At, B0); PG8_BAR; PG8_SCHED;
            PG8_LDB(B1, 1, 1); PG8_STAGE(PG8_SB(1, 0), b3, voffB);
            PG8_BAR; PG8_WAIT_L(0); PG8_MMA(0, 1, At, B1); PG8_BAR;
            PG8_LDA(At, 1, 1); PG8_STAGE(PG8_SA(1, 0), a3, voffA);
            PG8_BAR; PG8_WAIT_L(0); PG8_MMA(1, 0, At, B0); PG8_BAR; PG8_SCHED;
            PG8_STAGE(PG8_SB(1, 1), b3 + hstep, voffB);
            PG8_WAIT_V(6); PG8_BAR; PG8_MMA(1, 1, At, B1); PG8_BAR;
            }
        }
        if constexpr (ALIGN_EPI) { if (wr == 0) PG8_BAR; }
        if constexpr (!Epi::AFTER_DRAIN) { E(acc, cur, wr, wc, fr, fq); S.done(cur); }
        if (!has_next) break;
        if constexpr (Epi::HAS_INIT) E.init(acc, nxt, wr, wc, fr, fq);
        else {
#pragma unroll
        for (int a = 0; a < 2; ++a)
#pragma unroll
            for (int b = 0; b < 2; ++b)
#pragma unroll
                for (int m = 0; m < 4; ++m)
#pragma unroll
                    for (int n = 0; n < 2; ++n) acc[a][b][m][n] = (f32x4){0.f, 0.f, 0.f, 0.f};
        }
        cur = nxt; cA = nA; cB = nB; ++ui;
        if constexpr (ALIGN_EPI) { if (wr == 1) PG8_BAR; }
    }
    PG8_WAIT_V(0);
    if constexpr (!ALIGN_EPI) { if (wr == 0) PG8_BAR; }
    PG8_BAR;
    if constexpr (Epi::AFTER_DRAIN) { E.fused(acc, cur, wr, wc, fr, fq, lds, wid, lane); S.done(cur); }
#undef PG8_SA
#undef PG8_SB
#undef PG8_STAGE
#undef PG8_LDA
#undef PG8_LDB
#undef PG8_MMA
#undef PG8_WAIT_V
#undef PG8_WAIT_L
#undef PG8_BAR
#undef PG8_SCHED
}
}

#define LAS __attribute__((address_space(3)))
typedef unsigned short bf16;
typedef short bf16x8 __attribute__((ext_vector_type(8)));
typedef short s16x4 __attribute__((ext_vector_type(4)));
typedef float f32x4 __attribute__((ext_vector_type(4)));
typedef float f32x16 __attribute__((ext_vector_type(16)));
typedef unsigned u32x4 __attribute__((ext_vector_type(4)));
typedef unsigned u32x2 __attribute__((ext_vector_type(2)));
constexpr int NWAVES = 8;
constexpr int M = 16384, D = 1024, SEQ = 4096, FF = 2816, NIN = 5120, NQKV = 3072, NGATE = 2048, DEPTH = 2;
constexpr float LOG2E = 1.4426950408889634f;
#ifndef SB_EARLY_EXIT
#define SB_EARLY_EXIT 1
#endif
#ifndef N_LAUNCH_MODE
#define N_LAUNCH_MODE 0
#endif
constexpr size_t MiB = 1u << 20;
constexpr size_t WS_CNT = 16384, WS_PCNT = 32768, WS_ZERO_BYTES = 32768 + 4 * 16384;
constexpr size_t WS_XSLOT = 250 * MiB;
constexpr size_t WS_BAR = 0;
constexpr size_t WS_SSQ = 1 * MiB, WS_ROPE = 2 * MiB, WS_LSE = 3 * MiB;
constexpr size_t WS_W = 4 * MiB;
constexpr size_t W_1CAT = 0, W_D1 = W_1CAT + (size_t)2 * FF * D * 2, W_IN = W_D1 + (size_t)D * FF * 2, W_PD = W_IN + (size_t)NIN * D * 2, W_PS = W_PD + (size_t)D * 256 * 2,
                 W_OUT = W_PS + (size_t)D * 256 * 2, W_2CAT = W_OUT + (size_t)D * D * 2, W_D2 = W_2CAT + (size_t)2 * FF * D * 2, W_END = W_D2 + (size_t)D * FF * 2;
static_assert(W_END <= 46 * MiB, "weights");
constexpr size_t WS_XB = 50 * MiB;
constexpr size_t OUT_OD3 = 0, OUT_OD = 24 * MiB;
constexpr size_t WS_R = 82 * MiB;
constexpr size_t WS_Y1 = WS_R, WS_Y = WS_R + 64 * MiB;
constexpr size_t WS_GATE = 178 * MiB;
constexpr size_t WS_OS = 242 * MiB;
constexpr size_t WS_END = 251 * MiB;
constexpr int RSL_OFF = 131072 + 1024;
constexpr int LDS_BYTES = RSL_OFF + 8 * 256 * 4;

__device__ __forceinline__ float wave_sum(float v) {
#pragma unroll
    for (int o = 1; o < 64; o <<= 1) v += __shfl_xor(v, o);
    return v;
}
__device__ __forceinline__ unsigned pk2(float lo, float hi) { return pg8::cvt_pk_bf16(lo, hi); }
#define LDS_WAIT() asm volatile("s_waitcnt lgkmcnt(0)" ::: "memory")

typedef __attribute__((address_space(1))) unsigned gu32;
#define XB_TMO      128
#define XB_XCNT(j)  (256  + 64 * (j))
#define XB_XSUB(j)  (1280 + 64 * (j))
#define XB_XGEN(j)  (2304 + 64 * (j))
#define XB_TOP      3328
#define XB_TOPGEN   3392
#define XCD_BAR_WORDS 3456
#define XB_SPIN_CAP (1u << 18)

__device__ __forceinline__ unsigned xb_ld(unsigned* p)              { return __hip_atomic_load(p, __ATOMIC_RELAXED, __HIP_MEMORY_SCOPE_AGENT); }
__device__ __forceinline__ unsigned xb_add(unsigned* p, unsigned v) { return __hip_atomic_fetch_add(p, v, __ATOMIC_RELAXED, __HIP_MEMORY_SCOPE_AGENT); }
__device__ __forceinline__ unsigned xb_xcc_id() { return (unsigned)__builtin_amdgcn_s_getreg((3 << 11) | 20) & 0xFu; }
#define XB_SPIN(cond, bar) do { unsigned _sp = 0; while (cond) { __builtin_amdgcn_s_sleep(1); \
    if ((++_sp & 255u) == 0u) { if (xb_ld(&(bar)[XB_TMO])) break; if (_sp > XB_SPIN_CAP) { atomicAdd(&(bar)[XB_TMO], 1u); break; } } } } while (0)

struct XcdBarrier {
    unsigned* bar; unsigned x;
    volatile LAS unsigned* st;
};

__device__ __forceinline__ XcdBarrier xcd_barrier_post(unsigned* bar, volatile LAS unsigned* st) {
    XcdBarrier b; b.bar = bar; b.x = xb_xcc_id(); b.st = st;
    if (threadIdx.x == 0) (void)xb_add(&bar[XB_XCNT(b.x)], 1u);
    return b;
}
__device__ __forceinline__ void xcd_barrier_complete(unsigned* bar, unsigned x, unsigned& nloc, unsigned& nx) {
    const unsigned G = gridDim.x * gridDim.y * gridDim.z;
    unsigned sum, cnt, mine, sp = 0u;
    for (;;) {
        sum = 0u; cnt = 0u; mine = 0u;
#pragma unroll
        for (unsigned j = 0; j < 16; ++j) { const unsigned c = xb_ld(&bar[XB_XCNT(j)]); sum += c; cnt += (c > 0u) ? 1u : 0u; mine = (j == x) ? c : mine; }
        if (sum == G) break;
        __builtin_amdgcn_s_sleep(1);
        if ((++sp & 255u) == 0u) { if (xb_ld(&bar[XB_TMO])) break; if (sp > XB_SPIN_CAP) { atomicAdd(&bar[XB_TMO], 1u); break; } }
    }
    nloc = mine > 0u ? mine : 1u; nx = cnt > 0u ? cnt : 1u;
}

__device__ __forceinline__ void xcd_barrier(const XcdBarrier& b) {
    asm volatile("s_waitcnt vmcnt(0)" ::: "memory");
    __syncthreads();
    if (threadIdx.x == 0) {
        unsigned* bar = b.bar;
        __builtin_amdgcn_s_waitcnt(0);
        unsigned nloc = b.st[0], nx = b.st[1];
        if (nloc == 0u) { xcd_barrier_complete(bar, b.x, nloc, nx); b.st[0] = nloc; b.st[1] = nx; }
        const unsigned old = xb_add(&bar[XB_XSUB(b.x)], 1u);
        const unsigned gen = old / nloc;
        if (old + 1u == (gen + 1u) * nloc) {
            __builtin_amdgcn_fence(__ATOMIC_RELEASE, "agent");
            asm volatile("s_waitcnt vmcnt(0)" ::: "memory");
            const unsigned og = xb_add(&bar[XB_TOP], 1u);
            const unsigned tg = og / nx;
            if (og + 1u == (tg + 1u) * nx) xb_add(&bar[XB_TOPGEN], 1u);
            else XB_SPIN(xb_ld(&bar[XB_TOPGEN]) == tg, bar);
            __builtin_amdgcn_fence(__ATOMIC_ACQUIRE, "agent");
            xb_add(&bar[XB_XGEN(b.x)], 1u);
            asm volatile("s_waitcnt vmcnt(0)" ::: "memory");
        } else {
            XB_SPIN(xb_ld(&bar[XB_XGEN(b.x)]) == gen, bar);
            __builtin_amdgcn_fence(__ATOMIC_ACQUIRE, "agent");
            asm volatile("s_waitcnt vmcnt(0)" ::: "memory");
        }
    }
    __syncthreads();
}


constexpr int CI_D1 = 2816, CI_IN = 4224, CI_B = 6784, CI_D2 = 9600, CI_PD = 11008, CI_PS = 11136, CI_OUT = 11264, CI_END = 11776;
struct ConvItem { const float* wp; const float* gp; bf16* dp; int ldw, K; bool rperm; };
struct ConvSrc { const float *n1, *wg1, *wu1, *wd1, *nm, *win, *wpd, *wps, *wout, *n2, *wg2, *wu2, *wd2; };
__device__ __forceinline__ ConvItem conv_decode(const ConvSrc& S, int l, int r, unsigned char* dA, unsigned char* dB, int lane) {
    const float* src; const float* gain = nullptr; bf16* dst; int ldw = D, K = D, kb, nb, sc0; bool rperm = false;
    if (r < CI_D1) { kb = r / 176; nb = r % 176; const int pn = nb >> 3, i8 = nb & 7; src = (i8 < 4 ? S.wg1 : S.wu1) + (size_t)l * D * FF; gain = S.n1 + (size_t)l * D; dst = (bf16*)(dA + W_1CAT); ldw = FF; sc0 = 128 * pn + 32 * (i8 & 3); }
    else if (r < CI_IN) { r -= CI_D1; kb = r / 32; nb = r % 32; src = S.wd1 + (size_t)l * FF * D; dst = (bf16*)(dA + W_D1); K = FF; sc0 = 32 * nb; }
    else if (r < CI_B) { r -= CI_IN; kb = r / 160; nb = r % 160; src = S.win + (size_t)l * D * NIN; gain = S.nm + (size_t)l * D; dst = (bf16*)(dA + W_IN); ldw = NIN; sc0 = 32 * nb; rperm = (nb < 48) && !(nb & 1); }
    else if (r < CI_D2) { r -= CI_B; kb = r / 176; nb = r % 176; const int pn = nb >> 3, i8 = nb & 7; src = (i8 < 4 ? S.wg2 : S.wu2) + (size_t)l * D * FF; gain = S.n2 + (size_t)l * D; dst = (bf16*)(dB + W_2CAT); ldw = FF; sc0 = 128 * pn + 32 * (i8 & 3); }
    else if (r < CI_PD) { r -= CI_D2; kb = r / 32; nb = r % 32; src = S.wd2 + (size_t)l * FF * D; dst = (bf16*)(dB + W_D2); K = FF; sc0 = 32 * nb; }
    else if (r < CI_PS) { r -= CI_PD; kb = r / 32; nb = r % 32; src = S.wpd + (size_t)l * 256 * D; dst = (bf16*)(dB + W_PD); K = 256; sc0 = 32 * nb; }
    else if (r < CI_OUT) { r -= CI_PS; kb = r / 32; nb = r % 32; src = S.wps + (size_t)l * 256 * D; dst = (bf16*)(dB + W_PS); K = 256; sc0 = 32 * nb; }
    else { r -= CI_OUT; kb = r / 32; nb = r % 32; src = S.wout + (size_t)l * D * D; dst = (bf16*)(dB + W_OUT); sc0 = 32 * nb; }
    const int c4 = lane & 7, kr = lane >> 3, k0 = 64 * kb;
    ConvItem I; I.wp = src + (size_t)(k0 + kr) * ldw + sc0 + 4 * c4; I.gp = gain ? gain + k0 + kr : nullptr; I.dp = dst + (size_t)(32 * nb) * K + k0; I.ldw = ldw; I.K = K; I.rperm = rperm;
    return I;
}
__device__ __forceinline__ void conv_load(f32x4 (&v)[8], const ConvItem& I) {
#pragma unroll
    for (int i = 0; i < 8; ++i) v[i] = __builtin_nontemporal_load((const f32x4*)(I.wp + (size_t)(8 * i) * I.ldw));
}
__device__ __forceinline__ void conv_finish(f32x4 (&v)[8], const ConvItem& I, LAS float* scr, int lane) {
    const int c4 = lane & 7, kr = lane >> 3;
    if (I.gp) {
#pragma unroll
        for (int i = 0; i < 8; ++i) v[i] *= I.gp[8 * i];
    }
    int p[4];
#pragma unroll
    for (int e = 0; e < 4; ++e) { const int sc = 4 * c4 + e; p[e] = (I.rperm && sc < 16) ? (sc < 8 ? 2 * sc : 2 * (sc - 8) + 1) : sc; }
#pragma unroll
    for (int i = 0; i < 8; ++i)
#pragma unroll
        for (int e = 0; e < 4; ++e) scr[(kr + 8 * i) * 33 + p[e]] = v[i][e];
    LDS_WAIT();
    const int c = lane & 7;
#pragma unroll
    for (int jj = 0; jj < 4; ++jj) { const int n = (lane >> 3) + 8 * jj; const LAS float* s = scr + (8 * c) * 33 + n;
        u32x4 o; o.x = pk2(s[0 * 33], s[1 * 33]); o.y = pk2(s[2 * 33], s[3 * 33]); o.z = pk2(s[4 * 33], s[5 * 33]); o.w = pk2(s[6 * 33], s[7 * 33]);
        *(u32x4*)(I.dp + (size_t)n * I.K + 8 * c) = o; }
    LDS_WAIT();
}
__device__ __forceinline__ void conv_items(const ConvSrc& S, int l, int lo, int hi, unsigned char* dA, unsigned char* dB, LAS unsigned char* lds, int widx, int nw, int wave, int lane) {
    LAS float* scr = (LAS float*)(lds + wave * 8704);
    int it = lo + widx; if (it >= hi) return;
    ConvItem cur = conv_decode(S, l, __builtin_amdgcn_readfirstlane(it), dA, dB, lane); f32x4 v[8]; conv_load(v, cur);
    for (;;) {
        const int itn = it + nw; const bool more = itn < hi;
        ConvItem nxt = cur; f32x4 vn[8];
        if (more) { nxt = conv_decode(S, l, __builtin_amdgcn_readfirstlane(itn), dA, dB, lane); conv_load(vn, nxt); }
        conv_finish(v, cur, scr, lane);
        if (!more) break;
        cur = nxt; it = itn;
#pragma unroll
        for (int i = 0; i < 8; ++i) v[i] = vn[i];
    }
}
__device__ __forceinline__ void conv_phase(const float* Px, const ConvSrc& S, unsigned char* Pws, int l, LAS unsigned char* lds, int gw, int NGW, int wave, int lane) {
    unsigned char* wsw = Pws + WS_W;
    conv_items(S, l, 0, CI_END, wsw, wsw, lds, gw, NGW, wave, lane);
    if (l == 0) {
        const float* x = Px; bf16* xb = (bf16*)(Pws + WS_XB); float* ssqp = (float*)(Pws + WS_SSQ);
        for (int m = gw; m < M; m += NGW) {
            const f32x4* xr = (const f32x4*)(x + (size_t)m * D) + 2 * lane; f32x4 v[4]; float s = 0.f;
#pragma unroll
            for (int j = 0; j < 2; ++j) { v[2 * j] = __builtin_nontemporal_load(xr + 128 * j); v[2 * j + 1] = __builtin_nontemporal_load(xr + 128 * j + 1); }
#pragma unroll
            for (int j = 0; j < 4; ++j) s += (v[j][0] * v[j][0] + v[j][1] * v[j][1]) + (v[j][2] * v[j][2] + v[j][3] * v[j][3]);
            s = wave_sum(s);
            u32x4* o = (u32x4*)(xb + (size_t)m * D) + lane;
#pragma unroll
            for (int j = 0; j < 2; ++j) { u32x4 w; w.x = pk2(v[2 * j][0], v[2 * j][1]); w.y = pk2(v[2 * j][2], v[2 * j][3]); w.z = pk2(v[2 * j + 1][0], v[2 * j + 1][1]); w.w = pk2(v[2 * j + 1][2], v[2 * j + 1][3]); o[64 * j] = w; }
            if (lane < 16) ssqp[(size_t)m * 16 + lane] = (lane == 0) ? s : 0.f;
        }
        float* rope = (float*)(Pws + WS_ROPE);
        for (int idx = gw * 64 + lane; idx < SEQ * 8; idx += NGW * 64) {
            const int t = idx >> 3, i = idx & 7;
            const float invf = (i == 0) ? 1.0f : (i == 1) ? 0.1939227432012558f : (i == 2) ? 0.03760603070259094f : (i == 3) ? 0.007292664609849453f : (i == 4) ? 0.0014142135623842478f
                             : (i == 5) ? 0.00027424818836152554f : (i == 6) ? 5.3182957344688475e-05f : 1.0313385246263351e-05f;
            const float angf = (float)t * invf; const double a = (double)angf;
            const double kq = __builtin_rint(a * 0.63661977236758134308);
            double rr = __builtin_fma(-kq, 1.57079632679489655800, a); rr = __builtin_fma(-kq, 6.12323399573676603587e-17, rr);
            const int qd = ((int)kq) & 3; const float rf = (float)rr, r2 = rf * rf;
            const float sn = rf + rf * r2 * (-1.0f / 6 + r2 * (1.0f / 120 + r2 * (-1.0f / 5040 + r2 * (1.0f / 362880))));
            const float cn = 1.0f + r2 * (-0.5f + r2 * (1.0f / 24 + r2 * (-1.0f / 720 + r2 * (1.0f / 40320 + r2 * (-1.0f / 3628800)))));
            const float c = (qd == 0) ? cn : (qd == 1) ? -sn : (qd == 2) ? -cn : sn;
            const float s = (qd == 0) ? sn : (qd == 1) ? cn : (qd == 2) ? -sn : -cn;
            rope[2 * idx] = c; rope[2 * idx + 1] = s;
        }
    }
}

__device__ __forceinline__ int crow(int r, int hi) { return (r & 3) + 8 * (r >> 2) + 4 * hi; }
struct F2 { float a, b; };
__device__ __forceinline__ F2 pair32(float v) { const auto rr = __builtin_amdgcn_permlane32_swap(__float_as_uint(v), __float_as_uint(v), false, false); return F2{__uint_as_float(rr[0]), __uint_as_float(rr[1])}; }
__device__ __forceinline__ void ld_frag4(bf16x8 (&f)[4], const bf16* ubase, unsigned rowstride, int lane) {
    const unsigned off = (unsigned)(lane & 31) * rowstride + (unsigned)(lane >> 5) * 8u;
#pragma unroll
    for (int d0 = 0; d0 < 4; ++d0) f[d0] = *(const bf16x8*)(ubase + (off + d0 * 16));
}
__device__ __forceinline__ void ld_frag4_nt(bf16x8 (&f)[4], const bf16* ubase, unsigned rowstride, int lane) {
    const unsigned off = (unsigned)(lane & 31) * rowstride + (unsigned)(lane >> 5) * 8u;
#pragma unroll
    for (int d0 = 0; d0 < 4; ++d0) f[d0] = __builtin_nontemporal_load((const bf16x8*)(ubase + (off + d0 * 16)));
}
__device__ __forceinline__ f32x16 qk_tile(const bf16x8 (&kf)[4], const bf16x8 (&qf)[4]) {
    f32x16 s = {};
#pragma unroll
    for (int d0 = 0; d0 < 4; ++d0) s = __builtin_amdgcn_mfma_f32_32x32x16_bf16(kf[d0], qf[d0], s, 0, 0, 0);
    return s;
}
__device__ __forceinline__ void v_load(u32x4 (&vr)[4], const bf16* ubase, unsigned rowstride, int lane) {
#pragma unroll
    for (int i = 0; i < 4; ++i) { const unsigned c = lane + 64 * i; vr[i] = *(const u32x4*)(ubase + ((c >> 3) * rowstride + (c & 7) * 8u)); }
}
__device__ __forceinline__ void v_stage(LAS unsigned char* vb, const u32x4 (&vr)[4], int lane) {
#pragma unroll
    for (int i = 0; i < 4; ++i) { const int c = lane + 64 * i, key = c >> 3, ch = c & 7; *(LAS u32x4*)(vb + key * 128 + ((ch * 16) ^ (((key >> 1) & 1) << 6))) = vr[i]; }
}
__device__ __forceinline__ void pv_tile(f32x16 (&o)[2], LAS unsigned char* vb, const f32x16& p, int lane) {
    const int hi = lane >> 5, g1 = (lane >> 4) & 1, q4 = (lane & 15) >> 2, pp = lane & 3;
    bf16x8 pf[2];
#pragma unroll
    for (int s = 0; s < 2; ++s) { u32x4 w; w.x = pk2(p[8 * s + 0], p[8 * s + 1]); w.y = pk2(p[8 * s + 2], p[8 * s + 3]); w.z = pk2(p[8 * s + 4], p[8 * s + 5]); w.w = pk2(p[8 * s + 6], p[8 * s + 7]);
        pf[s] = __builtin_bit_cast(bf16x8, w); }
    const int swz = ((q4 >> 1) & 1) << 6;
#pragma unroll
    for (int dblk = 0; dblk < 2; ++dblk)
#pragma unroll
        for (int s = 0; s < 2; ++s) {
            const int colb = (dblk * 64 + g1 * 32 + pp * 8) ^ swz;
            const int row0 = 16 * s + 4 * hi + q4;
            const s16x4 t0 = __builtin_bit_cast(s16x4, __builtin_amdgcn_ds_read_tr16_b64_v4i16((LAS s16x4*)(vb + row0 * 128 + colb)));
            const s16x4 t1 = __builtin_bit_cast(s16x4, __builtin_amdgcn_ds_read_tr16_b64_v4i16((LAS s16x4*)(vb + (row0 + 8) * 128 + colb)));
            const bf16x8 a = (bf16x8){t0[0], t0[1], t0[2], t0[3], t1[0], t1[1], t1[2], t1[3]};
            o[dblk] = __builtin_amdgcn_mfma_f32_32x32x16_bf16(a, pf[s], o[dblk], 0, 0, 0);
        }
}
__device__ __forceinline__ void store_ot(bf16* rowp, const f32x16 (&o)[2], float sc, int hi) {
#pragma unroll
    for (int dblk = 0; dblk < 2; ++dblk)
#pragma unroll
        for (int p = 0; p < 2; ++p) {
            const unsigned x0 = pk2(o[dblk][8 * p] * sc, o[dblk][8 * p + 1] * sc), x1 = pk2(o[dblk][8 * p + 2] * sc, o[dblk][8 * p + 3] * sc);
            const unsigned y0 = pk2(o[dblk][8 * p + 4] * sc, o[dblk][8 * p + 5] * sc), y1 = pk2(o[dblk][8 * p + 6] * sc, o[dblk][8 * p + 7] * sc);
            const auto s0 = __builtin_amdgcn_permlane32_swap(x0, y0, false, false), s1 = __builtin_amdgcn_permlane32_swap(x1, y1, false, false);
            u32x4 w; w.x = s0[0]; w.y = s1[0]; w.z = s0[1]; w.w = s1[1];
            *(u32x4*)(rowp + dblk * 32 + 16 * p + 8 * hi) = w; }
}
struct DilGeo { size_t rowb, kstride; int h12, dil, r, i0; };
__device__ __forceinline__ DilGeo dil_geo(int item) {
    DilGeo g; const int b = item / 1536, rem = item % 1536, ch = rem & 127; g.h12 = rem >> 7;
    const int gg = g.h12 >> 2, ncl = 7 - 2 * gg; g.dil = 1 << (2 * gg); g.r = ch >> ncl; g.i0 = 32 * (ch & ((1 << ncl) - 1));
    g.rowb = (size_t)b * SEQ; g.kstride = (size_t)g.dil * 64; return g;
}
__device__ __forceinline__ void dil_load_qk(const bf16* QKV, const DilGeo& g, bf16x8 (&qf)[4], bf16x8 (&kf)[5][4], int lane) {
    const int q = lane & 31, hi = lane >> 5;
    ld_frag4_nt(qf, QKV + ((size_t)g.h12 * M + g.rowb + (size_t)g.i0 * g.dil + g.r) * 64, (unsigned)g.kstride, lane);
#pragma unroll
    for (int kt = 0; kt < 5; ++kt) { const int ib = g.i0 - 128 + 32 * kt, ibc = ib < 0 ? 0 : ib; ld_frag4(kf[kt], QKV + ((size_t)(12 + g.h12) * M + g.rowb + (size_t)ibc * g.dil + g.r) * 64, (unsigned)g.kstride, lane); }
}
__device__ __forceinline__ void dil_vload(const bf16* QKV, const DilGeo& g, u32x4 (&vr)[4], int kt, int lane) {
    const int ib = g.i0 - 128 + 32 * kt, ibc = ib < 0 ? 0 : ib;
    v_load(vr, QKV + ((size_t)(24 + g.h12) * M + g.rowb + g.r) * 64 + (size_t)ibc * g.kstride, (unsigned)g.kstride, lane);
}
__device__ __forceinline__ void pv_tile_p(f32x16 (&o)[2], LAS unsigned char* vb, const bf16x8 (&pf)[2], int lane) {
    const int hi = lane >> 5, g1 = (lane >> 4) & 1, q4 = (lane & 15) >> 2, pp = lane & 3;
    const int swz = ((q4 >> 1) & 1) << 6;
#pragma unroll
    for (int dblk = 0; dblk < 2; ++dblk)
#pragma unroll
        for (int s = 0; s < 2; ++s) {
            const int colb = (dblk * 64 + g1 * 32 + pp * 8) ^ swz;
            const int row0 = 16 * s + 4 * hi + q4;
            const s16x4 t0 = __builtin_bit_cast(s16x4, __builtin_amdgcn_ds_read_tr16_b64_v4i16((LAS s16x4*)(vb + row0 * 128 + colb)));
            const s16x4 t1 = __builtin_bit_cast(s16x4, __builtin_amdgcn_ds_read_tr16_b64_v4i16((LAS s16x4*)(vb + (row0 + 8) * 128 + colb)));
            const bf16x8 a = (bf16x8){t0[0], t0[1], t0[2], t0[3], t1[0], t1[1], t1[2], t1[3]};
            o[dblk] = __builtin_amdgcn_mfma_f32_32x32x16_bf16(a, pf[s], o[dblk], 0, 0, 0);
        }
}
__device__ __forceinline__ void dil_items(const bf16* QKV, bf16* OD3, float* LSE, LAS unsigned char* vb, int first, int stride, int lane) {
    int it = first; if (it >= 6144) return;
    const int q = lane & 31, hi = lane >> 5;
    DilGeo g = dil_geo(__builtin_amdgcn_readfirstlane(it));
    for (;;) {
        bf16x8 qf[4], kf[5][4];
        dil_load_qk(QKV, g, qf, kf, lane);
        u32x4 vr[5][4];
#pragma unroll
        for (int kt = 0; kt < 5; ++kt) dil_vload(QKV, g, vr[kt], kt, lane);
        bf16x8 pf[5][2]; float mx = -INFINITY, l = 0.f;
        {
            f32x16 s[5];
#pragma unroll
            for (int kt = 0; kt < 5; ++kt) {
                s[kt] = qk_tile(kf[kt], qf);
                if (g.i0 - 128 + 32 * kt < 0) {
#pragma unroll
                    for (int rr = 0; rr < 16; ++rr) s[kt][rr] = -INFINITY;
                }
            }
#pragma unroll
            for (int rr = 0; rr < 16; ++rr) { const int kk = crow(rr, hi); if (kk < q) s[0][rr] = -INFINITY; if (kk > q) s[4][rr] = -INFINITY; }
#pragma unroll
            for (int kt = 0; kt < 5; ++kt)
#pragma unroll
                for (int rr = 0; rr < 16; ++rr) mx = fmaxf(mx, s[kt][rr]);
            { const F2 t = pair32(mx); mx = fmaxf(t.a, t.b); }
            const float mb = mx * LOG2E;
#pragma unroll
            for (int kt = 0; kt < 5; ++kt) {
#pragma unroll
                for (int rr = 0; rr < 16; ++rr) { const float p = __builtin_amdgcn_exp2f(__builtin_fmaf(s[kt][rr], LOG2E, -mb)); s[kt][rr] = p; l += p; }
#pragma unroll
                for (int h2 = 0; h2 < 2; ++h2) { u32x4 w; w.x = pk2(s[kt][8 * h2 + 0], s[kt][8 * h2 + 1]); w.y = pk2(s[kt][8 * h2 + 2], s[kt][8 * h2 + 3]); w.z = pk2(s[kt][8 * h2 + 4], s[kt][8 * h2 + 5]); w.w = pk2(s[kt][8 * h2 + 6], s[kt][8 * h2 + 7]);
                    pf[kt][h2] = __builtin_bit_cast(bf16x8, w); }
            }
            { const F2 t = pair32(l); l = t.a + t.b; }
        }
        const int itn = it + stride; const bool more = itn < 6144;
        const DilGeo gn = dil_geo(__builtin_amdgcn_readfirstlane(more ? itn : it));
        f32x16 o[2]; o[0] = f32x16{}; o[1] = f32x16{};
#pragma unroll
        for (int kt = 0; kt < 5; ++kt) {
            LDS_WAIT();
            v_stage(vb, vr[kt], lane);
            LDS_WAIT();
            pv_tile_p(o, vb, pf[kt], lane);
        }
        const float inv = 1.0f / l;
        const size_t tok = g.rowb + (size_t)(g.i0 + q) * g.dil + g.r;
        store_ot(OD3 + (g.rowb + (size_t)g.i0 * g.dil + g.r) * 768 + g.h12 * 64 + (unsigned)q * (unsigned)(g.dil * 768), o, inv, hi);
        if (hi == 0) LSE[tok * 12 + g.h12] = mx + __logf(l);
        if (!more) break;
        it = itn; g = gn;
    }
}
__device__ __forceinline__ void sb_step(f32x16 (&o)[2], float& R, const bf16x8 (&kf)[4], const bf16x8 (&qf)[4], const u32x4 (&vr)[4], LAS unsigned char* vb, int dq, int lane) {
    const int hi = lane >> 5;
    f32x16 z = qk_tile(kf, qf);
    float gp[4];
#pragma unroll
    for (int c4 = 0; c4 < 4; ++c4) {
        float be[4], ke[4];
#pragma unroll
        for (int i = 0; i < 4; ++i) { const float zz = z[4 * c4 + i]; const float e = __builtin_amdgcn_exp2f(-fabsf(zz) * LOG2E); const float rr = __builtin_amdgcn_rcpf(1.0f + e), sm = e * rr;
            const bool pos = zz >= 0.f; const bool past = (8 * c4 + 4 * hi + i) < dq;
            be[i] = past ? (pos ? rr : sm) : 0.f; ke[i] = past ? (pos ? sm : rr) : 1.f; }
        const float e2 = ke[3], e1 = e2 * ke[2], e0 = e1 * ke[1];
        gp[c4] = e0 * ke[0];
        z[4 * c4 + 3] = be[3]; z[4 * c4 + 2] = be[2] * e2; z[4 * c4 + 1] = be[1] * e1; z[4 * c4 + 0] = be[0] * e0;
    }
    float U = R;
#pragma unroll
    for (int c4 = 3; c4 >= 0; --c4) {
        const F2 t = pair32(gp[c4]);
        const float T = (hi == 0) ? U * t.b : U;
#pragma unroll
        for (int i = 0; i < 4; ++i) z[4 * c4 + i] *= T;
        U *= t.a * t.b;
    }
    R = U;
    LDS_WAIT();
    v_stage(vb, vr, lane);
    LDS_WAIT();
    pv_tile(o, vb, z, lane);
}
__device__ __forceinline__ void sb_item(const bf16* QKV, bf16* OS, LAS unsigned char* vb, int bh, int c, int lane) {
    const int b = bh >> 2, h = bh & 3, q = lane & 31, hi = lane >> 5;
    const size_t rowb = (size_t)b * SEQ;
    const bf16* Qp = QKV + ((size_t)(36 + h) * M + rowb + 32 * c) * 64;
    const bf16* Kb = QKV + ((size_t)(40 + h) * M + rowb) * 64;
    const bf16* Vb = QKV + ((size_t)(44 + h) * M + rowb) * 64;
    bf16x8 qf[4]; ld_frag4_nt(qf, Qp, 64, lane);
    f32x16 o[2]; o[0] = f32x16{}; o[1] = f32x16{};
    float R = 1.0f;
    bf16x8 kf[3][4]; u32x4 vr[3][4];
#pragma unroll
    for (int j = 0; j < 3; ++j) { const int t = (c - j) < 0 ? 0 : (c - j); ld_frag4(kf[j], Kb + (size_t)(32 * t) * 64, 64, lane); v_load(vr[j], Vb + (size_t)(32 * t) * 64, 64, lane); }
#if SB_EARLY_EXIT
#define SB_DONE() (__all(R < 1e-20f))
#else
#define SB_DONE() (false)
#endif
#define SB_STEP(j, kt_) do { sb_step(o, R, kf[j], qf, vr[j], vb, 32 * (c - (kt_)) + q, lane); \
        { const int t = (kt_) - 3 < 0 ? 0 : (kt_) - 3; ld_frag4(kf[j], Kb + (size_t)(32 * t) * 64, 64, lane); v_load(vr[j], Vb + (size_t)(32 * t) * 64, 64, lane); } } while (0)
    for (int kt = c; kt >= 0; kt -= 3) {
        SB_STEP(0, kt); if (kt - 1 < 0 || SB_DONE()) break;
        SB_STEP(1, kt - 1); if (kt - 2 < 0 || SB_DONE()) break;
        SB_STEP(2, kt - 2); if (SB_DONE()) break;
    }
#undef SB_STEP
#undef SB_DONE
    store_ot(OS + (rowb + 32 * c) * 256 + h * 64 + (unsigned)q * 256u, o, 1.0f, hi);
}
__device__ __forceinline__ void attn_phase(unsigned char* Pws, unsigned char* Pscr, LAS unsigned char* lds, int G, int wg, int NGW, int wave, int lane) {
    LAS unsigned char* vb = lds + wave * 4096;
    const bf16* QKV = (const bf16*)(Pws + WS_R);
    const int v = (G % 8 == 0) ? (wg % 8) * (G / 8) + wg / 8 : wg;
    const int base = v * NWAVES + wave;
    for (int it = base; it < 2048; it += NGW) { const int itu = __builtin_amdgcn_readfirstlane(it);
#if SB_EARLY_EXIT
        sb_item(QKV, (bf16*)(Pws + WS_OS), vb, itu >> 7, itu & 127, lane);
#else
        sb_item(QKV, (bf16*)(Pws + WS_OS), vb, itu >> 7, ((itu & 127) + 16 * (itu >> 8)) & 127, lane);
#endif
    }
    dil_items(QKV, (bf16*)(Pscr + OUT_OD3), (float*)(Pws + WS_LSE), vb, base, NGW, lane);
}
__device__ __forceinline__ void merge_phase(unsigned char* Pws, unsigned char* Pscr, int idx_lo, int idx_hi, int first, int stride) {
    const bf16* OD3 = (const bf16*)(Pscr + OUT_OD3); bf16* OD = (bf16*)(Pscr + OUT_OD); const float* LSE = (const float*)(Pws + WS_LSE);
    const __amdgpu_buffer_rsrc_t odr = __builtin_amdgcn_make_buffer_rsrc(OD, 0, M * 256 * 2, 0x00020000);
    for (int idx = idx_lo + first; idx < idx_hi; idx += stride) {
        const int t = idx >> 5, hh = (idx >> 3) & 3, ch = idx & 7;
        const float l0 = LSE[(size_t)t * 12 + hh], l1 = LSE[(size_t)t * 12 + 4 + hh], l2 = LSE[(size_t)t * 12 + 8 + hh];
        const float mx = fmaxf(l0, fmaxf(l1, l2)); float e0 = __expf(l0 - mx), e1 = __expf(l1 - mx), e2 = __expf(l2 - mx); const float inv = 1.0f / (e0 + e1 + e2);
        e0 *= inv; e1 *= inv; e2 *= inv;
        const u32x4 a = *(const u32x4*)(OD3 + (size_t)t * 768 + hh * 64 + ch * 8), bq = *(const u32x4*)(OD3 + (size_t)t * 768 + (4 + hh) * 64 + ch * 8), cq = *(const u32x4*)(OD3 + (size_t)t * 768 + (8 + hh) * 64 + ch * 8);
        u32x4 o;
#pragma unroll
        for (int k = 0; k < 4; ++k) {
            const float lo = e0 * __uint_as_float(a[k] << 16) + e1 * __uint_as_float(bq[k] << 16) + e2 * __uint_as_float(cq[k] << 16);
            const float hi = e0 * __uint_as_float(a[k] & 0xffff0000u) + e1 * __uint_as_float(bq[k] & 0xffff0000u) + e2 * __uint_as_float(cq[k] & 0xffff0000u);
            o[k] = pk2(lo, hi);
        }
        __builtin_amdgcn_raw_buffer_store_b128(o, odr, (unsigned)(t * 256 + hh * 64 + ch * 8) * 2u, 0,   16);
    }
}
__device__ __forceinline__ void merge_quarter(unsigned char* Pws, unsigned char* Pscr, int idx_lo, int tid) {
    const bf16* OD3 = (const bf16*)(Pscr + OUT_OD3); bf16* OD = (bf16*)(Pscr + OUT_OD); const float* LSE = (const float*)(Pws + WS_LSE);
    const __amdgpu_buffer_rsrc_t odr = __builtin_amdgcn_make_buffer_rsrc(OD, 0, M * 256 * 2, 0x00020000);
    float ls[4][3]; u32x4 v[4][3];
#pragma unroll
    for (int j = 0; j < 4; ++j) { const unsigned idx = (unsigned)(idx_lo + tid + 512 * j), t = idx >> 5, hh = (idx >> 3) & 3, ch = idx & 7;
#pragma unroll
        for (int g = 0; g < 3; ++g) { ls[j][g] = __builtin_nontemporal_load(LSE + (t * 12u + 4u * g + hh)); v[j][g] = __builtin_nontemporal_load((const u32x4*)(OD3 + (t * 768u + (4u * g + hh) * 64u + ch * 8u))); } }
#pragma unroll
    for (int j = 0; j < 4; ++j) { const unsigned idx = (unsigned)(idx_lo + tid + 512 * j), t = idx >> 5, hh = (idx >> 3) & 3, ch = idx & 7;
        const float mx = fmaxf(ls[j][0], fmaxf(ls[j][1], ls[j][2])); float e0 = __expf(ls[j][0] - mx), e1 = __expf(ls[j][1] - mx), e2 = __expf(ls[j][2] - mx); const float inv = 1.0f / (e0 + e1 + e2);
        e0 *= inv; e1 *= inv; e2 *= inv;
        u32x4 o;
#pragma unroll
        for (int k = 0; k < 4; ++k) {
            const float lo = e0 * __uint_as_float(v[j][0][k] << 16) + e1 * __uint_as_float(v[j][1][k] << 16) + e2 * __uint_as_float(v[j][2][k] << 16);
            const float hi = e0 * __uint_as_float(v[j][0][k] & 0xffff0000u) + e1 * __uint_as_float(v[j][1][k] & 0xffff0000u) + e2 * __uint_as_float(v[j][2][k] & 0xffff0000u);
            o[k] = pk2(lo, hi);
        }
        __builtin_amdgcn_raw_buffer_store_b128(o, odr, (t * 256u + hh * 64u + ch * 8u) * 2u, 0,   16); }
}
__device__ __forceinline__ void panel_arrive(unsigned* cnt, int pm, int wave, int lane) {
    asm volatile("s_waitcnt vmcnt(0)" ::: "memory");
    __syncthreads();
    if (wave == 0 && lane == 0) __hip_atomic_fetch_add(cnt + 64 * pm, 1u, __ATOMIC_RELAXED, __HIP_MEMORY_SCOPE_AGENT);
}
__device__ __forceinline__ void panel_sync(unsigned* cnt, int pm, int wave, int lane) {
    asm volatile("s_waitcnt vmcnt(0)" ::: "memory");
    __syncthreads();
    if (wave == 0) {
        if (lane == 0) __hip_atomic_fetch_add(cnt + 64 * pm, 1u, __ATOMIC_RELAXED, __HIP_MEMORY_SCOPE_AGENT);
        unsigned spins = 0;
        while ((unsigned)__builtin_amdgcn_readfirstlane(__hip_atomic_load(cnt + 64 * pm, __ATOMIC_RELAXED, __HIP_MEMORY_SCOPE_AGENT)) < 4u) { __builtin_amdgcn_s_sleep(1); if (++spins > (1u << 20)) break; }
        __builtin_amdgcn_fence(__ATOMIC_ACQUIRE, "agent"); }
    asm volatile("s_waitcnt vmcnt(0) lgkmcnt(0)" ::: "memory"); __syncthreads();
}
__device__ __forceinline__ void final_phase(unsigned char* Pws, float* Pout, const float* Pnf, int gw, int NGW, int lane) {
    const float* ssqp = (const float*)(Pws + WS_SSQ); const f32x4* gf = (const f32x4*)Pnf + 2 * lane; const bf16* xb = (const bf16*)(Pws + WS_XB);
    for (int m = gw; m < M; m += NGW) {
        const float rs = pg8::row_rstd(ssqp, m);
        const u32x4* xr = (const u32x4*)(xb + (size_t)m * D) + lane; f32x4* orow = (f32x4*)(Pout + (size_t)m * D) + 2 * lane;
#pragma unroll
        for (int j = 0; j < 2; ++j) { const u32x4 w = xr[64 * j];
            const f32x4 v0 = {__uint_as_float(w.x << 16), __uint_as_float(w.x & 0xffff0000u), __uint_as_float(w.y << 16), __uint_as_float(w.y & 0xffff0000u)};
            const f32x4 v1 = {__uint_as_float(w.z << 16), __uint_as_float(w.z & 0xffff0000u), __uint_as_float(w.w << 16), __uint_as_float(w.w & 0xffff0000u)};
            orow[128 * j] = v0 * rs * gf[128 * j]; orow[128 * j + 1] = v1 * rs * gf[128 * j + 1]; }
    }
}

struct Args { const float* in[15]; float* out; unsigned char* ws; int ph_lo, ph_hi; };
constexpr int N_PHASES = 10 * DEPTH + 1;
__global__ void __launch_bounds__(NWAVES * 64, 2) fwd_megakernel(Args args) {
    extern __shared__ __attribute__((aligned(16))) unsigned char lds_raw[];
    LAS unsigned char* lds = (LAS unsigned char*)lds_raw;
    cg::grid_group grid = cg::this_grid();
    volatile LAS unsigned* bst = (volatile LAS unsigned*)(lds + 131072);
    if (threadIdx.x < 2) bst[threadIdx.x] = 0u;
    __syncthreads();
    (void)xcd_barrier_post((unsigned*)(args.ws + WS_BAR), bst);
    for (int ph = args.ph_lo; ph < args.ph_hi; ++ph) {
        const __attribute__((address_space(4))) unsigned char* ka = (const __attribute__((address_space(4))) unsigned char*)__builtin_amdgcn_kernarg_segment_ptr();
        asm volatile("" : "+s"(ka));
#define KARG(i) (*(const float* const __attribute__((address_space(4)))*)(ka + 8 * (i)))
        const float* Px = KARG(0); float* Pout = (float*)KARG(15); unsigned char* ws = (unsigned char*)KARG(16);
        int tid = threadIdx.x, G = gridDim.x, wg = blockIdx.x; asm volatile("" : "+v"(tid), "+s"(G), "+s"(wg));
        const int lane = tid & 63, wave = __builtin_amdgcn_readfirstlane(tid >> 6);
        const int gw = wave * G + wg, NGW = G * NWAVES;
        const int gtid = wg * (NWAVES * 64) + tid, NT = G * NWAVES * 64;
        unsigned char* wsw = ws + WS_W;
        float* ssqp = (float*)(ws + WS_SSQ);
        bf16* XB = (bf16*)(ws + WS_XB); bf16* H = (bf16*)(ws + WS_R); bf16* QKV = (bf16*)(ws + WS_R); bf16* GATE = (bf16*)(ws + WS_GATE);
        const int l = ph / 10, k = (ph == N_PHASES - 1) ? 10 : ph % 10;
        const bool fuse_final = (G == 256);
        if (k == 10 && fuse_final) continue;
        const bool chain = (G == 256);
        if ((k == 6 || k == 7) && chain) continue;
        if (k == 0 && l > 0) continue;
        unsigned char* dA1 = (unsigned char*)Pout + 32 * MiB;
        unsigned char* wA = (l == 0) ? wsw : dA1;
        if (k == 0) {
            { const ConvSrc CS{KARG(1), KARG(2), KARG(3), KARG(4), KARG(5), KARG(6), KARG(7), KARG(8), KARG(9), KARG(10), KARG(11), KARG(12), KARG(13)}; conv_phase(Px, CS, ws, l, lds, gw, NGW, wave, lane); }
        }
        else if (k == 1 || k == 8) {
            pg8::Gemm g{XB, (const bf16*)(k == 1 ? wA + W_1CAT : wsw + W_2CAT), M, 2 * FF, D}; pg8::StaticOrder S; S.init(M, 2 * FF, G, wg);
            { const LAS float* rsl_c = (const LAS float*)(lds + RSL_OFF); LAS float* rsl_w = (LAS float*)(lds + RSL_OFF); pg8::Unit uu;
#pragma unroll 1
              for (int i = 0; i < pg8::RSL_UNITS; ++i) if (S.next(i, uu) && tid < 256) rsl_w[i * 256 + tid] = pg8::row_rstd(ssqp, uu.pm * 256 + tid);
              __syncthreads(); (void)rsl_c; }
            pg8::EpiSwiglu E{H, ssqp, (const LAS float*)(lds + RSL_OFF)};
            pg8::gemm_phase<pg8::EpiSwiglu, pg8::StaticOrder, true, true>(lds, g, S, E);
            if ((l == 0) || (k == 1)) {
                const int rem = ((M / 256) * (2 * FF / 256)) % G; const bool idle = (rem == 0) || (wg >= rem);
                if (idle) {
                    const int nidle = (rem == 0) ? G : G - rem, iw = (rem == 0) ? wg : wg - rem;
                    const ConvSrc CS{KARG(1), KARG(2), KARG(3), KARG(4), KARG(5), KARG(6), KARG(7), KARG(8), KARG(9), KARG(10), KARG(11), KARG(12), KARG(13)};
                    const int lo = (l == 0) ? (k == 1 ? 0 : CI_IN) : CI_B, hi = (l == 0) ? (k == 1 ? CI_IN : CI_B) : CI_END;
                    conv_items(CS, 1, lo, hi, dA1, wsw, lds, wave * nidle + iw, nidle * NWAVES, wave, lane);
                }
            }
        } else if (k == 2 || k == 9) {
            pg8::Gemm g{H, (const bf16*)(k == 2 ? wA + W_D1 : wsw + W_D2), M, D, FF}; pg8::StaticOrder S; S.init(M, D, G, wg);
            if (ph == 2) { pg8::EpiResid<true> E{Px, XB, ssqp, 0.5f}; pg8::gemm_phase<pg8::EpiResid<true>, pg8::StaticOrder, true, true>(lds, g, S, E); }
            else if (ph == N_PHASES - 2 && fuse_final) { pg8::EpiResidFinal E{XB, Pout, KARG(14), (unsigned*)(ws + WS_XSLOT), (unsigned*)(ws + WS_CNT), 0.5f};
                pg8::gemm_phase<pg8::EpiResidFinal, pg8::StaticOrder, true, true>(lds, g, S, E); }
            else { pg8::EpiResid<false> E{nullptr, XB, ssqp, 0.5f}; pg8::gemm_phase<pg8::EpiResid<false>, pg8::StaticOrder, true, true>(lds, g, S, E); }
        } else if (k == 3) {
            pg8::Gemm g{XB, (const bf16*)(wA + W_IN), M, NIN, D}; pg8::StaticOrder S; S.init(M, NIN, G, wg);
            { const LAS float* rsl_c = (const LAS float*)(lds + RSL_OFF); LAS float* rsl_w = (LAS float*)(lds + RSL_OFF); pg8::Unit uu;
#pragma unroll 1
              for (int i = 0; i < pg8::RSL_UNITS; ++i) if (S.next(i, uu) && tid < 256) rsl_w[i * 256 + tid] = pg8::row_rstd(ssqp, uu.pm * 256 + tid);
              __syncthreads(); (void)rsl_c; }
            pg8::EpiWin E{QKV, GATE, ssqp, (const float*)(ws + WS_ROPE), (const LAS float*)(lds + RSL_OFF)};
            pg8::gemm_phase<pg8::EpiWin, pg8::StaticOrder, true, true>(lds, g, S, E);
        } else if (k == 4) {
            attn_phase(ws, (unsigned char*)Pout, lds, G, wg, NGW, wave, lane);
        }
        else if (k == 5) {
            pg8::Unit pu; { pg8::StaticOrder S; S.init(M, D, G, wg); S.next(0, pu); }
            unsigned* pcnt = (unsigned*)(ws + WS_PCNT) + (size_t)l * 2 * 4096;
            if (chain) { const int r0 = pu.pm * 256 + pu.pn * 64; merge_quarter(ws, (unsigned char*)Pout, r0 * 32, tid); panel_arrive(pcnt, pu.pm, wave, lane); }
            else merge_phase(ws, (unsigned char*)Pout, 0, M * 32, gtid, NT);
            if (chain) {
                int K256 = 256; asm volatile("" : "+s"(K256));
                { pg8::Gemm g{(const bf16*)(ws + WS_OS), (const bf16*)(wsw + W_PS), M, D, K256, (const bf16*)((unsigned char*)Pout + OUT_OD), (const bf16*)(wsw + W_PD)}; pg8::PairOrder S; S.init(M, D, G, wg); S.cnt = pcnt;
                  pg8::EpiGate2 E{GATE, (bf16*)(ws + WS_Y1), (bf16*)(ws + WS_Y)};
                  pg8::gemm_phase<pg8::EpiGate2, pg8::PairOrder, true, true>(lds, g, S, E); }
                panel_sync(pcnt + 4096, pu.pm, wave, lane);
                { pg8::Gemm g{(const bf16*)(ws + WS_Y), (const bf16*)(wsw + W_OUT), M, D, D}; pg8::StaticOrder S; S.init(M, D, G, wg);
                  pg8::EpiResid<false> E{nullptr, XB, ssqp, 1.0f};
                  pg8::gemm_phase<pg8::EpiResid<false>, pg8::StaticOrder, true, true>(lds, g, S, E); }
            }
        }
        else if (k == 6) {
            int K256 = 256; asm volatile("" : "+s"(K256));
            { pg8::Gemm g{(const bf16*)((unsigned char*)Pout + OUT_OD), (const bf16*)(wsw + W_PD), M, D, K256}; pg8::StaticOrder S; S.init(M, D, G, wg);
              pg8::EpiGate<false> E{GATE, (bf16*)(ws + WS_Y1), (bf16*)(ws + WS_Y)};
              pg8::gemm_phase<pg8::EpiGate<false>, pg8::StaticOrder, true, true>(lds, g, S, E); }
            { pg8::Gemm g{(const bf16*)(ws + WS_OS), (const bf16*)(wsw + W_PS), M, D, K256}; pg8::StaticOrder S; S.init(M, D, G, wg);
              pg8::EpiGate<true> E{GATE + 1024, (bf16*)(ws + WS_Y1), (bf16*)(ws + WS_Y)};
              pg8::gemm_phase<pg8::EpiGate<true>, pg8::StaticOrder, true, true>(lds, g, S, E); }
        } else if (k == 7) {
            pg8::Gemm g{(const bf16*)(ws + WS_Y), (const bf16*)(wsw + W_OUT), M, D, D}; pg8::StaticOrder S; S.init(M, D, G, wg);
            pg8::EpiResid<false> E{nullptr, XB, ssqp, 1.0f};
            pg8::gemm_phase<pg8::EpiResid<false>, pg8::StaticOrder, true, true>(lds, g, S, E);
        } else final_phase(ws, Pout, KARG(14), gw, NGW, lane);
        if (ph + 1 < args.ph_hi && !(fuse_final && ph == N_PHASES - 2)) {
            unsigned* barw = (unsigned*)(ws + WS_BAR);
            if (args.ph_hi > 1000) grid.sync();
            { XcdBarrier bar; bar.bar = barw; bar.x = xb_xcc_id(); bar.st = bst; xcd_barrier(bar);
            }
        }
    }
}

extern "C" void kernel_launch(void* const* d_in, const int* in_sizes, int n_in, void* d_out, int out_size, void* d_ws, size_t ws_size, hipStream_t stream) {
    static int grid = 0;
    if (grid == 0) {
        if (n_in != 15 || in_sizes[0] != M * D || out_size != M * D || ws_size < WS_END) { fprintf(stderr, "kernel_launch: unexpected shapes (n_in %d, in0 %d, out %d, ws %zu)\n", n_in, n_in > 0 ? in_sizes[0] : -1, out_size, ws_size); grid = -1; return; }
        int dev = 0, cus = 0, per_cu = 0;
        if (hipGetDevice(&dev) != hipSuccess || hipDeviceGetAttribute(&cus, hipDeviceAttributeMultiprocessorCount, dev) != hipSuccess) { grid = -1; return; }
        if (hipFuncSetAttribute((const void*)fwd_megakernel, hipFuncAttributeMaxDynamicSharedMemorySize, LDS_BYTES) != hipSuccess) { fprintf(stderr, "kernel_launch: hipFuncSetAttribute failed\n"); grid = -1; return; }
        if (hipOccupancyMaxActiveBlocksPerMultiprocessor(&per_cu, (const void*)fwd_megakernel, NWAVES * 64, LDS_BYTES) != hipSuccess || per_cu < 1) { fprintf(stderr, "kernel_launch: occupancy query says %d\n", per_cu); per_cu = 1; }
        (void)hipGetLastError();
        grid = cus;
        if (grid < 176) { fprintf(stderr, "kernel_launch: %d CUs: the per-workgroup rstd table holds 8 units per GEMM phase (needs >= 176 workgroups)\n", grid); grid = -1; return; }
    }
    if (grid < 0) return;
    Args a{};
    for (int i = 0; i < 15; ++i) a.in[i] = (const float*)d_in[i];
    a.out = (float*)d_out; a.ws = (unsigned char*)d_ws;
#if N_LAUNCH_MODE == 0
    a.ph_lo = 0; a.ph_hi = N_PHASES;
    if (hipMemsetAsync((char*)d_ws + WS_BAR, 0, WS_ZERO_BYTES, stream) != hipSuccess) { fprintf(stderr, "kernel_launch: memset of the barrier words failed\n"); return; }
    void* kargs[] = {&a};
    const hipError_t e = hipLaunchCooperativeKernel((const void*)fwd_megakernel, dim3(grid), dim3(NWAVES * 64), kargs, LDS_BYTES, stream);
    if (e != hipSuccess) fprintf(stderr, "kernel_launch: cooperative launch failed: %s (grid %d)\n", hipGetErrorString(e), grid);
#else
    for (int ph = 0; ph < N_PHASES; ++ph) {
        a.ph_lo = ph; a.ph_hi = ph + 1;
        hipLaunchKernelGGL(fwd_megakernel, dim3(grid), dim3(NWAVES * 64), LDS_BYTES, stream, a);
    }
#endif
}
```

```cpp
#include <hip/hip_runtime.h>
#include <hip/hip_cooperative_groups.h>
#include <cstdio>
#include <cstdint>
namespace cg = cooperative_groups;
namespace pg8 {
#define PG8_LAS __attribute__((address_space(3)))
typedef unsigned short bf16_t;
typedef short bf16x8 __attribute__((ext_vector_type(8)));
typedef float f32x4 __attribute__((ext_vector_type(4)));
typedef unsigned u32x4 __attribute__((ext_vector_type(4)));
constexpr int BM = 256, BK = 64, HALF = 128, HTB = HALF * BK * 2  , STAGE_BYTES = 8 * HTB, NXCD = 8, WGM = 8;

__host__ __device__ __forceinline__ int lds_byte(int r, int c) { const int st = (r >> 4) * 2 + (c >> 5), rr = r & 15, cc = c & 31, ob = rr * 64 + cc * 2; return st * 1024 + (ob ^ (((ob >> 9) & 1) << 5)); }
__host__ __device__ __forceinline__ void stage_rc(int b, int& R, int& C) { const int st = b / 1024, sb = b % 1024, swz = sb ^ (((sb >> 9) & 1) << 5); R = (st >> 1) * 16 + swz / 64; C = (st & 1) * 32 + (swz % 64) / 2; }
__host__ __device__ __forceinline__ int perm32(int rho) { const int n = rho >> 4, i = rho & 15; return 8 * (i >> 2) + 4 * n + (i & 3); }

struct Unit { int pm, pn, ui, sel; };
struct Gemm { const bf16_t* A; const bf16_t* Bt; int M, N, K; const bf16_t* A2 = nullptr; const bf16_t* Bt2 = nullptr; };

struct StaticOrder {
    int nM, nN, nwg, G, c;
    __host__ __device__ void init(int M, int N, int G_, int c_) { nM = M / BM; nN = N / BM; nwg = nM * nN; G = G_; c = c_; }
    __host__ __device__ bool next(int i, Unit& u) const {
        const long L = (long)i * G + c; if (L >= nwg) return false;
        int wgid = (int)L; { const int q = nwg / NXCD, r = nwg % NXCD, xcd = wgid % NXCD, off = wgid / NXCD; wgid = (xcd < r ? xcd * (q + 1) : r * (q + 1) + (xcd - r) * q) + off; }
        const int nig = WGM * nN, gid = wgid / nig, fm = gid * WGM, gsz = (nM - fm) < WGM ? (nM - fm) : WGM;
        u.pm = fm + ((wgid % nig) % gsz); u.pn = (wgid % nig) / gsz; u.ui = i; u.sel = 0; return true;
    }
    __device__ __forceinline__ void a_ready(const Unit&) const {}
    __device__ __forceinline__ void done(const Unit&) const {}
};
struct PairOrder : StaticOrder {
    unsigned* cnt;
    __host__ __device__ bool next(int i, Unit& u) const { if (i >= 2) return false; if (!StaticOrder::next(0, u)) return false; u.ui = i; u.sel = i; return true; }
    __device__ __forceinline__ void a_ready(const Unit& u) const {
        if (u.sel == 1 && cnt != nullptr) {
            if (threadIdx.x < 64) { unsigned spins = 0;
                while ((unsigned)__builtin_amdgcn_readfirstlane(__hip_atomic_load(cnt + 64 * u.pm, __ATOMIC_RELAXED, __HIP_MEMORY_SCOPE_AGENT)) < 4u) { __builtin_amdgcn_s_sleep(1); if (++spins > (1u << 20)) break; }
                __builtin_amdgcn_fence(__ATOMIC_ACQUIRE, "agent");
                asm volatile("s_waitcnt vmcnt(0)" ::: "memory"); }
            asm volatile("" ::: "memory"); __builtin_amdgcn_s_barrier(); asm volatile("" ::: "memory");
        }
    }
};

typedef float f32x2_cv __attribute__((ext_vector_type(2))); typedef __bf16 bf16x2_cv __attribute__((ext_vector_type(2)));
__device__ __forceinline__ unsigned cvt_pk_bf16(float lo, float hi) { const f32x2_cv v = {lo, hi}; const bf16x2_cv b = __builtin_convertvector(v, bf16x2_cv); return __builtin_bit_cast(unsigned, b); }
typedef unsigned u32x2 __attribute__((ext_vector_type(2)));
constexpr float LOG2E = 1.4426950408889634f;
constexpr int RSL_UNITS = 8;
__device__ __forceinline__ float row_rstd(const float* ssqp, int r) {
    const f32x4* p = (const f32x4*)(ssqp + (size_t)r * 16);
    const f32x4 a = p[0], b = p[1], c = p[2], d = p[3];
    const float s = (((a[0] + a[1]) + (a[2] + a[3])) + ((b[0] + b[1]) + (b[2] + b[3]))) + (((c[0] + c[1]) + (c[2] + c[3])) + ((d[0] + d[1]) + (d[2] + d[3])));
    return __builtin_amdgcn_rsqf(s * (1.0f / 1024.0f) + 1e-6f);
}
__device__ __forceinline__ float bf2f(unsigned short b) { return __uint_as_float(((unsigned)b) << 16); }
struct EpiSwiglu {
    static constexpr bool PERM = true, AFTER_DRAIN = false, HAS_INIT = false;
    bf16_t* H; const float* ssqp; const PG8_LAS float* rsl;
    __device__ __forceinline__ void operator()(const f32x4 (&acc)[2][2][4][2], const Unit& u, int wr, int wc, int fr, int fq) const {
        const int row0 = u.pm * BM + wr * 64 + fr, col0 = u.pn * 128 + wc * 32 + 8 * fq;
#pragma unroll
        for (int ai = 0; ai < 2; ++ai)
#pragma unroll
            for (int m = 0; m < 4; ++m) {
                const int r = row0 + ai * HALF + m * 16; const float rs = rsl[u.ui * 256 + ai * HALF + wr * 64 + m * 16 + fr];
                const float nrl = -rs * LOG2E, rs2 = rs * rs; f32x4 hq[2];
#pragma unroll
                for (int n = 0; n < 2; ++n) { const f32x4 ga = acc[ai][0][m][n], ua = acc[ai][1][m][n]; const f32x4 x = ga * nrl; f32x4 e;
                    e[0] = __builtin_amdgcn_exp2f(x[0]); e[1] = __builtin_amdgcn_exp2f(x[1]); e[2] = __builtin_amdgcn_exp2f(x[2]); e[3] = __builtin_amdgcn_exp2f(x[3]);
                    const f32x4 d = e + 1.0f; f32x4 rc; rc[0] = __builtin_amdgcn_rcpf(d[0]); rc[1] = __builtin_amdgcn_rcpf(d[1]); rc[2] = __builtin_amdgcn_rcpf(d[2]); rc[3] = __builtin_amdgcn_rcpf(d[3]);
                    hq[n] = (ga * ua) * (rc * rs2); }
                u32x4 w; w.x = cvt_pk_bf16(hq[0][0], hq[0][1]); w.y = cvt_pk_bf16(hq[0][2], hq[0][3]); w.z = cvt_pk_bf16(hq[1][0], hq[1][1]); w.w = cvt_pk_bf16(hq[1][2], hq[1][3]);
                *(u32x4*)(H + ((unsigned)r * 2816u + (unsigned)col0)) = w;
            }
    }
};
template <bool BASE32> struct EpiResid {
    static constexpr bool PERM = true, AFTER_DRAIN = false, HAS_INIT = true;
    const float* base32; bf16_t* xb; float* ssqp; float alpha;
    __device__ __forceinline__ void init(f32x4 (&acc)[2][2][4][2], const Unit& u, int wr, int wc, int fr, int fq) const {
        const unsigned row0 = u.pm * BM + wr * 64 + fr, col0 = u.pn * BM + wc * 32 + 8 * fq; const float ia = 1.0f / alpha;
#pragma unroll
        for (int ai = 0; ai < 2; ++ai)
#pragma unroll
            for (int m = 0; m < 4; ++m)
#pragma unroll
                for (int bj = 0; bj < 2; ++bj) { const unsigned off = (row0 + ai * HALF + m * 16) * 1024u + col0 + bj * HALF;
                    f32x4 b0, b1;
                    if (BASE32) { b0 = __builtin_nontemporal_load((const f32x4*)(base32 + off)); b1 = __builtin_nontemporal_load((const f32x4*)(base32 + off + 4)); }
                    else { const u32x4 bw = __builtin_nontemporal_load((const u32x4*)(xb + off));
                        b0[0] = __uint_as_float(bw.x << 16); b0[1] = __uint_as_float(bw.x & 0xffff0000u); b0[2] = __uint_as_float(bw.y << 16); b0[3] = __uint_as_float(bw.y & 0xffff0000u);
                        b1[0] = __uint_as_float(bw.z << 16); b1[1] = __uint_as_float(bw.z & 0xffff0000u); b1[2] = __uint_as_float(bw.w << 16); b1[3] = __uint_as_float(bw.w & 0xffff0000u); }
                    acc[ai][bj][m][0] = b0 * ia; acc[ai][bj][m][1] = b1 * ia; }
    }
    __device__ __forceinline__ void operator()(const f32x4 (&acc)[2][2][4][2], const Unit& u, int wr, int wc, int fr, int fq) const {
        const unsigned row0 = u.pm * BM + wr * 64 + fr, col0 = u.pn * BM + wc * 32 + 8 * fq;
#pragma unroll
        for (int ai = 0; ai < 2; ++ai)
#pragma unroll
            for (int m = 0; m < 4; ++m) {
                const unsigned r = row0 + ai * HALF + m * 16; float s = 0.f;
#pragma unroll
                for (int bj = 0; bj < 2; ++bj) { const unsigned off = r * 1024u + col0 + bj * HALF;
                    const f32x4 o0 = acc[ai][bj][m][0] * alpha, o1 = acc[ai][bj][m][1] * alpha;
                    u32x4 w; w.x = cvt_pk_bf16(o0[0], o0[1]); w.y = cvt_pk_bf16(o0[2], o0[3]); w.z = cvt_pk_bf16(o1[0], o1[1]); w.w = cvt_pk_bf16(o1[2], o1[3]);
                    *(u32x4*)(xb + off) = w;
                    f32x4 q0, q1;
                    q0[0] = __uint_as_float(w.x << 16); q0[1] = __uint_as_float(w.x & 0xffff0000u); q0[2] = __uint_as_float(w.y << 16); q0[3] = __uint_as_float(w.y & 0xffff0000u);
                    q1[0] = __uint_as_float(w.z << 16); q1[1] = __uint_as_float(w.z & 0xffff0000u); q1[2] = __uint_as_float(w.w << 16); q1[3] = __uint_as_float(w.w & 0xffff0000u);
                    const f32x4 sq = q0 * q0 + q1 * q1; s += (sq[0] + sq[1]) + (sq[2] + sq[3]); }
                { const auto t16 = __builtin_amdgcn_permlane16_swap(__float_as_uint(s), __float_as_uint(s), false, false); s = __uint_as_float(t16[0]) + __uint_as_float(t16[1]);
                  const auto t32 = __builtin_amdgcn_permlane32_swap(__float_as_uint(s), __float_as_uint(s), false, false); s = __uint_as_float(t32[0]) + __uint_as_float(t32[1]); }
                if (fq == 0) ssqp[r * 16u + u.pn * 4 + wc] = s;
            }
    }
};
struct EpiResidFinal {
    static constexpr bool PERM = true, AFTER_DRAIN = true, HAS_INIT = true;
    const bf16_t* xb; float* out; const float* gain; unsigned* xslot; unsigned* cnt; float alpha;
    __device__ __forceinline__ void init(f32x4 (&acc)[2][2][4][2], const Unit& u, int wr, int wc, int fr, int fq) const {
        const unsigned row0 = u.pm * BM + wr * 64 + fr, col0 = u.pn * BM + wc * 32 + 8 * fq; const float ia = 1.0f / alpha;
#pragma unroll
        for (int ai = 0; ai < 2; ++ai)
#pragma unroll
            for (int m = 0; m < 4; ++m)
#pragma unroll
                for (int bj = 0; bj < 2; ++bj) { const unsigned off = (row0 + ai * HALF + m * 16) * 1024u + col0 + bj * HALF; const u32x4 bw = __builtin_nontemporal_load((const u32x4*)(xb + off)); f32x4 b0, b1;
                    b0[0] = __uint_as_float(bw.x << 16); b0[1] = __uint_as_float(bw.x & 0xffff0000u); b0[2] = __uint_as_float(bw.y << 16); b0[3] = __uint_as_float(bw.y & 0xffff0000u);
                    b1[0] = __uint_as_float(bw.z << 16); b1[1] = __uint_as_float(bw.z & 0xffff0000u); b1[2] = __uint_as_float(bw.w << 16); b1[3] = __uint_as_float(bw.w & 0xffff0000u);
                    acc[ai][bj][m][0] = b0 * ia; acc[ai][bj][m][1] = b1 * ia; }
    }
    __device__ __forceinline__ void fused(f32x4 (&acc)[2][2][4][2], const Unit& u, int wr, int wc, int fr, int fq, PG8_LAS unsigned char* lds, int wid, int lane) const {
        PG8_LAS float* P = (PG8_LAS float*)lds;
        PG8_LAS float* S = (PG8_LAS float*)(lds + 4096);
        const int tid = wid * 64 + lane;
#pragma unroll
        for (int ai = 0; ai < 2; ++ai)
#pragma unroll
            for (int m = 0; m < 4; ++m) { float s = 0.f;
#pragma unroll
                for (int bj = 0; bj < 2; ++bj)
#pragma unroll
                    for (int n = 0; n < 2; ++n) { const f32x4 o = acc[ai][bj][m][n] * alpha; acc[ai][bj][m][n] = o; const f32x4 q = o * o; s += (q[0] + q[1]) + (q[2] + q[3]); }
                { const auto t16 = __builtin_amdgcn_permlane16_swap(__float_as_uint(s), __float_as_uint(s), false, false); s = __uint_as_float(t16[0]) + __uint_as_float(t16[1]);
                  const auto t32 = __builtin_amdgcn_permlane32_swap(__float_as_uint(s), __float_as_uint(s), false, false); s = __uint_as_float(t32[0]) + __uint_as_float(t32[1]); }
                if (fq == 0) P[(ai * HALF + wr * 64 + m * 16 + fr) * 4 + wc] = s; }
        asm volatile("s_waitcnt lgkmcnt(0)" ::: "memory"); __builtin_amdgcn_s_barrier(); asm volatile("" ::: "memory");
        if (tid < 256) { const float t = (P[tid * 4 + 0] + P[tid * 4 + 1]) + (P[tid * 4 + 2] + P[tid * 4 + 3]);
            __hip_atomic_store(xslot + ((size_t)(u.pm * BM + tid) * 4 + u.pn), __float_as_uint(t), __ATOMIC_RELAXED, __HIP_MEMORY_SCOPE_AGENT); }
        asm volatile("s_waitcnt vmcnt(0)" ::: "memory");
        if (lane == 0) __hip_atomic_fetch_add(cnt + 64 * u.pm, 1u, __ATOMIC_RELAXED, __HIP_MEMORY_SCOPE_AGENT);
        if (wid == 0) { unsigned spins = 0;
            while ((unsigned)__builtin_amdgcn_readfirstlane(__hip_atomic_load(cnt + 64 * u.pm, __ATOMIC_RELAXED, __HIP_MEMORY_SCOPE_AGENT)) < 32u) { __builtin_amdgcn_s_sleep(2); if (++spins > (1u << 20)) break; }
            __builtin_amdgcn_fence(__ATOMIC_ACQUIRE, "agent"); }
        asm volatile("s_waitcnt vmcnt(0) lgkmcnt(0)" ::: "memory"); __builtin_amdgcn_s_barrier(); asm volatile("" ::: "memory");
        if (tid < 256) { const unsigned* sl = xslot + (size_t)(u.pm * BM + tid) * 4; float t = 0.f;
#pragma unroll
            for (int k = 0; k < 4; ++k) t += __uint_as_float(__hip_atomic_load(sl + k, __ATOMIC_RELAXED, __HIP_MEMORY_SCOPE_AGENT));
            S[tid] = __builtin_amdgcn_rsqf(t * (1.0f / 1024.0f) + 1e-6f); }
        asm volatile("s_waitcnt vmcnt(0) lgkmcnt(0)" ::: "memory"); __builtin_amdgcn_s_barrier(); asm volatile("" ::: "memory");
        const unsigned row0 = u.pm * BM + wr * 64 + fr, col0 = u.pn * BM + wc * 32 + 8 * fq;
        f32x4 gv[2][2];
#pragma unroll
        for (int bj = 0; bj < 2; ++bj) { gv[bj][0] = *(const f32x4*)(gain + col0 + bj * HALF); gv[bj][1] = *(const f32x4*)(gain + col0 + bj * HALF + 4); }
#pragma unroll
        for (int ai = 0; ai < 2; ++ai)
#pragma unroll
            for (int m = 0; m < 4; ++m) { const float rs = S[ai * HALF + wr * 64 + m * 16 + fr]; const unsigned r = row0 + ai * HALF + m * 16;
#pragma unroll
                for (int bj = 0; bj < 2; ++bj) { float* op = out + (r * 1024u + col0 + bj * HALF);
                    *(f32x4*)op = acc[ai][bj][m][0] * rs * gv[bj][0]; *(f32x4*)(op + 4) = acc[ai][bj][m][1] * rs * gv[bj][1]; } }
    }
};
struct EpiWin {
    static constexpr bool PERM = true, AFTER_DRAIN = false, HAS_INIT = false;
    bf16_t* QKV; bf16_t* GATE; const float* ssqp; const float* rope; const PG8_LAS float* rsl;
    __device__ __forceinline__ void operator()(const f32x4 (&acc)[2][2][4][2], const Unit& u, int wr, int wc, int fr, int fq) const {
        const int row0 = u.pm * BM + wr * 64 + fr; const int pn = u.pn; const bool isgate = pn >= 12;
        const bool dorope = (pn < 6) && ((wc & 1) == 0) && (fq < 2); const float qs = (pn < 3 || pn == 9) ? 0.125f : 1.0f;
#pragma unroll
        for (int ai = 0; ai < 2; ++ai)
#pragma unroll
            for (int m = 0; m < 4; ++m) {
                const int r = row0 + ai * HALF + m * 16; const float rs = rsl[u.ui * 256 + ai * HALF + wr * 64 + m * 16 + fr]; const int t = r & 4095;
#pragma unroll
                for (int bj = 0; bj < 2; ++bj) {
                    const int colt = bj * HALF + wc * 32 + 8 * fq; float v[8];
#pragma unroll
                    for (int n = 0; n < 2; ++n)
#pragma unroll
                        for (int j = 0; j < 4; ++j) v[n * 4 + j] = acc[ai][bj][m][n][j] * rs;
                    bf16_t* dst;
                    if (isgate) {
#pragma unroll
                        for (int i = 0; i < 8; ++i) v[i] = __builtin_amdgcn_rcpf(1.0f + __builtin_amdgcn_exp2f(-v[i] * LOG2E));
                        dst = GATE + ((unsigned)r * 2048u + (unsigned)((pn - 12) * 256 + colt));
                    } else {
                        if (dorope) {
                            const f32x4* cs = (const f32x4*)(rope + ((unsigned)t * 16u + 8u * (unsigned)fq));
                            const f32x4 c01 = cs[0], c23 = cs[1];
                            { const float x1 = v[0], x2 = v[1]; v[0] = x1 * c01[0] - x2 * c01[1]; v[1] = x2 * c01[0] + x1 * c01[1]; }
                            { const float x1 = v[2], x2 = v[3]; v[2] = x1 * c01[2] - x2 * c01[3]; v[3] = x2 * c01[2] + x1 * c01[3]; }
                            { const float x1 = v[4], x2 = v[5]; v[4] = x1 * c23[0] - x2 * c23[1]; v[5] = x2 * c23[0] + x1 * c23[1]; }
                            { const float x1 = v[6], x2 = v[7]; v[6] = x1 * c23[2] - x2 * c23[3]; v[7] = x2 * c23[2] + x1 * c23[3]; }
                        }
#pragma unroll
                        for (int i = 0; i < 8; ++i) v[i] *= qs;
                        { const unsigned cc = (unsigned)(pn * 256 + colt); dst = QKV + (((cc >> 6) * 16384u + (unsigned)r) * 64u + (cc & 63u)); }
                    }
                    u32x4 w; w.x = cvt_pk_bf16(v[0], v[1]); w.y = cvt_pk_bf16(v[2], v[3]); w.z = cvt_pk_bf16(v[4], v[5]); w.w = cvt_pk_bf16(v[6], v[7]);
                    *(u32x4*)dst = w;
                }
                asm volatile("" ::: "memory");
            }
    }
};
template <bool SECOND> struct EpiGate {
    static constexpr bool PERM = true, AFTER_DRAIN = false, HAS_INIT = false;
    const bf16_t* gate; bf16_t* Y1; bf16_t* Y;
    __device__ __forceinline__ void operator()(const f32x4 (&acc)[2][2][4][2], const Unit& u, int wr, int wc, int fr, int fq) const {
        const unsigned row0 = u.pm * BM + wr * 64 + fr, col0 = u.pn * BM + wc * 32 + 8 * fq;
#pragma unroll
        for (int ai = 0; ai < 2; ++ai)
#pragma unroll
            for (int m = 0; m < 4; ++m) {
                const unsigned r = row0 + ai * HALF + m * 16;
#pragma unroll
                for (int bj = 0; bj < 2; ++bj) {
                    const unsigned c = col0 + bj * HALF; const unsigned go = r * 2048u + c, yo = r * 1024u + c;
                    const u32x4 gw = *(const u32x4*)(gate + go);
                    f32x4 a0 = acc[ai][bj][m][0], a1 = acc[ai][bj][m][1];
                    a0[0] *= __uint_as_float(gw.x << 16); a0[1] *= __uint_as_float(gw.x & 0xffff0000u); a0[2] *= __uint_as_float(gw.y << 16); a0[3] *= __uint_as_float(gw.y & 0xffff0000u);
                    a1[0] *= __uint_as_float(gw.z << 16); a1[1] *= __uint_as_float(gw.z & 0xffff0000u); a1[2] *= __uint_as_float(gw.w << 16); a1[3] *= __uint_as_float(gw.w & 0xffff0000u);
                    if (!SECOND) { u32x4 w; w.x = cvt_pk_bf16(a0[0], a0[1]); w.y = cvt_pk_bf16(a0[2], a0[3]); w.z = cvt_pk_bf16(a1[0], a1[1]); w.w = cvt_pk_bf16(a1[2], a1[3]); *(u32x4*)(Y1 + yo) = w; }
                    else { const u32x4 yw = *(const u32x4*)(Y1 + yo);
                        a0[0] += __uint_as_float(yw.x << 16); a0[1] += __uint_as_float(yw.x & 0xffff0000u); a0[2] += __uint_as_float(yw.y << 16); a0[3] += __uint_as_float(yw.y & 0xffff0000u);
                        a1[0] += __uint_as_float(yw.z << 16); a1[1] += __uint_as_float(yw.z & 0xffff0000u); a1[2] += __uint_as_float(yw.w << 16); a1[3] += __uint_as_float(yw.w & 0xffff0000u);
                        u32x4 w; w.x = cvt_pk_bf16(a0[0], a0[1]); w.y = cvt_pk_bf16(a0[2], a0[3]); w.z = cvt_pk_bf16(a1[0], a1[1]); w.w = cvt_pk_bf16(a1[2], a1[3]);
                        __builtin_amdgcn_raw_buffer_store_b128(w, __builtin_amdgcn_make_buffer_rsrc(Y, 0, 16384 * 1024 * 2, 0x00020000), yo * 2u, 0,   16); }
                    asm volatile("" ::: "memory");
                }
            }
    }
};
struct EpiGate2 {
    static constexpr bool PERM = true, AFTER_DRAIN = false, HAS_INIT = false;
    const bf16_t* gate; bf16_t* Y1; bf16_t* Y;
    __device__ __forceinline__ void operator()(const f32x4 (&acc)[2][2][4][2], const Unit& u, int wr, int wc, int fr, int fq) const {
        const unsigned row0 = u.pm * BM + wr * 64 + fr, col0 = u.pn * BM + wc * 32 + 8 * fq; const bool second = u.sel != 0; const unsigned gofs = second ? 0u : 1024u;
#pragma unroll
        for (int ai = 0; ai < 2; ++ai)
#pragma unroll
            for (int m = 0; m < 4; ++m) {
                const unsigned r = row0 + ai * HALF + m * 16;
#pragma unroll
                for (int bj = 0; bj < 2; ++bj) {
                    const unsigned c = col0 + bj * HALF; const unsigned go = r * 2048u + gofs + c, yo = r * 1024u + c;
                    const u32x4 gw = __builtin_nontemporal_load((const u32x4*)(gate + go));
                    f32x4 a0 = acc[ai][bj][m][0], a1 = acc[ai][bj][m][1];
                    a0[0] *= __uint_as_float(gw.x << 16); a0[1] *= __uint_as_float(gw.x & 0xffff0000u); a0[2] *= __uint_as_float(gw.y << 16); a0[3] *= __uint_as_float(gw.y & 0xffff0000u);
                    a1[0] *= __uint_as_float(gw.z << 16); a1[1] *= __uint_as_float(gw.z & 0xffff0000u); a1[2] *= __uint_as_float(gw.w << 16); a1[3] *= __uint_as_float(gw.w & 0xffff0000u);
                    if (second) { const u32x4 yw = *(const u32x4*)(Y1 + yo);
                        a0[0] += __uint_as_float(yw.x << 16); a0[1] += __uint_as_float(yw.x & 0xffff0000u); a0[2] += __uint_as_float(yw.y << 16); a0[3] += __uint_as_float(yw.y & 0xffff0000u);
                        a1[0] += __uint_as_float(yw.z << 16); a1[1] += __uint_as_float(yw.z & 0xffff0000u); a1[2] += __uint_as_float(yw.w << 16); a1[3] += __uint_as_float(yw.w & 0xffff0000u); }
                    u32x4 w; w.x = cvt_pk_bf16(a0[0], a0[1]); w.y = cvt_pk_bf16(a0[2], a0[3]); w.z = cvt_pk_bf16(a1[0], a1[1]); w.w = cvt_pk_bf16(a1[2], a1[3]);
                    if (second) __builtin_amdgcn_raw_buffer_store_b128(w, __builtin_amdgcn_make_buffer_rsrc(Y, 0, 16384 * 1024 * 2, 0x00020000), yo * 2u, 0,   16);
                    else *(u32x4*)(Y1 + yo) = w;
                    asm volatile("" ::: "memory");
                }
            }
    }
};

template <class Epi, class Sched, bool ALIGN_EPI = false, bool SP2 = false>
__device__ __forceinline__ void gemm_phase(PG8_LAS unsigned char* lds, const Gemm g, const Sched& S, const Epi& E) {
    int tid_ = threadIdx.x; asm volatile("" : "+v"(tid_));
    const int tid = tid_, wid = __builtin_amdgcn_readfirstlane(tid >> 6), lane = tid & 63, wr = wid >> 2, wc = wid & 3, fr = lane & 15, fq = lane >> 4;
    const int K = g.K, nt = K / BK;
    unsigned voffA[2], voffB[2];
#pragma unroll
    for (int i = 0; i < 2; ++i) { int R, C; stage_rc(tid * 16 + i * 8192, R, C); const int Rb = Epi::PERM ? ((R & ~31) + perm32(R & 31)) : R;
        voffA[i] = (unsigned)(R * K + C) * 2u; voffB[i] = (unsigned)(Rb * K + C) * 2u; }
    const size_t kstep = (size_t)(BK * 2);
    const size_t hstep = (size_t)HALF * K * 2;
    const size_t tstep = 2 * hstep;
    const unsigned ldsw = (unsigned)wid * 1024u;
    const int aoff = lds_byte(wr * 64 + fr, fq * 8), boff = lds_byte(wc * 32 + fr, fq * 8);
#define PG8_SA(b, h) (((b) * 2 + (h)) * HTB)
#define PG8_SB(b, h) ((4 + (b) * 2 + (h)) * HTB)
#define PG8_STAGE(bufoff, gbase, voff) do { _Pragma("unroll") for (int _i = 0; _i < 2; ++_i) \
        __builtin_amdgcn_global_load_lds((const unsigned*)((const char*)(gbase) + (voff)[_i]), (PG8_LAS unsigned*)(lds + (bufoff) + ldsw + _i * 8192), 16, 0, 0); } while (0)
#define PG8_LDA(dst, b, h) do { _Pragma("unroll") for (int m = 0; m < 4; ++m) _Pragma("unroll") for (int k = 0; k < 2; ++k) dst[m][k] = *(const PG8_LAS bf16x8*)(lds + PG8_SA(b, h) + aoff + m * 2048 + k * 1024); } while (0)
#define PG8_LDB(dst, b, h) do { _Pragma("unroll") for (int n = 0; n < 2; ++n) _Pragma("unroll") for (int k = 0; k < 2; ++k) dst[n][k] = *(const PG8_LAS bf16x8*)(lds + PG8_SB(b, h) + boff + n * 2048 + k * 1024); } while (0)
#define PG8_MMA(ai, bj, At, Bt) do { __builtin_amdgcn_s_setprio(1); _Pragma("unroll") for (int m = 0; m < 4; ++m) _Pragma("unroll") for (int n = 0; n < 2; ++n) _Pragma("unroll") for (int k = 0; k < 2; ++k) \
        acc[ai][bj][m][n] = __builtin_amdgcn_mfma_f32_16x16x32_bf16(Bt[n][k], At[m][k], acc[ai][bj][m][n], 0, 0, 0); __builtin_amdgcn_s_setprio(0); } while (0)
#define PG8_WAIT_V(n) asm volatile("s_waitcnt vmcnt(" #n ")" ::: "memory")
#define PG8_WAIT_L(n) asm volatile("s_waitcnt lgkmcnt(" #n ")" ::: "memory")
#define PG8_BAR __builtin_amdgcn_s_barrier()
#define PG8_SCHED __builtin_amdgcn_sched_barrier(0)
    Unit cur, nxt; int ui = 0;
    if (!S.next(0, cur)) return;
    f32x4 acc[2][2][4][2];
    if constexpr (Epi::HAS_INIT) E.init(acc, cur, wr, wc, fr, fq);
    else {
#pragma unroll
    for (int a = 0; a < 2; ++a)
#pragma unroll
        for (int b = 0; b < 2; ++b)
#pragma unroll
            for (int m = 0; m < 4; ++m)
#pragma unroll
                for (int n = 0; n < 2; ++n) acc[a][b][m][n] = (f32x4){0.f, 0.f, 0.f, 0.f};
    }
    bf16x8 At[4][2], B0[2][2], B1[2][2];
    const char* cA = (const char*)(cur.sel ? g.A2 : g.A) + (size_t)cur.pm * tstep; const char* cB = (const char*)(cur.sel ? g.Bt2 : g.Bt) + (size_t)cur.pn * tstep;
    S.a_ready(cur);
    if constexpr (SP2) {
        PG8_STAGE(PG8_SB(0, 0), cB, voffB); PG8_STAGE(PG8_SB(0, 1), cB + hstep, voffB); PG8_STAGE(PG8_SA(0, 0), cA, voffA); PG8_STAGE(PG8_SA(0, 1), cA + hstep, voffA);
        if (wr == 1) PG8_BAR;
        PG8_WAIT_V(2); PG8_BAR;
        PG8_STAGE(PG8_SB(1, 0), cB + kstep, voffB); PG8_STAGE(PG8_SA(1, 0), cA + kstep, voffA); PG8_STAGE(PG8_SB(1, 1), cB + hstep + kstep, voffB);
        PG8_WAIT_V(6); PG8_BAR;
    } else {
        PG8_STAGE(PG8_SB(0, 0), cB, voffB); PG8_STAGE(PG8_SA(0, 0), cA, voffA); PG8_STAGE(PG8_SB(0, 1), cB + hstep, voffB); PG8_STAGE(PG8_SA(0, 1), cA + hstep, voffA);
        if (wr == 1) PG8_BAR;
        PG8_WAIT_V(4); PG8_BAR;
        PG8_STAGE(PG8_SB(1, 0), cB + kstep, voffB); PG8_STAGE(PG8_SA(1, 0), cA + kstep, voffA); PG8_STAGE(PG8_SB(1, 1), cB + hstep + kstep, voffB);
        PG8_WAIT_V(6); PG8_BAR;
    }
    for (;;) {
        const bool has_next = S.next(ui + 1, nxt);
        const char* nA = has_next ? (const char*)(nxt.sel ? g.A2 : g.A) + (size_t)nxt.pm * tstep : cA; const char* nB = has_next ? (const char*)(nxt.sel ? g.Bt2 : g.Bt) + (size_t)nxt.pn * tstep : cB;
        for (int t = 0; t < nt; t += 2) {
            const bool last = (t == nt - 2);
            const char* a1 = cA + (size_t)(t + 1) * kstep;
            const char* a2 = last ? nA : cA + (size_t)(t + 2) * kstep; const char* b2 = last ? nB : cB + (size_t)(t + 2) * kstep;
            const char* a3 = a2 + kstep; const char* b3 = b2 + kstep;
            if (last && has_next) S.a_ready(nxt);
            if constexpr (SP2) {
            PG8_LDB(B0, 0, 0); PG8_LDB(B1, 0, 1); PG8_SCHED; PG8_LDA(At, 0, 0); PG8_STAGE(PG8_SA(1, 1), a1 + hstep, voffA);
            PG8_WAIT_V(8); PG8_WAIT_L(0); PG8_BAR; PG8_MMA(0, 0, At, B0); PG8_MMA(0, 1, At, B1); PG8_BAR; PG8_SCHED;
            PG8_LDA(At, 0, 1); PG8_STAGE(PG8_SB(0, 0), b2, voffB); PG8_STAGE(PG8_SB(0, 1), b2 + hstep, voffB); PG8_STAGE(PG8_SA(0, 0), a2, voffA);
            PG8_WAIT_V(8); PG8_WAIT_L(0); PG8_BAR; PG8_MMA(1, 0, At, B0); PG8_MMA(1, 1, At, B1); PG8_BAR; PG8_SCHED;
            PG8_LDB(B0, 1, 0); PG8_LDB(B1, 1, 1); PG8_SCHED; PG8_LDA(At, 1, 0); PG8_STAGE(PG8_SA(0, 1), a2 + hstep, voffA);
            PG8_WAIT_V(8); PG8_WAIT_L(0); PG8_BAR; PG8_MMA(0, 0, At, B0); PG8_MMA(0, 1, At, B1); PG8_BAR; PG8_SCHED;
            PG8_LDA(At, 1, 1); PG8_STAGE(PG8_SB(1, 0), b3, voffB); PG8_STAGE(PG8_SB(1, 1), b3 + hstep, voffB); PG8_STAGE(PG8_SA(1, 0), a3, voffA);
            PG8_WAIT_V(8); PG8_WAIT_L(0); PG8_BAR; PG8_MMA(1, 0, At, B0); PG8_MMA(1, 1, At, B1); PG8_BAR; PG8_SCHED;
            } else {
            PG8_LDB(B0, 0, 0); PG8_SCHED; PG8_LDA(At, 0, 0); PG8_STAGE(PG8_SA(1, 1), a1 + hstep, voffA);
            PG8_WAIT_L(8); PG8_BAR; PG8_WAIT_L(0); PG8_MMA(0, 0, At, B0); PG8_BAR; PG8_SCHED;
            PG8_LDB(B1, 0, 1); PG8_STAGE(PG8_SB(0, 0), b2, voffB);
            PG8_BAR; PG8_WAIT_L(0); PG8_MMA(0, 1, At, B1); PG8_BAR;
            PG8_LDA(At, 0, 1); PG8_STAGE(PG8_SA(0, 0), a2, voffA);
            PG8_BAR; PG8_WAIT_L(0); PG8_MMA(1, 0, At, B0); PG8_BAR; PG8_SCHED;
            PG8_STAGE(PG8_SB(0, 1), b2 + hstep, voffB);
            PG8_WAIT_V(6); PG8_BAR; PG8_MMA(1, 1, At, B1); PG8_BAR;
            PG8_LDB(B0, 1, 0); PG8_SCHED; PG8_LDA(At, 1, 0); PG8_STAGE(PG8_SA(0, 1), a2 + hstep, voffA);
            PG8_WAIT_L(8); PG8_BAR; PG8_WAIT_L(0); PG8_MMA(0, 0, At, B0); PG8_BAR; PG8_SCHED;
            PG8_LDB(B1, 1, 1); PG8_STAGE(PG8_SB(1, 0), b3, voffB);
            PG8_BAR; PG8_WAIT_L(0); PG8_MMA(0, 1, At, B1); PG8_BAR;
            PG8_LDA(At, 1, 1); PG8_STAGE(PG8_SA(1, 0), a3, voffA);
            PG8_BAR; PG8_WAIT_L(0); PG8_MMA(1, 0, At, B0); PG8_BAR; PG8_SCHED;
            PG8_STAGE(PG8_SB(1, 1), b3 + hstep, voffB);
            PG8_WAIT_V(6); PG8_BAR; PG8_MMA(1, 1, At, B1); PG8_BAR;
            }
        }
        if constexpr (ALIGN_EPI) { if (wr == 0) PG8_BAR; }
        if constexpr (!Epi::AFTER_DRAIN) { E(acc, cur, wr, wc, fr, fq); S.done(cur); }
        if (!has_next) break;
        if constexpr (Epi::HAS_INIT) E.init(acc, nxt, wr, wc, fr, fq);
        else {
#pragma unroll
        for (int a = 0; a < 2; ++a)
#pragma unroll
            for (int b = 0; b < 2; ++b)
#pragma unroll
                for (int m = 0; m < 4; ++m)
#pragma unroll
                    for (int n = 0; n < 2; ++n) acc[a][b][m][n] = (f32x4){0.f, 0.f, 0.f, 0.f};
        }
        cur = nxt; cA = nA; cB = nB; ++ui;
        if constexpr (ALIGN_EPI) { if (wr == 1) PG8_BAR; }
    }
    PG8_WAIT_V(0);
    if constexpr (!ALIGN_EPI) { if (wr == 0) PG8_BAR; }
    PG8_BAR;
    if constexpr (Epi::AFTER_DRAIN) { E.fused(acc, cur, wr, wc, fr, fq, lds, wid, lane); S.done(cur); }
#undef PG8_SA
#undef PG8_SB
#undef PG8_STAGE
#undef PG8_LDA
#undef PG8_LDB
#undef PG8_MMA
#undef PG8_WAIT_V
#undef PG8_WAIT_L
#undef PG8_BAR
#undef PG8_SCHED
}
}

#define LAS __attribute__((address_space(3)))
typedef unsigned short bf16;
typedef short bf16x8 __attribute__((ext_vector_type(8)));
typedef short s16x4 __attribute__((ext_vector_type(4)));
typedef float f32x4 __attribute__((ext_vector_type(4)));
typedef float f32x16 __attribute__((ext_vector_type(16)));
typedef unsigned u32x4 __attribute__((ext_vector_type(4)));
typedef unsigned u32x2 __attribute__((ext_vector_type(2)));
constexpr int NWAVES = 8;
constexpr int M = 16384, D = 1024, SEQ = 4096, FF = 2816, NIN = 5120, NQKV = 3072, NGATE = 2048, DEPTH = 2;
constexpr float LOG2E = 1.4426950408889634f;
#ifndef SB_EARLY_EXIT
#define SB_EARLY_EXIT 1
#endif
#ifndef N_LAUNCH_MODE
#define N_LAUNCH_MODE 0
#endif
constexpr size_t MiB = 1u << 20;
constexpr size_t WS_CNT = 16384, WS_PCNT = 32768, WS_ZERO_BYTES = 32768 + 4 * 16384;
constexpr size_t WS_XSLOT = 250 * MiB;
constexpr size_t WS_BAR = 0;
constexpr size_t WS_SSQ = 1 * MiB, WS_ROPE = 2 * MiB, WS_LSE = 3 * MiB;
constexpr size_t WS_W = 4 * MiB;
constexpr size_t W_1CAT = 0, W_D1 = W_1CAT + (size_t)2 * FF * D * 2, W_IN = W_D1 + (size_t)D * FF * 2, W_PD = W_IN + (size_t)NIN * D * 2, W_PS = W_PD + (size_t)D * 256 * 2,
                 W_OUT = W_PS + (size_t)D * 256 * 2, W_2CAT = W_OUT + (size_t)D * D * 2, W_D2 = W_2CAT + (size_t)2 * FF * D * 2, W_END = W_D2 + (size_t)D * FF * 2;
static_assert(W_END <= 46 * MiB, "weights");
constexpr size_t WS_XB = 50 * MiB;
constexpr size_t OUT_OD3 = 0, OUT_OD = 24 * MiB;
constexpr size_t WS_R = 82 * MiB;
constexpr size_t WS_Y1 = WS_R, WS_Y = WS_R + 64 * MiB;
constexpr size_t WS_GATE = 178 * MiB;
constexpr size_t WS_OS = 242 * MiB;
constexpr size_t WS_END = 251 * MiB;
constexpr int RSL_OFF = 131072 + 1024;
constexpr int LDS_BYTES = RSL_OFF + 8 * 256 * 4;

__device__ __forceinline__ float wave_sum(float v) {
#pragma unroll
    for (int o = 1; o < 64; o <<= 1) v += __shfl_xor(v, o);
    return v;
}
__device__ __forceinline__ unsigned pk2(float lo, float hi) { return pg8::cvt_pk_bf16(lo, hi); }
#define LDS_WAIT() asm volatile("s_waitcnt lgkmcnt(0)" ::: "memory")

typedef __attribute__((address_space(1))) unsigned gu32;
#define XB_TMO      128
#define XB_XCNT(j)  (256  + 64 * (j))
#define XB_XSUB(j)  (1280 + 64 * (j))
#define XB_XGEN(j)  (2304 + 64 * (j))
#define XB_TOP      3328
#define XB_TOPGEN   3392
#define XCD_BAR_WORDS 3456
#define XB_SPIN_CAP (1u << 18)

__device__ __forceinline__ unsigned xb_ld(unsigned* p)              { return __hip_atomic_load(p, __ATOMIC_RELAXED, __HIP_MEMORY_SCOPE_AGENT); }
__device__ __forceinline__ unsigned xb_add(unsigned* p, unsigned v) { return __hip_atomic_fetch_add(p, v, __ATOMIC_RELAXED, __HIP_MEMORY_SCOPE_AGENT); }
__device__ __forceinline__ unsigned xb_xcc_id() { return (unsigned)__builtin_amdgcn_s_getreg((3 << 11) | 20) & 0xFu; }
#define XB_SPIN(cond, bar) do { unsigned _sp = 0; while (cond) { __builtin_amdgcn_s_sleep(1); \
    if ((++_sp & 255u) == 0u) { if (xb_ld(&(bar)[XB_TMO])) break; if (_sp > XB_SPIN_CAP) { atomicAdd(&(bar)[XB_TMO], 1u); break; } } } } while (0)

struct XcdBarrier {
    unsigned* bar; unsigned x;
    volatile LAS unsigned* st;
};

__device__ __forceinline__ XcdBarrier xcd_barrier_post(unsigned* bar, volatile LAS unsigned* st) {
    XcdBarrier b; b.bar = bar; b.x = xb_xcc_id(); b.st = st;
    if (threadIdx.x == 0) (void)xb_add(&bar[XB_XCNT(b.x)], 1u);
    return b;
}
__device__ __forceinline__ void xcd_barrier_complete(unsigned* bar, unsigned x, unsigned& nloc, unsigned& nx) {
    const unsigned G = gridDim.x * gridDim.y * gridDim.z;
    unsigned sum, cnt, mine, sp = 0u;
    for (;;) {
        sum = 0u; cnt = 0u; mine = 0u;
#pragma unroll
        for (unsigned j = 0; j < 16; ++j) { const unsigned c = xb_ld(&bar[XB_XCNT(j)]); sum += c; cnt += (c > 0u) ? 1u : 0u; mine = (j == x) ? c : mine; }
        if (sum == G) break;
        __builtin_amdgcn_s_sleep(1);
        if ((++sp & 255u) == 0u) { if (xb_ld(&bar[XB_TMO])) break; if (sp > XB_SPIN_CAP) { atomicAdd(&bar[XB_TMO], 1u); break; } }
    }
    nloc = mine > 0u ? mine : 1u; nx = cnt > 0u ? cnt : 1u;
}

__device__ __forceinline__ void xcd_barrier(const XcdBarrier& b) {
    asm volatile("s_waitcnt vmcnt(0)" ::: "memory");
    __syncthreads();
    if (threadIdx.x == 0) {
        unsigned* bar = b.bar;
        __builtin_amdgcn_s_waitcnt(0);
        unsigned nloc = b.st[0], nx = b.st[1];
        if (nloc == 0u) { xcd_barrier_complete(bar, b.x, nloc, nx); b.st[0] = nloc; b.st[1] = nx; }
        const unsigned old = xb_add(&bar[XB_XSUB(b.x)], 1u);
        const unsigned gen = old / nloc;
        if (old + 1u == (gen + 1u) * nloc) {
            __builtin_amdgcn_fence(__ATOMIC_RELEASE, "agent");
            asm volatile("s_waitcnt vmcnt(0)" ::: "memory");
            const unsigned og = xb_add(&bar[XB_TOP], 1u);
            const unsigned tg = og / nx;
            if (og + 1u == (tg + 1u) * nx) xb_add(&bar[XB_TOPGEN], 1u);
            else XB_SPIN(xb_ld(&bar[XB_TOPGEN]) == tg, bar);
            __builtin_amdgcn_fence(__ATOMIC_ACQUIRE, "agent");
            xb_add(&bar[XB_XGEN(b.x)], 1u);
            asm volatile("s_waitcnt vmcnt(0)" ::: "memory");
        } else {
            XB_SPIN(xb_ld(&bar[XB_XGEN(b.x)]) == gen, bar);
            __builtin_amdgcn_fence(__ATOMIC_ACQUIRE, "agent");
            asm volatile("s_waitcnt vmcnt(0)" ::: "memory");
        }
    }
    __syncthreads();
}


constexpr int CI_D1 = 2816, CI_IN = 4224, CI_B = 6784, CI_D2 = 9600, CI_PD = 11008, CI_PS = 11136, CI_OUT = 11264, CI_END = 11776;
struct ConvItem { const float* wp; const float* gp; bf16* dp; int ldw, K; bool rperm; };
struct ConvSrc { const float *n1, *wg1, *wu1, *wd1, *nm, *win, *wpd, *wps, *wout, *n2, *wg2, *wu2, *wd2; };
__device__ __forceinline__ ConvItem conv_decode(const ConvSrc& S, int l, int r, unsigned char* dA, unsigned char* dB, int lane) {
    const float* src; const float* gain = nullptr; bf16* dst; int ldw = D, K = D, kb, nb, sc0; bool rperm = false;
    if (r < CI_D1) { kb = r / 176; nb = r % 176; const int pn = nb >> 3, i8 = nb & 7; src = (i8 < 4 ? S.wg1 : S.wu1) + (size_t)l * D * FF; gain = S.n1 + (size_t)l * D; dst = (bf16*)(dA + W_1CAT); ldw = FF; sc0 = 128 * pn + 32 * (i8 & 3); }
    else if (r < CI_IN) { r -= CI_D1; kb = r / 32; nb = r % 32; src = S.wd1 + (size_t)l * FF * D; dst = (bf16*)(dA + W_D1); K = FF; sc0 = 32 * nb; }
    else if (r < CI_B) { r -= CI_IN; kb = r / 160; nb = r % 160; src = S.win + (size_t)l * D * NIN; gain = S.nm + (size_t)l * D; dst = (bf16*)(dA + W_IN); ldw = NIN; sc0 = 32 * nb; rperm = (nb < 48) && !(nb & 1); }
    else if (r < CI_D2) { r -= CI_B; kb = r / 176; nb = r % 176; const int pn = nb >> 3, i8 = nb & 7; src = (i8 < 4 ? S.wg2 : S.wu2) + (size_t)l * D * FF; gain = S.n2 + (size_t)l * D; dst = (bf16*)(dB + W_2CAT); ldw = FF; sc0 = 128 * pn + 32 * (i8 & 3); }
    else if (r < CI_PD) { r -= CI_D2; kb = r / 32; nb = r % 32; src = S.wd2 + (size_t)l * FF * D; dst = (bf16*)(dB + W_D2); K = FF; sc0 = 32 * nb; }
    else if (r < CI_PS) { r -= CI_PD; kb = r / 32; nb = r % 32; src = S.wpd + (size_t)l * 256 * D; dst = (bf16*)(dB + W_PD); K = 256; sc0 = 32 * nb; }
    else if (r < CI_OUT) { r -= CI_PS; kb = r / 32; nb = r % 32; src = S.wps + (size_t)l * 256 * D; dst = (bf16*)(dB + W_PS); K = 256; sc0 = 32 * nb; }
    else { r -= CI_OUT; kb = r / 32; nb = r % 32; src = S.wout + (size_t)l * D * D; dst = (bf16*)(dB + W_OUT); sc0 = 32 * nb; }
    const int c4 = lane & 7, kr = lane >> 3, k0 = 64 * kb;
    ConvItem I; I.wp = src + (size_t)(k0 + kr) * ldw + sc0 + 4 * c4; I.gp = gain ? gain + k0 + kr : nullptr; I.dp = dst + (size_t)(32 * nb) * K + k0; I.ldw = ldw; I.K = K; I.rperm = rperm;
    return I;
}
__device__ __forceinline__ void conv_load(f32x4 (&v)[8], const ConvItem& I) {
#pragma unroll
    for (int i = 0; i < 8; ++i) v[i] = __builtin_nontemporal_load((const f32x4*)(I.wp + (size_t)(8 * i) * I.ldw));
}
__device__ __forceinline__ void conv_finish(f32x4 (&v)[8], const ConvItem& I, LAS float* scr, int lane) {
    const int c4 = lane & 7, kr = lane >> 3;
    if (I.gp) {
#pragma unroll
        for (int i = 0; i < 8; ++i) v[i] *= I.gp[8 * i];
    }
    int p[4];
#pragma unroll
    for (int e = 0; e < 4; ++e) { const int sc = 4 * c4 + e; p[e] = (I.rperm && sc < 16) ? (sc < 8 ? 2 * sc : 2 * (sc - 8) + 1) : sc; }
#pragma unroll
    for (int i = 0; i < 8; ++i)
#pragma unroll
        for (int e = 0; e < 4; ++e) scr[(kr + 8 * i) * 33 + p[e]] = v[i][e];
    LDS_WAIT();
    const int c = lane & 7;
#pragma unroll
    for (int jj = 0; jj < 4; ++jj) { const int n = (lane >> 3) + 8 * jj; const LAS float* s = scr + (8 * c) * 33 + n;
        u32x4 o; o.x = pk2(s[0 * 33], s[1 * 33]); o.y = pk2(s[2 * 33], s[3 * 33]); o.z = pk2(s[4 * 33], s[5 * 33]); o.w = pk2(s[6 * 33], s[7 * 33]);
        *(u32x4*)(I.dp + (size_t)n * I.K + 8 * c) = o; }
    LDS_WAIT();
}
__device__ __forceinline__ void conv_items(const ConvSrc& S, int l, int lo, int hi, unsigned char* dA, unsigned char* dB, LAS unsigned char* lds, int widx, int nw, int wave, int lane) {
    LAS float* scr = (LAS float*)(lds + wave * 8704);
    int it = lo + widx; if (it >= hi) return;
    ConvItem cur = conv_decode(S, l, __builtin_amdgcn_readfirstlane(it), dA, dB, lane); f32x4 v[8]; conv_load(v, cur);
    for (;;) {
        const int itn = it + nw; const bool more = itn < hi;
        ConvItem nxt = cur; f32x4 vn[8];
        if (more) { nxt = conv_decode(S, l, __builtin_amdgcn_readfirstlane(itn), dA, dB, lane); conv_load(vn, nxt); }
        conv_finish(v, cur, scr, lane);
        if (!more) break;
        cur = nxt; it = itn;
#pragma unroll
        for (int i = 0; i < 8; ++i) v[i] = vn[i];
    }
}
__device__ __forceinline__ void conv_phase(const float* Px, const ConvSrc& S, unsigned char* Pws, int l, LAS unsigned char* lds, int gw, int NGW, int wave, int lane) {
    unsigned char* wsw = Pws + WS_W;
    conv_items(S, l, 0, CI_END, wsw, wsw, lds, gw, NGW, wave, lane);
    if (l == 0) {
        const float* x = Px; bf16* xb = (bf16*)(Pws + WS_XB); float* ssqp = (float*)(Pws + WS_SSQ);
        for (int m = gw; m < M; m += NGW) {
            const f32x4* xr = (const f32x4*)(x + (size_t)m * D) + 2 * lane; f32x4 v[4]; float s = 0.f;
#pragma unroll
            for (int j = 0; j < 2; ++j) { v[2 * j] = __builtin_nontemporal_load(xr + 128 * j); v[2 * j + 1] = __builtin_nontemporal_load(xr + 128 * j + 1); }
#pragma unroll
            for (int j = 0; j < 4; ++j) s += (v[j][0] * v[j][0] + v[j][1] * v[j][1]) + (v[j][2] * v[j][2] + v[j][3] * v[j][3]);
            s = wave_sum(s);
            u32x4* o = (u32x4*)(xb + (size_t)m * D) + lane;
#pragma unroll
            for (int j = 0; j < 2; ++j) { u32x4 w; w.x = pk2(v[2 * j][0], v[2 * j][1]); w.y = pk2(v[2 * j][2], v[2 * j][3]); w.z = pk2(v[2 * j + 1][0], v[2 * j + 1][1]); w.w = pk2(v[2 * j + 1][2], v[2 * j + 1][3]); o[64 * j] = w; }
            if (lane < 16) ssqp[(size_t)m * 16 + lane] = (lane == 0) ? s : 0.f;
        }
        float* rope = (float*)(Pws + WS_ROPE);
        for (int idx = gw * 64 + lane; idx < SEQ * 8; idx += NGW * 64) {
            const int t = idx >> 3, i = idx & 7;
            const float invf = (i == 0) ? 1.0f : (i == 1) ? 0.1939227432012558f : (i == 2) ? 0.03760603070259094f : (i == 3) ? 0.007292664609849453f : (i == 4) ? 0.0014142135623842478f
                             : (i == 5) ? 0.00027424818836152554f : (i == 6) ? 5.3182957344688475e-05f : 1.0313385246263351e-05f;
            const float angf = (float)t * invf; const double a = (double)angf;
            const double kq = __builtin_rint(a * 0.63661977236758134308);
            double rr = __builtin_fma(-kq, 1.57079632679489655800, a); rr = __builtin_fma(-kq, 6.12323399573676603587e-17, rr);
            const int qd = ((int)kq) & 3; const float rf = (float)rr, r2 = rf * rf;
            const float sn = rf + rf * r2 * (-1.0f / 6 + r2 * (1.0f / 120 + r2 * (-1.0f / 5040 + r2 * (1.0f / 362880))));
            const float cn = 1.0f + r2 * (-0.5f + r2 * (1.0f / 24 + r2 * (-1.0f / 720 + r2 * (1.0f / 40320 + r2 * (-1.0f / 3628800)))));
            const float c = (qd == 0) ? cn : (qd == 1) ? -sn : (qd == 2) ? -cn : sn;
            const float s = (qd == 0) ? sn : (qd == 1) ? cn : (qd == 2) ? -sn : -cn;
            rope[2 * idx] = c; rope[2 * idx + 1] = s;
        }
    }
}

__device__ __forceinline__ int crow(int r, int hi) { return (r & 3) + 8 * (r >> 2) + 4 * hi; }
struct F2 { float a, b; };
__device__ __forceinline__ F2 pair32(float v) { const auto rr = __builtin_amdgcn_permlane32_swap(__float_as_uint(v), __float_as_uint(v), false, false); return F2{__uint_as_float(rr[0]), __uint_as_float(rr[1])}; }
__device__ __forceinline__ void ld_frag4(bf16x8 (&f)[4], const bf16* ubase, unsigned rowstride, int lane) {
    const unsigned off = (unsigned)(lane & 31) * rowstride + (unsigned)(lane >> 5) * 8u;
#pragma unroll
    for (int d0 = 0; d0 < 4; ++d0) f[d0] = *(const bf16x8*)(ubase + (off + d0 * 16));
}
__device__ __forceinline__ void ld_frag4_nt(bf16x8 (&f)[4], const bf16* ubase, unsigned rowstride, int lane) {
    const unsigned off = (unsigned)(lane & 31) * rowstride + (unsigned)(lane >> 5) * 8u;
#pragma unroll
    for (int d0 = 0; d0 < 4; ++d0) f[d0] = __builtin_nontemporal_load((const bf16x8*)(ubase + (off + d0 * 16)));
}
__device__ __forceinline__ f32x16 qk_tile(const bf16x8 (&kf)[4], const bf16x8 (&qf)[4]) {
    f32x16 s = {};
#pragma unroll
    for (int d0 = 0; d0 < 4; ++d0) s = __builtin_amdgcn_mfma_f32_32x32x16_bf16(kf[d0], qf[d0], s, 0, 0, 0);
    return s;
}
__device__ __forceinline__ void v_load(u32x4 (&vr)[4], const bf16* ubase, unsigned rowstride, int lane) {
#pragma unroll
    for (int i = 0; i < 4; ++i) { const unsigned c = lane + 64 * i; vr[i] = *(const u32x4*)(ubase + ((c >> 3) * rowstride + (c & 7) * 8u)); }
}
__device__ __forceinline__ void v_stage(LAS unsigned char* vb, const u32x4 (&vr)[4], int lane) {
#pragma unroll
    for (int i = 0; i < 4; ++i) { const int c = lane + 64 * i, key = c >> 3, ch = c & 7; *(LAS u32x4*)(vb + key * 128 + ((ch * 16) ^ (((key >> 1) & 1) << 6))) = vr[i]; }
}
__device__ __forceinline__ void pv_tile(f32x16 (&o)[2], LAS unsigned char* vb, const f32x16& p, int lane) {
    const int hi = lane >> 5, g1 = (lane >> 4) & 1, q4 = (lane & 15) >> 2, pp = lane & 3;
    bf16x8 pf[2];
#pragma unroll
    for (int s = 0; s < 2; ++s) { u32x4 w; w.x = pk2(p[8 * s + 0], p[8 * s + 1]); w.y = pk2(p[8 * s + 2], p[8 * s + 3]); w.z = pk2(p[8 * s + 4], p[8 * s + 5]); w.w = pk2(p[8 * s + 6], p[8 * s + 7]);
        pf[s] = __builtin_bit_cast(bf16x8, w); }
    const int swz = ((q4 >> 1) & 1) << 6;
#pragma unroll
    for (int dblk = 0; dblk < 2; ++dblk)
#pragma unroll
        for (int s = 0; s < 2; ++s) {
            const int colb = (dblk * 64 + g1 * 32 + pp * 8) ^ swz;
            const int row0 = 16 * s + 4 * hi + q4;
            const s16x4 t0 = __builtin_bit_cast(s16x4, __builtin_amdgcn_ds_read_tr16_b64_v4i16((LAS s16x4*)(vb + row0 * 128 + colb)));
            const s16x4 t1 = __builtin_bit_cast(s16x4, __builtin_amdgcn_ds_read_tr16_b64_v4i16((LAS s16x4*)(vb + (row0 + 8) * 128 + colb)));
            const bf16x8 a = (bf16x8){t0[0], t0[1], t0[2], t0[3], t1[0], t1[1], t1[2], t1[3]};
            o[dblk] = __builtin_amdgcn_mfma_f32_32x32x16_bf16(a, pf[s], o[dblk], 0, 0, 0);
        }
}
__device__ __forceinline__ void store_ot(bf16* rowp, const f32x16 (&o)[2], float sc, int hi) {
#pragma unroll
    for (int dblk = 0; dblk < 2; ++dblk)
#pragma unroll
        for (int p = 0; p < 2; ++p) {
            const unsigned x0 = pk2(o[dblk][8 * p] * sc, o[dblk][8 * p + 1] * sc), x1 = pk2(o[dblk][8 * p + 2] * sc, o[dblk][8 * p + 3] * sc);
            const unsigned y0 = pk2(o[dblk][8 * p + 4] * sc, o[dblk][8 * p + 5] * sc), y1 = pk2(o[dblk][8 * p + 6] * sc, o[dblk][8 * p + 7] * sc);
            const auto s0 = __builtin_amdgcn_permlane32_swap(x0, y0, false, false), s1 = __builtin_amdgcn_permlane32_swap(x1, y1, false, false);
            u32x4 w; w.x = s0[0]; w.y = s1[0]; w.z = s0[1]; w.w = s1[1];
            *(u32x4*)(rowp + dblk * 32 + 16 * p + 8 * hi) = w; }
}
struct DilGeo { size_t rowb, kstride; int h12, dil, r, i0; };
__device__ __forceinline__ DilGeo dil_geo(int item) {
    DilGeo g; const int b = item / 1536, rem = item % 1536, ch = rem & 127; g.h12 = rem >> 7;
    const int gg = g.h12 >> 2, ncl = 7 - 2 * gg; g.dil = 1 << (2 * gg); g.r = ch >> ncl; g.i0 = 32 * (ch & ((1 << ncl) - 1));
    g.rowb = (size_t)b * SEQ; g.kstride = (size_t)g.dil * 64; return g;
}
__device__ __forceinline__ void dil_load_qk(const bf16* QKV, const DilGeo& g, bf16x8 (&qf)[4], bf16x8 (&kf)[5][4], int lane) {
    const int q = lane & 31, hi = lane >> 5;
    ld_frag4_nt(qf, QKV + ((size_t)g.h12 * M + g.rowb + (size_t)g.i0 * g.dil + g.r) * 64, (unsigned)g.kstride, lane);
#pragma unroll
    for (int kt = 0; kt < 5; ++kt) { const int ib = g.i0 - 128 + 32 * kt, ibc = ib < 0 ? 0 : ib; ld_frag4(kf[kt], QKV + ((size_t)(12 + g.h12) * M + g.rowb + (size_t)ibc * g.dil + g.r) * 64, (unsigned)g.kstride, lane); }
}
__device__ __forceinline__ void dil_vload(const bf16* QKV, const DilGeo& g, u32x4 (&vr)[4], int kt, int lane) {
    const int ib = g.i0 - 128 + 32 * kt, ibc = ib < 0 ? 0 : ib;
    v_load(vr, QKV + ((size_t)(24 + g.h12) * M + g.rowb + g.r) * 64 + (size_t)ibc * g.kstride, (unsigned)g.kstride, lane);
}
__device__ __forceinline__ void pv_tile_p(f32x16 (&o)[2], LAS unsigned char* vb, const bf16x8 (&pf)[2], int lane) {
    const int hi = lane >> 5, g1 = (lane >> 4) & 1, q4 = (lane & 15) >> 2, pp = lane & 3;
    const int swz = ((q4 >> 1) & 1) << 6;
#pragma unroll
    for (int dblk = 0; dblk < 2; ++dblk)
#pragma unroll
        for (int s = 0; s < 2; ++s) {
            const int colb = (dblk * 64 + g1 * 32 + pp * 8) ^ swz;
            const int row0 = 16 * s + 4 * hi + q4;
            const s16x4 t0 = __builtin_bit_cast(s16x4, __builtin_amdgcn_ds_read_tr16_b64_v4i16((LAS s16x4*)(vb + row0 * 128 + colb)));
            const s16x4 t1 = __builtin_bit_cast(s16x4, __builtin_amdgcn_ds_read_tr16_b64_v4i16((LAS s16x4*)(vb + (row0 + 8) * 128 + colb)));
            const bf16x8 a = (bf16x8){t0[0], t0[1], t0[2], t0[3], t1[0], t1[1], t1[2], t1[3]};
            o[dblk] = __builtin_amdgcn_mfma_f32_32x32x16_bf16(a, pf[s], o[dblk], 0, 0, 0);
        }
}
__device__ __forceinline__ void dil_items(const bf16* QKV, bf16* OD3, float* LSE, LAS unsigned char* vb, int first, int stride, int lane) {
    int it = first; if (it >= 6144) return;
    const int q = lane & 31, hi = lane >> 5;
    DilGeo g = dil_geo(__builtin_amdgcn_readfirstlane(it));
    for (;;) {
        bf16x8 qf[4], kf[5][4];
        dil_load_qk(QKV, g, qf, kf, lane);
        u32x4 vr[5][4];
#pragma unroll
        for (int kt = 0; kt < 5; ++kt) dil_vload(QKV, g, vr[kt], kt, lane);
        float mx = -INFINITY, l = 0.f;
        f32x16 s[5];
#pragma unroll
        for (int kt = 0; kt < 5; ++kt) {
            s[kt] = qk_tile(kf[kt], qf);
            if (g.i0 - 128 + 32 * kt < 0) {
#pragma unroll
                for (int rr = 0; rr < 16; ++rr) s[kt][rr] = -INFINITY;
            }
        }
#pragma unroll
        for (int rr = 0; rr < 16; ++rr) { const int kk = crow(rr, hi); if (kk < q) s[0][rr] = -INFINITY; if (kk > q) s[4][rr] = -INFINITY; }
#pragma unroll
        for (int kt = 0; kt < 5; ++kt)
#pragma unroll
            for (int rr = 0; rr < 16; ++rr) mx = fmaxf(mx, s[kt][rr]);
        { const F2 t = pair32(mx); mx = fmaxf(t.a, t.b); }
        const float mb = mx * LOG2E;
#define DIL_EXP_PACK(kt_, dst) do { _Pragma("unroll") for (int rr = 0; rr < 16; ++rr) { const float p = __builtin_amdgcn_exp2f(__builtin_fmaf(s[kt_][rr], LOG2E, -mb)); s[kt_][rr] = p; l += p; } \
        _Pragma("unroll") for (int h2 = 0; h2 < 2; ++h2) { u32x4 w; w.x = pk2(s[kt_][8 * h2 + 0], s[kt_][8 * h2 + 1]); w.y = pk2(s[kt_][8 * h2 + 2], s[kt_][8 * h2 + 3]); \
            w.z = pk2(s[kt_][8 * h2 + 4], s[kt_][8 * h2 + 5]); w.w = pk2(s[kt_][8 * h2 + 6], s[kt_][8 * h2 + 7]); dst[h2] = __builtin_bit_cast(bf16x8, w); } } while (0)
        bf16x8 pf[2][2];
        DIL_EXP_PACK(0, pf[0]);
        const int itn = it + stride; const bool more = itn < 6144;
        const DilGeo gn = dil_geo(__builtin_amdgcn_readfirstlane(more ? itn : it));
        f32x16 o[2]; o[0] = f32x16{}; o[1] = f32x16{};
#pragma unroll
        for (int kt = 0; kt < 5; ++kt) {
            LDS_WAIT();
            v_stage(vb, vr[kt], lane);
            LDS_WAIT();
            pv_tile_p(o, vb, pf[kt & 1], lane);
            if (kt + 1 < 5) DIL_EXP_PACK(kt + 1, pf[(kt + 1) & 1]);
        }
#undef DIL_EXP_PACK
        { const F2 t = pair32(l); l = t.a + t.b; }
        const float inv = 1.0f / l;
        const size_t tok = g.rowb + (size_t)(g.i0 + q) * g.dil + g.r;
        store_ot(OD3 + (g.rowb + (size_t)g.i0 * g.dil + g.r) * 768 + g.h12 * 64 + (unsigned)q * (unsigned)(g.dil * 768), o, inv, hi);
        if (hi == 0) LSE[tok * 12 + g.h12] = mx + __logf(l);
        if (!more) break;
        it = itn; g = gn;
    }
}
__device__ __forceinline__ void sb_step(f32x16 (&o)[2], float& R, const bf16x8 (&kf)[4], const bf16x8 (&qf)[4], const u32x4 (&vr)[4], LAS unsigned char* vb, int dq, int lane) {
    const int hi = lane >> 5;
    f32x16 z = qk_tile(kf, qf);
    float gp[4];
#pragma unroll
    for (int c4 = 0; c4 < 4; ++c4) {
        float be[4], ke[4];
#pragma unroll
        for (int i = 0; i < 4; ++i) { const float zz = z[4 * c4 + i]; const float e = __builtin_amdgcn_exp2f(-fabsf(zz) * LOG2E); const float rr = __builtin_amdgcn_rcpf(1.0f + e), sm = e * rr;
            const bool pos = zz >= 0.f; const bool past = (8 * c4 + 4 * hi + i) < dq;
            be[i] = past ? (pos ? rr : sm) : 0.f; ke[i] = past ? (pos ? sm : rr) : 1.f; }
        const float e2 = ke[3], e1 = e2 * ke[2], e0 = e1 * ke[1];
        gp[c4] = e0 * ke[0];
        z[4 * c4 + 3] = be[3]; z[4 * c4 + 2] = be[2] * e2; z[4 * c4 + 1] = be[1] * e1; z[4 * c4 + 0] = be[0] * e0;
    }
    float U = R;
#pragma unroll
    for (int c4 = 3; c4 >= 0; --c4) {
        const F2 t = pair32(gp[c4]);
        const float T = (hi == 0) ? U * t.b : U;
#pragma unroll
        for (int i = 0; i < 4; ++i) z[4 * c4 + i] *= T;
        U *= t.a * t.b;
    }
    R = U;
    LDS_WAIT();
    v_stage(vb, vr, lane);
    LDS_WAIT();
    pv_tile(o, vb, z, lane);
}
__device__ __forceinline__ void sb_item(const bf16* QKV, bf16* OS, LAS unsigned char* vb, int bh, int c, int lane) {
    const int b = bh >> 2, h = bh & 3, q = lane & 31, hi = lane >> 5;
    const size_t rowb = (size_t)b * SEQ;
    const bf16* Qp = QKV + ((size_t)(36 + h) * M + rowb + 32 * c) * 64;
    const bf16* Kb = QKV + ((size_t)(40 + h) * M + rowb) * 64;
    const bf16* Vb = QKV + ((size_t)(44 + h) * M + rowb) * 64;
    bf16x8 qf[4]; ld_frag4_nt(qf, Qp, 64, lane);
    f32x16 o[2]; o[0] = f32x16{}; o[1] = f32x16{};
    float R = 1.0f;
    bf16x8 kf[3][4]; u32x4 vr[3][4];
#pragma unroll
    for (int j = 0; j < 3; ++j) { const int t = (c - j) < 0 ? 0 : (c - j); ld_frag4(kf[j], Kb + (size_t)(32 * t) * 64, 64, lane); v_load(vr[j], Vb + (size_t)(32 * t) * 64, 64, lane); }
#if SB_EARLY_EXIT
#define SB_DONE() (__all(R < 1e-20f))
#else
#define SB_DONE() (false)
#endif
#define SB_STEP(j, kt_) do { sb_step(o, R, kf[j], qf, vr[j], vb, 32 * (c - (kt_)) + q, lane); \
        { const int t = (kt_) - 3 < 0 ? 0 : (kt_) - 3; ld_frag4(kf[j], Kb + (size_t)(32 * t) * 64, 64, lane); v_load(vr[j], Vb + (size_t)(32 * t) * 64, 64, lane); } } while (0)
    for (int kt = c; kt >= 0; kt -= 3) {
        SB_STEP(0, kt); if (kt - 1 < 0 || SB_DONE()) break;
        SB_STEP(1, kt - 1); if (kt - 2 < 0 || SB_DONE()) break;
        SB_STEP(2, kt - 2); if (SB_DONE()) break;
    }
#undef SB_STEP
#undef SB_DONE
    store_ot(OS + (rowb + 32 * c) * 256 + h * 64 + (unsigned)q * 256u, o, 1.0f, hi);
}
__device__ __forceinline__ void attn_phase(unsigned char* Pws, unsigned char* Pscr, LAS unsigned char* lds, int G, int wg, int NGW, int wave, int lane) {
    LAS unsigned char* vb = lds + wave * 4096;
    const bf16* QKV = (const bf16*)(Pws + WS_R);
    const int v = (G % 8 == 0) ? (wg % 8) * (G / 8) + wg / 8 : wg;
    const int base = v * NWAVES + wave;
    for (int it = base; it < 2048; it += NGW) { const int itu = __builtin_amdgcn_readfirstlane(it);
#if SB_EARLY_EXIT
        sb_item(QKV, (bf16*)(Pws + WS_OS), vb, itu >> 7, itu & 127, lane);
#else
        sb_item(QKV, (bf16*)(Pws + WS_OS), vb, itu >> 7, ((itu & 127) + 16 * (itu >> 8)) & 127, lane);
#endif
    }
    dil_items(QKV, (bf16*)(Pscr + OUT_OD3), (float*)(Pws + WS_LSE), vb, base, NGW, lane);
}
__device__ __forceinline__ void merge_phase(unsigned char* Pws, unsigned char* Pscr, int idx_lo, int idx_hi, int first, int stride) {
    const bf16* OD3 = (const bf16*)(Pscr + OUT_OD3); bf16* OD = (bf16*)(Pscr + OUT_OD); const float* LSE = (const float*)(Pws + WS_LSE);
    const __amdgpu_buffer_rsrc_t odr = __builtin_amdgcn_make_buffer_rsrc(OD, 0, M * 256 * 2, 0x00020000);
    for (int idx = idx_lo + first; idx < idx_hi; idx += stride) {
        const int t = idx >> 5, hh = (idx >> 3) & 3, ch = idx & 7;
        const float l0 = LSE[(size_t)t * 12 + hh], l1 = LSE[(size_t)t * 12 + 4 + hh], l2 = LSE[(size_t)t * 12 + 8 + hh];
        const float mx = fmaxf(l0, fmaxf(l1, l2)); float e0 = __expf(l0 - mx), e1 = __expf(l1 - mx), e2 = __expf(l2 - mx); const float inv = 1.0f / (e0 + e1 + e2);
        e0 *= inv; e1 *= inv; e2 *= inv;
        const u32x4 a = *(const u32x4*)(OD3 + (size_t)t * 768 + hh * 64 + ch * 8), bq = *(const u32x4*)(OD3 + (size_t)t * 768 + (4 + hh) * 64 + ch * 8), cq = *(const u32x4*)(OD3 + (size_t)t * 768 + (8 + hh) * 64 + ch * 8);
        u32x4 o;
#pragma unroll
        for (int k = 0; k < 4; ++k) {
            const float lo = e0 * __uint_as_float(a[k] << 16) + e1 * __uint_as_float(bq[k] << 16) + e2 * __uint_as_float(cq[k] << 16);
            const float hi = e0 * __uint_as_float(a[k] & 0xffff0000u) + e1 * __uint_as_float(bq[k] & 0xffff0000u) + e2 * __uint_as_float(cq[k] & 0xffff0000u);
            o[k] = pk2(lo, hi);
        }
        __builtin_amdgcn_raw_buffer_store_b128(o, odr, (unsigned)(t * 256 + hh * 64 + ch * 8) * 2u, 0,   16);
    }
}
__device__ __forceinline__ void merge_quarter(unsigned char* Pws, unsigned char* Pscr, int idx_lo, int tid) {
    const bf16* OD3 = (const bf16*)(Pscr + OUT_OD3); bf16* OD = (bf16*)(Pscr + OUT_OD); const float* LSE = (const float*)(Pws + WS_LSE);
    const __amdgpu_buffer_rsrc_t odr = __builtin_amdgcn_make_buffer_rsrc(OD, 0, M * 256 * 2, 0x00020000);
    float ls[4][3]; u32x4 v[4][3];
#pragma unroll
    for (int j = 0; j < 4; ++j) { const unsigned idx = (unsigned)(idx_lo + tid + 512 * j), t = idx >> 5, hh = (idx >> 3) & 3, ch = idx & 7;
#pragma unroll
        for (int g = 0; g < 3; ++g) { ls[j][g] = __builtin_nontemporal_load(LSE + (t * 12u + 4u * g + hh)); v[j][g] = __builtin_nontemporal_load((const u32x4*)(OD3 + (t * 768u + (4u * g + hh) * 64u + ch * 8u))); } }
#pragma unroll
    for (int j = 0; j < 4; ++j) { const unsigned idx = (unsigned)(idx_lo + tid + 512 * j), t = idx >> 5, hh = (idx >> 3) & 3, ch = idx & 7;
        const float mx = fmaxf(ls[j][0], fmaxf(ls[j][1], ls[j][2])); float e0 = __expf(ls[j][0] - mx), e1 = __expf(ls[j][1] - mx), e2 = __expf(ls[j][2] - mx); const float inv = 1.0f / (e0 + e1 + e2);
        e0 *= inv; e1 *= inv; e2 *= inv;
        u32x4 o;
#pragma unroll
        for (int k = 0; k < 4; ++k) {
            const float lo = e0 * __uint_as_float(v[j][0][k] << 16) + e1 * __uint_as_float(v[j][1][k] << 16) + e2 * __uint_as_float(v[j][2][k] << 16);
            const float hi = e0 * __uint_as_float(v[j][0][k] & 0xffff0000u) + e1 * __uint_as_float(v[j][1][k] & 0xffff0000u) + e2 * __uint_as_float(v[j][2][k] & 0xffff0000u);
            o[k] = pk2(lo, hi);
        }
        __builtin_amdgcn_raw_buffer_store_b128(o, odr, (t * 256u + hh * 64u + ch * 8u) * 2u, 0,   16); }
}
__device__ __forceinline__ void panel_arrive(unsigned* cnt, int pm, int wave, int lane) {
    asm volatile("s_waitcnt vmcnt(0)" ::: "memory");
    __syncthreads();
    if (wave == 0 && lane == 0) __hip_atomic_fetch_add(cnt + 64 * pm, 1u, __ATOMIC_RELAXED, __HIP_MEMORY_SCOPE_AGENT);
}
__device__ __forceinline__ void panel_sync(unsigned* cnt, int pm, int wave, int lane) {
    asm volatile("s_waitcnt vmcnt(0)" ::: "memory");
    __syncthreads();
    if (wave == 0) {
        if (lane == 0) __hip_atomic_fetch_add(cnt + 64 * pm, 1u, __ATOMIC_RELAXED, __HIP_MEMORY_SCOPE_AGENT);
        unsigned spins = 0;
        while ((unsigned)__builtin_amdgcn_readfirstlane(__hip_atomic_load(cnt + 64 * pm, __ATOMIC_RELAXED, __HIP_MEMORY_SCOPE_AGENT)) < 4u) { __builtin_amdgcn_s_sleep(1); if (++spins > (1u << 20)) break; }
        __builtin_amdgcn_fence(__ATOMIC_ACQUIRE, "agent"); }
    asm volatile("s_waitcnt vmcnt(0) lgkmcnt(0)" ::: "memory"); __syncthreads();
}
__device__ __forceinline__ void final_phase(unsigned char* Pws, float* Pout, const float* Pnf, int gw, int NGW, int lane) {
    const float* ssqp = (const float*)(Pws + WS_SSQ); const f32x4* gf = (const f32x4*)Pnf + 2 * lane; const bf16* xb = (const bf16*)(Pws + WS_XB);
    for (int m = gw; m < M; m += NGW) {
        const float rs = pg8::row_rstd(ssqp, m);
        const u32x4* xr = (const u32x4*)(xb + (size_t)m * D) + lane; f32x4* orow = (f32x4*)(Pout + (size_t)m * D) + 2 * lane;
#pragma unroll
        for (int j = 0; j < 2; ++j) { const u32x4 w = xr[64 * j];
            const f32x4 v0 = {__uint_as_float(w.x << 16), __uint_as_float(w.x & 0xffff0000u), __uint_as_float(w.y << 16), __uint_as_float(w.y & 0xffff0000u)};
            const f32x4 v1 = {__uint_as_float(w.z << 16), __uint_as_float(w.z & 0xffff0000u), __uint_as_float(w.w << 16), __uint_as_float(w.w & 0xffff0000u)};
            orow[128 * j] = v0 * rs * gf[128 * j]; orow[128 * j + 1] = v1 * rs * gf[128 * j + 1]; }
    }
}

struct Args { const float* in[15]; float* out; unsigned char* ws; int ph_lo, ph_hi; };
constexpr int N_PHASES = 10 * DEPTH + 1;
__global__ void __launch_bounds__(NWAVES * 64, 2) fwd_megakernel(Args args) {
    extern __shared__ __attribute__((aligned(16))) unsigned char lds_raw[];
    LAS unsigned char* lds = (LAS unsigned char*)lds_raw;
    cg::grid_group grid = cg::this_grid();
    volatile LAS unsigned* bst = (volatile LAS unsigned*)(lds + 131072);
    if (threadIdx.x < 2) bst[threadIdx.x] = 0u;
    __syncthreads();
    (void)xcd_barrier_post((unsigned*)(args.ws + WS_BAR), bst);
    for (int ph = args.ph_lo; ph < args.ph_hi; ++ph) {
        const __attribute__((address_space(4))) unsigned char* ka = (const __attribute__((address_space(4))) unsigned char*)__builtin_amdgcn_kernarg_segment_ptr();
        asm volatile("" : "+s"(ka));
#define KARG(i) (*(const float* const __attribute__((address_space(4)))*)(ka + 8 * (i)))
        const float* Px = KARG(0); float* Pout = (float*)KARG(15); unsigned char* ws = (unsigned char*)KARG(16);
        int tid = threadIdx.x, G = gridDim.x, wg = blockIdx.x; asm volatile("" : "+v"(tid), "+s"(G), "+s"(wg));
        const int lane = tid & 63, wave = __builtin_amdgcn_readfirstlane(tid >> 6);
        const int gw = wave * G + wg, NGW = G * NWAVES;
        const int gtid = wg * (NWAVES * 64) + tid, NT = G * NWAVES * 64;
        unsigned char* wsw = ws + WS_W;
        float* ssqp = (float*)(ws + WS_SSQ);
        bf16* XB = (bf16*)(ws + WS_XB); bf16* H = (bf16*)(ws + WS_R); bf16* QKV = (bf16*)(ws + WS_R); bf16* GATE = (bf16*)(ws + WS_GATE);
        const int l = ph / 10, k = (ph == N_PHASES - 1) ? 10 : ph % 10;
        const bool fuse_final = (G == 256);
        if (k == 10 && fuse_final) continue;
        const bool chain = (G == 256);
        if ((k == 6 || k == 7) && chain) continue;
        if (k == 0 && l > 0) continue;
        unsigned char* dA1 = (unsigned char*)Pout + 32 * MiB;
        unsigned char* wA = (l == 0) ? wsw : dA1;
        if (k == 0) {
            { const ConvSrc CS{KARG(1), KARG(2), KARG(3), KARG(4), KARG(5), KARG(6), KARG(7), KARG(8), KARG(9), KARG(10), KARG(11), KARG(12), KARG(13)}; conv_phase(Px, CS, ws, l, lds, gw, NGW, wave, lane); }
        }
        else if (k == 1 || k == 8) {
            pg8::Gemm g{XB, (const bf16*)(k == 1 ? wA + W_1CAT : wsw + W_2CAT), M, 2 * FF, D}; pg8::StaticOrder S; S.init(M, 2 * FF, G, wg);
            { const LAS float* rsl_c = (const LAS float*)(lds + RSL_OFF); LAS float* rsl_w = (LAS float*)(lds + RSL_OFF); pg8::Unit uu;
#pragma unroll 1
              for (int i = 0; i < pg8::RSL_UNITS; ++i) if (S.next(i, uu) && tid < 256) rsl_w[i * 256 + tid] = pg8::row_rstd(ssqp, uu.pm * 256 + tid);
              __syncthreads(); (void)rsl_c; }
            pg8::EpiSwiglu E{H, ssqp, (const LAS float*)(lds + RSL_OFF)};
            pg8::gemm_phase<pg8::EpiSwiglu, pg8::StaticOrder, true, true>(lds, g, S, E);
            if ((l == 0) || (k == 1)) {
                const int rem = ((M / 256) * (2 * FF / 256)) % G; const bool idle = (rem == 0) || (wg >= rem);
                if (idle) {
                    const int nidle = (rem == 0) ? G : G - rem, iw = (rem == 0) ? wg : wg - rem;
                    const ConvSrc CS{KARG(1), KARG(2), KARG(3), KARG(4), KARG(5), KARG(6), KARG(7), KARG(8), KARG(9), KARG(10), KARG(11), KARG(12), KARG(13)};
                    const int lo = (l == 0) ? (k == 1 ? 0 : CI_IN) : CI_B, hi = (l == 0) ? (k == 1 ? CI_IN : CI_B) : CI_END;
                    conv_items(CS, 1, lo, hi, dA1, wsw, lds, wave * nidle + iw, nidle * NWAVES, wave, lane);
                }
            }
        } else if (k == 2 || k == 9) {
            pg8::Gemm g{H, (const bf16*)(k == 2 ? wA + W_D1 : wsw + W_D2), M, D, FF}; pg8::StaticOrder S; S.init(M, D, G, wg);
            if (ph == 2) { pg8::EpiResid<true> E{Px, XB, ssqp, 0.5f}; pg8::gemm_phase<pg8::EpiResid<true>, pg8::StaticOrder, true, true>(lds, g, S, E); }
            else if (ph == N_PHASES - 2 && fuse_final) { pg8::EpiResidFinal E{XB, Pout, KARG(14), (unsigned*)(ws + WS_XSLOT), (unsigned*)(ws + WS_CNT), 0.5f};
                pg8::gemm_phase<pg8::EpiResidFinal, pg8::StaticOrder, true, true>(lds, g, S, E); }
            else { pg8::EpiResid<false> E{nullptr, XB, ssqp, 0.5f}; pg8::gemm_phase<pg8::EpiResid<false>, pg8::StaticOrder, true, true>(lds, g, S, E); }
        } else if (k == 3) {
            pg8::Gemm g{XB, (const bf16*)(wA + W_IN), M, NIN, D}; pg8::StaticOrder S; S.init(M, NIN, G, wg);
            { const LAS float* rsl_c = (const LAS float*)(lds + RSL_OFF); LAS float* rsl_w = (LAS float*)(lds + RSL_OFF); pg8::Unit uu;
#pragma unroll 1
              for (int i = 0; i < pg8::RSL_UNITS; ++i) if (S.next(i, uu) && tid < 256) rsl_w[i * 256 + tid] = pg8::row_rstd(ssqp, uu.pm * 256 + tid);
              __syncthreads(); (void)rsl_c; }
            pg8::EpiWin E{QKV, GATE, ssqp, (const float*)(ws + WS_ROPE), (const LAS float*)(lds + RSL_OFF)};
            pg8::gemm_phase<pg8::EpiWin, pg8::StaticOrder, true, true>(lds, g, S, E);
        } else if (k == 4) {
            attn_phase(ws, (unsigned char*)Pout, lds, G, wg, NGW, wave, lane);
        }
        else if (k == 5) {
            pg8::Unit pu; { pg8::StaticOrder S; S.init(M, D, G, wg); S.next(0, pu); }
            unsigned* pcnt = (unsigned*)(ws + WS_PCNT) + (size_t)l * 2 * 4096;
            if (chain) { const int r0 = pu.pm * 256 + pu.pn * 64; merge_quarter(ws, (unsigned char*)Pout, r0 * 32, tid); panel_arrive(pcnt, pu.pm, wave, lane); }
            else merge_phase(ws, (unsigned char*)Pout, 0, M * 32, gtid, NT);
            if (chain) {
                int K256 = 256; asm volatile("" : "+s"(K256));
                { pg8::Gemm g{(const bf16*)(ws + WS_OS), (const bf16*)(wsw + W_PS), M, D, K256, (const bf16*)((unsigned char*)Pout + OUT_OD), (const bf16*)(wsw + W_PD)}; pg8::PairOrder S; S.init(M, D, G, wg); S.cnt = pcnt;
                  pg8::EpiGate2 E{GATE, (bf16*)(ws + WS_Y1), (bf16*)(ws + WS_Y)};
                  pg8::gemm_phase<pg8::EpiGate2, pg8::PairOrder, true, true>(lds, g, S, E); }
                panel_sync(pcnt + 4096, pu.pm, wave, lane);
                { pg8::Gemm g{(const bf16*)(ws + WS_Y), (const bf16*)(wsw + W_OUT), M, D, D}; pg8::StaticOrder S; S.init(M, D, G, wg);
                  pg8::EpiResid<false> E{nullptr, XB, ssqp, 1.0f};
                  pg8::gemm_phase<pg8::EpiResid<false>, pg8::StaticOrder, true, true>(lds, g, S, E); }
            }
        }
        else if (k == 6) {
            int K256 = 256; asm volatile("" : "+s"(K256));
            { pg8::Gemm g{(const bf16*)((unsigned char*)Pout + OUT_OD), (const bf16*)(wsw + W_PD), M, D, K256}; pg8::StaticOrder S; S.init(M, D, G, wg);
              pg8::EpiGate<false> E{GATE, (bf16*)(ws + WS_Y1), (bf16*)(ws + WS_Y)};
              pg8::gemm_phase<pg8::EpiGate<false>, pg8::StaticOrder, true, true>(lds, g, S, E); }
            { pg8::Gemm g{(const bf16*)(ws + WS_OS), (const bf16*)(wsw + W_PS), M, D, K256}; pg8::StaticOrder S; S.init(M, D, G, wg);
              pg8::EpiGate<true> E{GATE + 1024, (bf16*)(ws + WS_Y1), (bf16*)(ws + WS_Y)};
              pg8::gemm_phase<pg8::EpiGate<true>, pg8::StaticOrder, true, true>(lds, g, S, E); }
        } else if (k == 7) {
            pg8::Gemm g{(const bf16*)(ws + WS_Y), (const bf16*)(wsw + W_OUT), M, D, D}; pg8::StaticOrder S; S.init(M, D, G, wg);
            pg8::EpiResid<false> E{nullptr, XB, ssqp, 1.0f};
            pg8::gemm_phase<pg8::EpiResid<false>, pg8::StaticOrder, true, true>(lds, g, S, E);
        } else final_phase(ws, Pout, KARG(14), gw, NGW, lane);
        if (ph + 1 < args.ph_hi && !(fuse_final && ph == N_PHASES - 2)) {
            unsigned* barw = (unsigned*)(ws + WS_BAR);
            if (args.ph_hi > 1000) grid.sync();
            { XcdBarrier bar; bar.bar = barw; bar.x = xb_xcc_id(); bar.st = bst; xcd_barrier(bar);
            }
        }
    }
}

extern "C" void kernel_launch(void* const* d_in, const int* in_sizes, int n_in, void* d_out, int out_size, void* d_ws, size_t ws_size, hipStream_t stream) {
    static int grid = 0;
    if (grid == 0) {
        if (n_in != 15 || in_sizes[0] != M * D || out_size != M * D || ws_size < WS_END) { fprintf(stderr, "kernel_launch: unexpected shapes (n_in %d, in0 %d, out %d, ws %zu)\n", n_in, n_in > 0 ? in_sizes[0] : -1, out_size, ws_size); grid = -1; return; }
        int dev = 0, cus = 0, per_cu = 0;
        if (hipGetDevice(&dev) != hipSuccess || hipDeviceGetAttribute(&cus, hipDeviceAttributeMultiprocessorCount, dev) != hipSuccess) { grid = -1; return; }
        if (hipFuncSetAttribute((const void*)fwd_megakernel, hipFuncAttributeMaxDynamicSharedMemorySize, LDS_BYTES) != hipSuccess) { fprintf(stderr, "kernel_launch: hipFuncSetAttribute failed\n"); grid = -1; return; }
        if (hipOccupancyMaxActiveBlocksPerMultiprocessor(&per_cu, (const void*)fwd_megakernel, NWAVES * 64, LDS_BYTES) != hipSuccess || per_cu < 1) { fprintf(stderr, "kernel_launch: occupancy query says %d\n", per_cu); per_cu = 1; }
        (void)hipGetLastError();
        grid = cus;
        if (grid < 176) { fprintf(stderr, "kernel_launch: %d CUs: the per-workgroup rstd table holds 8 units per GEMM phase (needs >= 176 workgroups)\n", grid); grid = -1; return; }
    }
    if (grid < 0) return;
    Args a{};
    for (int i = 0; i < 15; ++i) a.in[i] = (const float*)d_in[i];
    a.out = (float*)d_out; a.ws = (unsigned char*)d_ws;
#if N_LAUNCH_MODE == 0
    a.ph_lo = 0; a.ph_hi = N_PHASES;
    if (hipMemsetAsync((char*)d_ws + WS_BAR, 0, WS_ZERO_BYTES, stream) != hipSuccess) { fprintf(stderr, "kernel_launch: memset of the barrier words failed\n"); return; }
    void* kargs[] = {&a};
    const hipError_t e = hipLaunchCooperativeKernel((const void*)fwd_megakernel, dim3(grid), dim3(NWAVES * 64), kargs, LDS_BYTES, stream);
    if (e != hipSuccess) fprintf(stderr, "kernel_launch: cooperative launch failed: %s (grid %d)\n", hipGetErrorString(e), grid);
#else
    for (int ph = 0; ph < N_PHASES; ++ph) {
        a.ph_lo = ph; a.ph_hi = ph + 1;
        hipLaunchKernelGGL(fwd_megakernel, dim3(grid), dim3(NWAVES * 64), LDS_BYTES, stream, a);
    }
#endif
}
```

```cpp
#include <hip/hip_runtime.h>
#include <hip/hip_cooperative_groups.h>
#include <cstdio>
#include <cstdint>
namespace cg = cooperative_groups;
namespace pg8 {
#define PG8_LAS __attribute__((address_space(3)))
typedef unsigned short bf16_t;
typedef short bf16x8 __attribute__((ext_vector_type(8)));
typedef float f32x4 __attribute__((ext_vector_type(4)));
typedef unsigned u32x4 __attribute__((ext_vector_type(4)));
constexpr int BM = 256, BK = 64, HALF = 128, HTB = HALF * BK * 2  , STAGE_BYTES = 8 * HTB, NXCD = 8, WGM = 8;

__host__ __device__ __forceinline__ int lds_byte(int r, int c) { const int st = (r >> 4) * 2 + (c >> 5), rr = r & 15, cc = c & 31, ob = rr * 64 + cc * 2; return st * 1024 + (ob ^ (((ob >> 9) & 1) << 5)); }
__host__ __device__ __forceinline__ void stage_rc(int b, int& R, int& C) { const int st = b / 1024, sb = b % 1024, swz = sb ^ (((sb >> 9) & 1) << 5); R = (st >> 1) * 16 + swz / 64; C = (st & 1) * 32 + (swz % 64) / 2; }
__host__ __device__ __forceinline__ int perm32(int rho) { const int n = rho >> 4, i = rho & 15; return 8 * (i >> 2) + 4 * n + (i & 3); }

struct Unit { int pm, pn, ui, sel; };
struct Gemm { const bf16_t* A; const bf16_t* Bt; int M, N, K; const bf16_t* A2 = nullptr; const bf16_t* Bt2 = nullptr; };

struct StaticOrder {
    int nM, nN, nwg, G, c;
    __host__ __device__ void init(int M, int N, int G_, int c_) { nM = M / BM; nN = N / BM; nwg = nM * nN; G = G_; c = c_; }
    __host__ __device__ bool next(int i, Unit& u) const {
        const long L = (long)i * G + c; if (L >= nwg) return false;
        int wgid = (int)L; { const int q = nwg / NXCD, r = nwg % NXCD, xcd = wgid % NXCD, off = wgid / NXCD; wgid = (xcd < r ? xcd * (q + 1) : r * (q + 1) + (xcd - r) * q) + off; }
        const int nig = WGM * nN, gid = wgid / nig, fm = gid * WGM, gsz = (nM - fm) < WGM ? (nM - fm) : WGM;
        u.pm = fm + ((wgid % nig) % gsz); u.pn = (wgid % nig) / gsz; u.ui = i; u.sel = 0; return true;
    }
    __device__ __forceinline__ void a_ready(const Unit&) const {}
    __device__ __forceinline__ void done(const Unit&) const {}
};
struct PairOrder : StaticOrder {
    unsigned* cnt;
    __host__ __device__ bool next(int i, Unit& u) const { if (i >= 2) return false; if (!StaticOrder::next(0, u)) return false; u.ui = i; u.sel = i; return true; }
    __device__ __forceinline__ void a_ready(const Unit& u) const {
        if (u.sel == 1 && cnt != nullptr) {
            if (threadIdx.x < 64) { unsigned spins = 0;
                while ((unsigned)__builtin_amdgcn_readfirstlane(__hip_atomic_load(cnt + 64 * u.pm, __ATOMIC_RELAXED, __HIP_MEMORY_SCOPE_AGENT)) < 4u) { __builtin_amdgcn_s_sleep(1); if (++spins > (1u << 20)) break; }
                __builtin_amdgcn_fence(__ATOMIC_ACQUIRE, "agent");
                asm volatile("s_waitcnt vmcnt(0)" ::: "memory"); }
            asm volatile("" ::: "memory"); __builtin_amdgcn_s_barrier(); asm volatile("" ::: "memory");
        }
    }
};

typedef float f32x2_cv __attribute__((ext_vector_type(2))); typedef __bf16 bf16x2_cv __attribute__((ext_vector_type(2)));
__device__ __forceinline__ unsigned cvt_pk_bf16(float lo, float hi) { const f32x2_cv v = {lo, hi}; const bf16x2_cv b = __builtin_convertvector(v, bf16x2_cv); return __builtin_bit_cast(unsigned, b); }
typedef unsigned u32x2 __attribute__((ext_vector_type(2)));
constexpr float LOG2E = 1.4426950408889634f;
constexpr int RSL_UNITS = 8;
__device__ __forceinline__ float row_rstd(const float* ssqp, int r) {
    const f32x4* p = (const f32x4*)(ssqp + (size_t)r * 16);
    const f32x4 a = p[0], b = p[1], c = p[2], d = p[3];
    const float s = (((a[0] + a[1]) + (a[2] + a[3])) + ((b[0] + b[1]) + (b[2] + b[3]))) + (((c[0] + c[1]) + (c[2] + c[3])) + ((d[0] + d[1]) + (d[2] + d[3])));
    return __builtin_amdgcn_rsqf(s * (1.0f / 1024.0f) + 1e-6f);
}
__device__ __forceinline__ float bf2f(unsigned short b) { return __uint_as_float(((unsigned)b) << 16); }
struct EpiSwiglu {
    static constexpr bool PERM = true, AFTER_DRAIN = false, HAS_INIT = false;
    bf16_t* H; const float* ssqp; const PG8_LAS float* rsl;
    __device__ __forceinline__ void operator()(const f32x4 (&acc)[2][2][4][2], const Unit& u, int wr, int wc, int fr, int fq) const {
        const int row0 = u.pm * BM + wr * 64 + fr, col0 = u.pn * 128 + wc * 32 + 8 * fq;
#pragma unroll
        for (int ai = 0; ai < 2; ++ai)
#pragma unroll
            for (int m = 0; m < 4; ++m) {
                const int r = row0 + ai * HALF + m * 16; const float rs = rsl[u.ui * 256 + ai * HALF + wr * 64 + m * 16 + fr];
                const float nrl = -rs * LOG2E, rs2 = rs * rs; f32x4 hq[2];
#pragma unroll
                for (int n = 0; n < 2; ++n) { const f32x4 ga = acc[ai][0][m][n], ua = acc[ai][1][m][n]; const f32x4 x = ga * nrl; f32x4 e;
                    e[0] = __builtin_amdgcn_exp2f(x[0]); e[1] = __builtin_amdgcn_exp2f(x[1]); e[2] = __builtin_amdgcn_exp2f(x[2]); e[3] = __builtin_amdgcn_exp2f(x[3]);
                    const f32x4 d = e + 1.0f; f32x4 rc; rc[0] = __builtin_amdgcn_rcpf(d[0]); rc[1] = __builtin_amdgcn_rcpf(d[1]); rc[2] = __builtin_amdgcn_rcpf(d[2]); rc[3] = __builtin_amdgcn_rcpf(d[3]);
                    hq[n] = (ga * ua) * (rc * rs2); }
                u32x4 w; w.x = cvt_pk_bf16(hq[0][0], hq[0][1]); w.y = cvt_pk_bf16(hq[0][2], hq[0][3]); w.z = cvt_pk_bf16(hq[1][0], hq[1][1]); w.w = cvt_pk_bf16(hq[1][2], hq[1][3]);
                *(u32x4*)(H + ((unsigned)r * 2816u + (unsigned)col0)) = w;
            }
    }
};
template <bool BASE32> struct EpiResid {
    static constexpr bool PERM = true, AFTER_DRAIN = false, HAS_INIT = true;
    const float* base32; bf16_t* xb; float* ssqp; float alpha;
    __device__ __forceinline__ void init(f32x4 (&acc)[2][2][4][2], const Unit& u, int wr, int wc, int fr, int fq) const {
        const unsigned row0 = u.pm * BM + wr * 64 + fr, col0 = u.pn * BM + wc * 32 + 8 * fq; const float ia = 1.0f / alpha;
#pragma unroll
        for (int ai = 0; ai < 2; ++ai)
#pragma unroll
            for (int m = 0; m < 4; ++m)
#pragma unroll
                for (int bj = 0; bj < 2; ++bj) { const unsigned off = (row0 + ai * HALF + m * 16) * 1024u + col0 + bj * HALF;
                    f32x4 b0, b1;
                    if (BASE32) { b0 = __builtin_nontemporal_load((const f32x4*)(base32 + off)); b1 = __builtin_nontemporal_load((const f32x4*)(base32 + off + 4)); }
                    else { const u32x4 bw = __builtin_nontemporal_load((const u32x4*)(xb + off));
                        b0[0] = __uint_as_float(bw.x << 16); b0[1] = __uint_as_float(bw.x & 0xffff0000u); b0[2] = __uint_as_float(bw.y << 16); b0[3] = __uint_as_float(bw.y & 0xffff0000u);
                        b1[0] = __uint_as_float(bw.z << 16); b1[1] = __uint_as_float(bw.z & 0xffff0000u); b1[2] = __uint_as_float(bw.w << 16); b1[3] = __uint_as_float(bw.w & 0xffff0000u); }
                    acc[ai][bj][m][0] = b0 * ia; acc[ai][bj][m][1] = b1 * ia; }
    }
    __device__ __forceinline__ void operator()(const f32x4 (&acc)[2][2][4][2], const Unit& u, int wr, int wc, int fr, int fq) const {
        const unsigned row0 = u.pm * BM + wr * 64 + fr, col0 = u.pn * BM + wc * 32 + 8 * fq;
#pragma unroll
        for (int ai = 0; ai < 2; ++ai)
#pragma unroll
            for (int m = 0; m < 4; ++m) {
                const unsigned r = row0 + ai * HALF + m * 16; float s = 0.f;
#pragma unroll
                for (int bj = 0; bj < 2; ++bj) { const unsigned off = r * 1024u + col0 + bj * HALF;
                    const f32x4 o0 = acc[ai][bj][m][0] * alpha, o1 = acc[ai][bj][m][1] * alpha;
                    u32x4 w; w.x = cvt_pk_bf16(o0[0], o0[1]); w.y = cvt_pk_bf16(o0[2], o0[3]); w.z = cvt_pk_bf16(o1[0], o1[1]); w.w = cvt_pk_bf16(o1[2], o1[3]);
                    *(u32x4*)(xb + off) = w;
                    f32x4 q0, q1;
                    q0[0] = __uint_as_float(w.x << 16); q0[1] = __uint_as_float(w.x & 0xffff0000u); q0[2] = __uint_as_float(w.y << 16); q0[3] = __uint_as_float(w.y & 0xffff0000u);
                    q1[0] = __uint_as_float(w.z << 16); q1[1] = __uint_as_float(w.z & 0xffff0000u); q1[2] = __uint_as_float(w.w << 16); q1[3] = __uint_as_float(w.w & 0xffff0000u);
                    const f32x4 sq = q0 * q0 + q1 * q1; s += (sq[0] + sq[1]) + (sq[2] + sq[3]); }
                { const auto t16 = __builtin_amdgcn_permlane16_swap(__float_as_uint(s), __float_as_uint(s), false, false); s = __uint_as_float(t16[0]) + __uint_as_float(t16[1]);
                  const auto t32 = __builtin_amdgcn_permlane32_swap(__float_as_uint(s), __float_as_uint(s), false, false); s = __uint_as_float(t32[0]) + __uint_as_float(t32[1]); }
                if (fq == 0) ssqp[r * 16u + u.pn * 4 + wc] = s;
            }
    }
};
struct EpiResidFinal {
    static constexpr bool PERM = true, AFTER_DRAIN = true, HAS_INIT = true;
    const bf16_t* xb; float* out; const float* gain; unsigned* xslot; unsigned* cnt; float alpha;
    __device__ __forceinline__ void init(f32x4 (&acc)[2][2][4][2], const Unit& u, int wr, int wc, int fr, int fq) const {
        const unsigned row0 = u.pm * BM + wr * 64 + fr, col0 = u.pn * BM + wc * 32 + 8 * fq; const float ia = 1.0f / alpha;
#pragma unroll
        for (int ai = 0; ai < 2; ++ai)
#pragma unroll
            for (int m = 0; m < 4; ++m)
#pragma unroll
                for (int bj = 0; bj < 2; ++bj) { const unsigned off = (row0 + ai * HALF + m * 16) * 1024u + col0 + bj * HALF; const u32x4 bw = __builtin_nontemporal_load((const u32x4*)(xb + off)); f32x4 b0, b1;
                    b0[0] = __uint_as_float(bw.x << 16); b0[1] = __uint_as_float(bw.x & 0xffff0000u); b0[2] = __uint_as_float(bw.y << 16); b0[3] = __uint_as_float(bw.y & 0xffff0000u);
                    b1[0] = __uint_as_float(bw.z << 16); b1[1] = __uint_as_float(bw.z & 0xffff0000u); b1[2] = __uint_as_float(bw.w << 16); b1[3] = __uint_as_float(bw.w & 0xffff0000u);
                    acc[ai][bj][m][0] = b0 * ia; acc[ai][bj][m][1] = b1 * ia; }
    }
    __device__ __forceinline__ void fused(f32x4 (&acc)[2][2][4][2], const Unit& u, int wr, int wc, int fr, int fq, PG8_LAS unsigned char* lds, int wid, int lane) const {
        PG8_LAS float* P = (PG8_LAS float*)lds;
        PG8_LAS float* S = (PG8_LAS float*)(lds + 4096);
        const int tid = wid * 64 + lane;
#pragma unroll
        for (int ai = 0; ai < 2; ++ai)
#pragma unroll
            for (int m = 0; m < 4; ++m) { float s = 0.f;
#pragma unroll
                for (int bj = 0; bj < 2; ++bj)
#pragma unroll
                    for (int n = 0; n < 2; ++n) { const f32x4 o = acc[ai][bj][m][n] * alpha; acc[ai][bj][m][n] = o; const f32x4 q = o * o; s += (q[0] + q[1]) + (q[2] + q[3]); }
                { const auto t16 = __builtin_amdgcn_permlane16_swap(__float_as_uint(s), __float_as_uint(s), false, false); s = __uint_as_float(t16[0]) + __uint_as_float(t16[1]);
                  const auto t32 = __builtin_amdgcn_permlane32_swap(__float_as_uint(s), __float_as_uint(s), false, false); s = __uint_as_float(t32[0]) + __uint_as_float(t32[1]); }
                if (fq == 0) P[(ai * HALF + wr * 64 + m * 16 + fr) * 4 + wc] = s; }
        asm volatile("s_waitcnt lgkmcnt(0)" ::: "memory"); __builtin_amdgcn_s_barrier(); asm volatile("" ::: "memory");
        if (tid < 256) { const float t = (P[tid * 4 + 0] + P[tid * 4 + 1]) + (P[tid * 4 + 2] + P[tid * 4 + 3]);
            __hip_atomic_store(xslot + ((size_t)(u.pm * BM + tid) * 4 + u.pn), __float_as_uint(t), __ATOMIC_RELAXED, __HIP_MEMORY_SCOPE_AGENT); }
        asm volatile("s_waitcnt vmcnt(0)" ::: "memory");
        if (lane == 0) __hip_atomic_fetch_add(cnt + 64 * u.pm, 1u, __ATOMIC_RELAXED, __HIP_MEMORY_SCOPE_AGENT);
        if (wid == 0) { unsigned spins = 0;
            while ((unsigned)__builtin_amdgcn_readfirstlane(__hip_atomic_load(cnt + 64 * u.pm, __ATOMIC_RELAXED, __HIP_MEMORY_SCOPE_AGENT)) < 32u) { __builtin_amdgcn_s_sleep(2); if (++spins > (1u << 20)) break; }
            __builtin_amdgcn_fence(__ATOMIC_ACQUIRE, "agent"); }
        asm volatile("s_waitcnt vmcnt(0) lgkmcnt(0)" ::: "memory"); __builtin_amdgcn_s_barrier(); asm volatile("" ::: "memory");
        if (tid < 256) { const unsigned* sl = xslot + (size_t)(u.pm * BM + tid) * 4; float t = 0.f;
#pragma unroll
            for (int k = 0; k < 4; ++k) t += __uint_as_float(__hip_atomic_load(sl + k, __ATOMIC_RELAXED, __HIP_MEMORY_SCOPE_AGENT));
            S[tid] = __builtin_amdgcn_rsqf(t * (1.0f / 1024.0f) + 1e-6f); }
        asm volatile("s_waitcnt vmcnt(0) lgkmcnt(0)" ::: "memory"); __builtin_amdgcn_s_barrier(); asm volatile("" ::: "memory");
        const unsigned row0 = u.pm * BM + wr * 64 + fr, col0 = u.pn * BM + wc * 32 + 8 * fq;
        f32x4 gv[2][2];
#pragma unroll
        for (int bj = 0; bj < 2; ++bj) { gv[bj][0] = *(const f32x4*)(gain + col0 + bj * HALF); gv[bj][1] = *(const f32x4*)(gain + col0 + bj * HALF + 4); }
#pragma unroll
        for (int ai = 0; ai < 2; ++ai)
#pragma unroll
            for (int m = 0; m < 4; ++m) { const float rs = S[ai * HALF + wr * 64 + m * 16 + fr]; const unsigned r = row0 + ai * HALF + m * 16;
#pragma unroll
                for (int bj = 0; bj < 2; ++bj) { float* op = out + (r * 1024u + col0 + bj * HALF);
                    *(f32x4*)op = acc[ai][bj][m][0] * rs * gv[bj][0]; *(f32x4*)(op + 4) = acc[ai][bj][m][1] * rs * gv[bj][1]; } }
    }
};
struct EpiWin {
    static constexpr bool PERM = true, AFTER_DRAIN = false, HAS_INIT = false;
    bf16_t* QKV; bf16_t* GATE; const float* ssqp; const float* rope; const PG8_LAS float* rsl;
    __device__ __forceinline__ void operator()(const f32x4 (&acc)[2][2][4][2], const Unit& u, int wr, int wc, int fr, int fq) const {
        const int row0 = u.pm * BM + wr * 64 + fr; const int pn = u.pn; const bool isgate = pn >= 12;
        const bool dorope = (pn < 6) && ((wc & 1) == 0) && (fq < 2); const float qs = (pn < 3 || pn == 9) ? 0.125f : 1.0f;
#pragma unroll
        for (int ai = 0; ai < 2; ++ai)
#pragma unroll
            for (int m = 0; m < 4; ++m) {
                const int r = row0 + ai * HALF + m * 16; const float rs = rsl[u.ui * 256 + ai * HALF + wr * 64 + m * 16 + fr]; const int t = r & 4095;
#pragma unroll
                for (int bj = 0; bj < 2; ++bj) {
                    const int colt = bj * HALF + wc * 32 + 8 * fq; float v[8];
#pragma unroll
                    for (int n = 0; n < 2; ++n)
#pragma unroll
                        for (int j = 0; j < 4; ++j) v[n * 4 + j] = acc[ai][bj][m][n][j] * rs;
                    bf16_t* dst;
                    if (isgate) {
#pragma unroll
                        for (int i = 0; i < 8; ++i) v[i] = __builtin_amdgcn_rcpf(1.0f + __builtin_amdgcn_exp2f(-v[i] * LOG2E));
                        dst = GATE + ((unsigned)r * 2048u + (unsigned)((pn - 12) * 256 + colt));
                    } else {
                        if (dorope) {
                            const f32x4* cs = (const f32x4*)(rope + ((unsigned)t * 16u + 8u * (unsigned)fq));
                            const f32x4 c01 = cs[0], c23 = cs[1];
                            { const float x1 = v[0], x2 = v[1]; v[0] = x1 * c01[0] - x2 * c01[1]; v[1] = x2 * c01[0] + x1 * c01[1]; }
                            { const float x1 = v[2], x2 = v[3]; v[2] = x1 * c01[2] - x2 * c01[3]; v[3] = x2 * c01[2] + x1 * c01[3]; }
                            { const float x1 = v[4], x2 = v[5]; v[4] = x1 * c23[0] - x2 * c23[1]; v[5] = x2 * c23[0] + x1 * c23[1]; }
                            { const float x1 = v[6], x2 = v[7]; v[6] = x1 * c23[2] - x2 * c23[3]; v[7] = x2 * c23[2] + x1 * c23[3]; }
                        }
#pragma unroll
                        for (int i = 0; i < 8; ++i) v[i] *= qs;
                        { const unsigned cc = (unsigned)(pn * 256 + colt); dst = QKV + (((cc >> 6) * 16384u + (unsigned)r) * 64u + (cc & 63u)); }
                    }
                    u32x4 w; w.x = cvt_pk_bf16(v[0], v[1]); w.y = cvt_pk_bf16(v[2], v[3]); w.z = cvt_pk_bf16(v[4], v[5]); w.w = cvt_pk_bf16(v[6], v[7]);
                    *(u32x4*)dst = w;
                }
                asm volatile("" ::: "memory");
            }
    }
};
template <bool SECOND> struct EpiGate {
    static constexpr bool PERM = true, AFTER_DRAIN = false, HAS_INIT = false;
    const bf16_t* gate; bf16_t* Y1; bf16_t* Y;
    __device__ __forceinline__ void operator()(const f32x4 (&acc)[2][2][4][2], const Unit& u, int wr, int wc, int fr, int fq) const {
        const unsigned row0 = u.pm * BM + wr * 64 + fr, col0 = u.pn * BM + wc * 32 + 8 * fq;
#pragma unroll
        for (int ai = 0; ai < 2; ++ai)
#pragma unroll
            for (int m = 0; m < 4; ++m) {
                const unsigned r = row0 + ai * HALF + m * 16;
#pragma unroll
                for (int bj = 0; bj < 2; ++bj) {
                    const unsigned c = col0 + bj * HALF; const unsigned go = r * 2048u + c, yo = r * 1024u + c;
                    const u32x4 gw = *(const u32x4*)(gate + go);
                    f32x4 a0 = acc[ai][bj][m][0], a1 = acc[ai][bj][m][1];
                    a0[0] *= __uint_as_float(gw.x << 16); a0[1] *= __uint_as_float(gw.x & 0xffff0000u); a0[2] *= __uint_as_float(gw.y << 16); a0[3] *= __uint_as_float(gw.y & 0xffff0000u);
                    a1[0] *= __uint_as_float(gw.z << 16); a1[1] *= __uint_as_float(gw.z & 0xffff0000u); a1[2] *= __uint_as_float(gw.w << 16); a1[3] *= __uint_as_float(gw.w & 0xffff0000u);
                    if (!SECOND) { u32x4 w; w.x = cvt_pk_bf16(a0[0], a0[1]); w.y = cvt_pk_bf16(a0[2], a0[3]); w.z = cvt_pk_bf16(a1[0], a1[1]); w.w = cvt_pk_bf16(a1[2], a1[3]); *(u32x4*)(Y1 + yo) = w; }
                    else { const u32x4 yw = *(const u32x4*)(Y1 + yo);
                        a0[0] += __uint_as_float(yw.x << 16); a0[1] += __uint_as_float(yw.x & 0xffff0000u); a0[2] += __uint_as_float(yw.y << 16); a0[3] += __uint_as_float(yw.y & 0xffff0000u);
                        a1[0] += __uint_as_float(yw.z << 16); a1[1] += __uint_as_float(yw.z & 0xffff0000u); a1[2] += __uint_as_float(yw.w << 16); a1[3] += __uint_as_float(yw.w & 0xffff0000u);
                        u32x4 w; w.x = cvt_pk_bf16(a0[0], a0[1]); w.y = cvt_pk_bf16(a0[2], a0[3]); w.z = cvt_pk_bf16(a1[0], a1[1]); w.w = cvt_pk_bf16(a1[2], a1[3]);
                        __builtin_amdgcn_raw_buffer_store_b128(w, __builtin_amdgcn_make_buffer_rsrc(Y, 0, 16384 * 1024 * 2, 0x00020000), yo * 2u, 0,   16); }
                    asm volatile("" ::: "memory");
                }
            }
    }
};
struct EpiGate2 {
    static constexpr bool PERM = true, AFTER_DRAIN = false, HAS_INIT = false;
    const bf16_t* gate; bf16_t* Y1; bf16_t* Y;
    __device__ __forceinline__ void operator()(const f32x4 (&acc)[2][2][4][2], const Unit& u, int wr, int wc, int fr, int fq) const {
        const unsigned row0 = u.pm * BM + wr * 64 + fr, col0 = u.pn * BM + wc * 32 + 8 * fq; const bool second = u.sel != 0; const unsigned gofs = second ? 0u : 1024u;
#pragma unroll
        for (int ai = 0; ai < 2; ++ai)
#pragma unroll
            for (int m = 0; m < 4; ++m) {
                const unsigned r = row0 + ai * HALF + m * 16;
#pragma unroll
                for (int bj = 0; bj < 2; ++bj) {
                    const unsigned c = col0 + bj * HALF; const unsigned go = r * 2048u + gofs + c, yo = r * 1024u + c;
                    const u32x4 gw = __builtin_nontemporal_load((const u32x4*)(gate + go));
                    f32x4 a0 = acc[ai][bj][m][0], a1 = acc[ai][bj][m][1];
                    a0[0] *= __uint_as_float(gw.x << 16); a0[1] *= __uint_as_float(gw.x & 0xffff0000u); a0[2] *= __uint_as_float(gw.y << 16); a0[3] *= __uint_as_float(gw.y & 0xffff0000u);
                    a1[0] *= __uint_as_float(gw.z << 16); a1[1] *= __uint_as_float(gw.z & 0xffff0000u); a1[2] *= __uint_as_float(gw.w << 16); a1[3] *= __uint_as_float(gw.w & 0xffff0000u);
                    if (second) { const u32x4 yw = *(const u32x4*)(Y1 + yo);
                        a0[0] += __uint_as_float(yw.x << 16); a0[1] += __uint_as_float(yw.x & 0xffff0000u); a0[2] += __uint_as_float(yw.y << 16); a0[3] += __uint_as_float(yw.y & 0xffff0000u);
                        a1[0] += __uint_as_float(yw.z << 16); a1[1] += __uint_as_float(yw.z & 0xffff0000u); a1[2] += __uint_as_float(yw.w << 16); a1[3] += __uint_as_float(yw.w & 0xffff0000u); }
                    u32x4 w; w.x = cvt_pk_bf16(a0[0], a0[1]); w.y = cvt_pk_bf16(a0[2], a0[3]); w.z = cvt_pk_bf16(a1[0], a1[1]); w.w = cvt_pk_bf16(a1[2], a1[3]);
                    if (second) __builtin_amdgcn_raw_buffer_store_b128(w, __builtin_amdgcn_make_buffer_rsrc(Y, 0, 16384 * 1024 * 2, 0x00020000), yo * 2u, 0,   16);
                    else *(u32x4*)(Y1 + yo) = w;
                    asm volatile("" ::: "memory");
                }
            }
    }
};

template <class Epi, class Sched, bool ALIGN_EPI = false, bool SP2 = false>
__device__ __forceinline__ void gemm_phase(PG8_LAS unsigned char* lds, const Gemm g, const Sched& S, const Epi& E) {
    int tid_ = threadIdx.x; asm volatile("" : "+v"(tid_));
    const int tid = tid_, wid = __builtin_amdgcn_readfirstlane(tid >> 6), lane = tid & 63, wr = wid >> 2, wc = wid & 3, fr = lane & 15, fq = lane >> 4;
    const int K = g.K, nt = K / BK;
    unsigned voffA[2], voffB[2];
#pragma unroll
    for (int i = 0; i < 2; ++i) { int R, C; stage_rc(tid * 16 + i * 8192, R, C); const int Rb = Epi::PERM ? ((R & ~31) + perm32(R & 31)) : R;
        voffA[i] = (unsigned)(R * K + C) * 2u; voffB[i] = (unsigned)(Rb * K + C) * 2u; }
    const size_t kstep = (size_t)(BK * 2);
    const size_t hstep = (size_t)HALF * K * 2;
    const size_t tstep = 2 * hstep;
    const unsigned ldsw = (unsigned)wid * 1024u;
    const int aoff = lds_byte(wr * 64 + fr, fq * 8), boff = lds_byte(wc * 32 + fr, fq * 8);
#define PG8_SA(b, h) (((b) * 2 + (h)) * HTB)
#define PG8_SB(b, h) ((4 + (b) * 2 + (h)) * HTB)
#define PG8_STAGE(bufoff, gbase, voff) do { _Pragma("unroll") for (int _i = 0; _i < 2; ++_i) \
        __builtin_amdgcn_global_load_lds((const unsigned*)((const char*)(gbase) + (voff)[_i]), (PG8_LAS unsigned*)(lds + (bufoff) + ldsw + _i * 8192), 16, 0, 0); } while (0)
#define PG8_LDA(dst, b, h) do { _Pragma("unroll") for (int m = 0; m < 4; ++m) _Pragma("unroll") for (int k = 0; k < 2; ++k) dst[m][k] = *(const PG8_LAS bf16x8*)(lds + PG8_SA(b, h) + aoff + m * 2048 + k * 1024); } while (0)
#define PG8_LDB(dst, b, h) do { _Pragma("unroll") for (int n = 0; n < 2; ++n) _Pragma("unroll") for (int k = 0; k < 2; ++k) dst[n][k] = *(const PG8_LAS bf16x8*)(lds + PG8_SB(b, h) + boff + n * 2048 + k * 1024); } while (0)
#define PG8_MMA(ai, bj, At, Bt) do { __builtin_amdgcn_s_setprio(1); _Pragma("unroll") for (int m = 0; m < 4; ++m) _Pragma("unroll") for (int n = 0; n < 2; ++n) _Pragma("unroll") for (int k = 0; k < 2; ++k) \
        acc[ai][bj][m][n] = __builtin_amdgcn_mfma_f32_16x16x32_bf16(Bt[n][k], At[m][k], acc[ai][bj][m][n], 0, 0, 0); __builtin_amdgcn_s_setprio(0); } while (0)
#define PG8_WAIT_V(n) asm volatile("s_waitcnt vmcnt(" #n ")" ::: "memory")
#define PG8_WAIT_L(n) asm volatile("s_waitcnt lgkmcnt(" #n ")" ::: "memory")
#define PG8_BAR __builtin_amdgcn_s_barrier()
#define PG8_SCHED __builtin_amdgcn_sched_barrier(0)
    Unit cur, nxt; int ui = 0;
    if (!S.next(0, cur)) return;
    f32x4 acc[2][2][4][2];
    if constexpr (Epi::HAS_INIT) E.init(acc, cur, wr, wc, fr, fq);
    else {
#pragma unroll
    for (int a = 0; a < 2; ++a)
#pragma unroll
        for (int b = 0; b < 2; ++b)
#pragma unroll
            for (int m = 0; m < 4; ++m)
#pragma unroll
                for (int n = 0; n < 2; ++n) acc[a][b][m][n] = (f32x4){0.f, 0.f, 0.f, 0.f};
    }
    bf16x8 At[4][2], B0[2][2], B1[2][2];
    const char* cA = (const char*)(cur.sel ? g.A2 : g.A) + (size_t)cur.pm * tstep; const char* cB = (const char*)(cur.sel ? g.Bt2 : g.Bt) + (size_t)cur.pn * tstep;
    S.a_ready(cur);
    if constexpr (SP2) {
        PG8_STAGE(PG8_SB(0, 0), cB, voffB); PG8_STAGE(PG8_SB(0, 1), cB + hstep, voffB); PG8_STAGE(PG8_SA(0, 0), cA, voffA); PG8_STAGE(PG8_SA(0, 1), cA + hstep, voffA);
        if (wr == 1) PG8_BAR;
        PG8_WAIT_V(2); PG8_BAR;
        PG8_STAGE(PG8_SB(1, 0), cB + kstep, voffB); PG8_STAGE(PG8_SA(1, 0), cA + kstep, voffA); PG8_STAGE(PG8_SB(1, 1), cB + hstep + kstep, voffB);
        PG8_WAIT_V(6); PG8_BAR;
    } else {
        PG8_STAGE(PG8_SB(0, 0), cB, voffB); PG8_STAGE(PG8_SA(0, 0), cA, voffA); PG8_STAGE(PG8_SB(0, 1), cB + hstep, voffB); PG8_STAGE(PG8_SA(0, 1), cA + hstep, voffA);
        if (wr == 1) PG8_BAR;
        PG8_WAIT_V(4); PG8_BAR;
        PG8_STAGE(PG8_SB(1, 0), cB + kstep, voffB); PG8_STAGE(PG8_SA(1, 0), cA + kstep, voffA); PG8_STAGE(PG8_SB(1, 1), cB + hstep + kstep, voffB);
        PG8_WAIT_V(6); PG8_BAR;
    }
    for (;;) {
        const bool has_next = S.next(ui + 1, nxt);
        const char* nA = has_next ? (const char*)(nxt.sel ? g.A2 : g.A) + (size_t)nxt.pm * tstep : cA; const char* nB = has_next ? (const char*)(nxt.sel ? g.Bt2 : g.Bt) + (size_t)nxt.pn * tstep : cB;
        for (int t = 0; t < nt; t += 2) {
            const bool last = (t == nt - 2);
            const char* a1 = cA + (size_t)(t + 1) * kstep;
            const char* a2 = last ? nA : cA + (size_t)(t + 2) * kstep; const char* b2 = last ? nB : cB + (size_t)(t + 2) * kstep;
            const char* a3 = a2 + kstep; const char* b3 = b2 + kstep;
            if (last && has_next) S.a_ready(nxt);
            if constexpr (SP2) {
            PG8_LDB(B0, 0, 0); PG8_LDB(B1, 0, 1); PG8_SCHED; PG8_LDA(At, 0, 0); PG8_STAGE(PG8_SA(1, 1), a1 + hstep, voffA);
            PG8_WAIT_V(8); PG8_WAIT_L(0); PG8_BAR; PG8_MMA(0, 0, At, B0); PG8_MMA(0, 1, At, B1); PG8_BAR; PG8_SCHED;
            PG8_LDA(At, 0, 1); PG8_STAGE(PG8_SB(0, 0), b2, voffB); PG8_STAGE(PG8_SB(0, 1), b2 + hstep, voffB); PG8_STAGE(PG8_SA(0, 0), a2, voffA);
            PG8_WAIT_V(8); PG8_WAIT_L(0); PG8_BAR; PG8_MMA(1, 0, At, B0); PG8_MMA(1, 1, At, B1); PG8_BAR; PG8_SCHED;
            PG8_LDB(B0, 1, 0); PG8_LDB(B1, 1, 1); PG8_SCHED; PG8_LDA(At, 1, 0); PG8_STAGE(PG8_SA(0, 1), a2 + hstep, voffA);
            PG8_WAIT_V(8); PG8_WAIT_L(0); PG8_BAR; PG8_MMA(0, 0, At, B0); PG8_MMA(0, 1, At, B1); PG8_BAR; PG8_SCHED;
            PG8_LDA(At, 1, 1); PG8_STAGE(PG8_SB(1, 0), b3, voffB); PG8_STAGE(PG8_SB(1, 1), b3 + hstep, voffB); PG8_STAGE(PG8_SA(1, 0), a3, voffA);
            PG8_WAIT_V(8); PG8_WAIT_L(0); PG8_BAR; PG8_MMA(1, 0, At, B0); PG8_MMA(1, 1, At, B1); PG8_BAR; PG8_SCHED;
            } else {
            PG8_LDB(B0, 0, 0); PG8_SCHED; PG8_LDA(At, 0, 0); PG8_STAGE(PG8_SA(1, 1), a1 + hstep, voffA);
            PG8_WAIT_L(8); PG8_BAR; PG8_WAIT_L(0); PG8_MMA(0, 0, At, B0); PG8_BAR; PG8_SCHED;
            PG8_LDB(B1, 0, 1); PG8_STAGE(PG8_SB(0, 0), b2, voffB);
            PG8_BAR; PG8_WAIT_L(0); PG8_MMA(0, 1, At, B1); PG8_BAR;
            PG8_LDA(At, 0, 1); PG8_STAGE(PG8_SA(0, 0), a2, voffA);
            PG8_BAR; PG8_WAIT_L(0); PG8_MMA(1, 0, At, B0); PG8_BAR; PG8_SCHED;
            PG8_STAGE(PG8_SB(0, 1), b2 + hstep, voffB);
            PG8_WAIT_V(6); PG8_BAR; PG8_MMA(1, 1, At, B1); PG8_BAR;
            PG8_LDB(B0, 1, 0); PG8_SCHED; PG8_LDA(At, 1, 0); PG8_STAGE(PG8_SA(0, 1), a2 + hstep, voffA);
            PG8_WAIT_L(8); PG8_BAR; PG8_WAIT_L(0); PG8_MMA(0, 0, At, B0); PG8_BAR; PG8_SCHED;
            PG8_LDB(B1, 1, 1); PG8_STAGE(PG8_SB(1, 0), b3, voffB);
            PG8_BAR; PG8_WAIT_L(0); PG8_MMA(0, 1, At, B1); PG8_BAR;
            PG8_LDA(At, 1, 1); PG8_STAGE(PG8_SA(1, 0), a3, voffA);
            PG8_BAR; PG8_WAIT_L(0); PG8_MMA(1, 0, At, B0); PG8_BAR; PG8_SCHED;
            PG8_STAGE(PG8_SB(1, 1), b3 + hstep, voffB);
            PG8_WAIT_V(6); PG8_BAR; PG8_MMA(1, 1, At, B1); PG8_BAR;
            }
        }
        if constexpr (ALIGN_EPI) { if (wr == 0) PG8_BAR; }
        if constexpr (!Epi::AFTER_DRAIN) { E(acc, cur, wr, wc, fr, fq); S.done(cur); }
        if (!has_next) break;
        if constexpr (Epi::HAS_INIT) E.init(acc, nxt, wr, wc, fr, fq);
        else {
#pragma unroll
        for (int a = 0; a < 2; ++a)
#pragma unroll
            for (int b = 0; b < 2; ++b)
#pragma unroll
                for (int m = 0; m < 4; ++m)
#pragma unroll
                    for (int n = 0; n < 2; ++n) acc[a][b][m][n] = (f32x4){0.f, 0.f, 0.f, 0.f};
        }
        cur = nxt; cA = nA; cB = nB; ++ui;
        if constexpr (ALIGN_EPI) { if (wr == 1) PG8_BAR; }
    }
    PG8_WAIT_V(0);
    if constexpr (!ALIGN_EPI) { if (wr == 0) PG8_BAR; }
    PG8_BAR;
    if constexpr (Epi::AFTER_DRAIN) { E.fused(acc, cur, wr, wc, fr, fq, lds, wid, lane); S.done(cur); }
#undef PG8_SA
#undef PG8_SB
#undef PG8_STAGE
#undef PG8_LDA
#undef PG8_LDB
#undef PG8_MMA
#undef PG8_WAIT_V
#undef PG8_WAIT_L
#undef PG8_BAR
#undef PG8_SCHED
}
}

#define LAS __attribute__((address_space(3)))
typedef unsigned short bf16;
typedef short bf16x8 __attribute__((ext_vector_type(8)));
typedef short s16x4 __attribute__((ext_vector_type(4)));
typedef float f32x4 __attribute__((ext_vector_type(4)));
typedef float f32x16 __attribute__((ext_vector_type(16)));
typedef unsigned u32x4 __attribute__((ext_vector_type(4)));
typedef unsigned u32x2 __attribute__((ext_vector_type(2)));
constexpr int NWAVES = 8;
constexpr int M = 16384, D = 1024, SEQ = 4096, FF = 2816, NIN = 5120, NQKV = 3072, NGATE = 2048, DEPTH = 2;
constexpr float LOG2E = 1.4426950408889634f;
#ifndef SB_EARLY_EXIT
#define SB_EARLY_EXIT 1
#endif
#ifndef N_LAUNCH_MODE
#define N_LAUNCH_MODE 0
#endif
constexpr size_t MiB = 1u << 20;
constexpr size_t WS_CNT = 16384, WS_PCNT = 32768, WS_ZERO_BYTES = 32768 + 4 * 16384;
constexpr size_t WS_XSLOT = 250 * MiB;
constexpr size_t WS_BAR = 0;
constexpr size_t WS_SSQ = 1 * MiB, WS_ROPE = 2 * MiB, WS_LSE = 3 * MiB;
constexpr size_t WS_W = 4 * MiB;
constexpr size_t W_1CAT = 0, W_D1 = W_1CAT + (size_t)2 * FF * D * 2, W_IN = W_D1 + (size_t)D * FF * 2, W_PD = W_IN + (size_t)NIN * D * 2, W_PS = W_PD + (size_t)D * 256 * 2,
                 W_OUT = W_PS + (size_t)D * 256 * 2, W_2CAT = W_OUT + (size_t)D * D * 2, W_D2 = W_2CAT + (size_t)2 * FF * D * 2, W_END = W_D2 + (size_t)D * FF * 2;
static_assert(W_END <= 46 * MiB, "weights");
constexpr size_t WS_XB = 50 * MiB;
constexpr size_t OUT_OD3 = 0, OUT_OD = 24 * MiB;
constexpr size_t WS_R = 82 * MiB;
constexpr size_t WS_Y1 = WS_R, WS_Y = WS_R + 64 * MiB;
constexpr size_t WS_GATE = 178 * MiB;
constexpr size_t WS_OS = 242 * MiB;
constexpr size_t WS_END = 251 * MiB;
constexpr int RSL_OFF = 131072 + 1024;
constexpr int LDS_BYTES = RSL_OFF + 8 * 256 * 4;

__device__ __forceinline__ float wave_sum(float v) {
#pragma unroll
    for (int o = 1; o < 64; o <<= 1) v += __shfl_xor(v, o);
    return v;
}
__device__ __forceinline__ unsigned pk2(float lo, float hi) { return pg8::cvt_pk_bf16(lo, hi); }
#define LDS_WAIT() asm volatile("s_waitcnt lgkmcnt(0)" ::: "memory")

typedef __attribute__((address_space(1))) unsigned gu32;
#define XB_TMO      128
#define XB_XCNT(j)  (256  + 64 * (j))
#define XB_XSUB(j)  (1280 + 64 * (j))
#define XB_XGEN(j)  (2304 + 64 * (j))
#define XB_TOP      3328
#define XB_TOPGEN   3392
#define XCD_BAR_WORDS 3456
#define XB_SPIN_CAP (1u << 18)

__device__ __forceinline__ unsigned xb_ld(unsigned* p)              { return __hip_atomic_load(p, __ATOMIC_RELAXED, __HIP_MEMORY_SCOPE_AGENT); }
__device__ __forceinline__ unsigned xb_add(unsigned* p, unsigned v) { return __hip_atomic_fetch_add(p, v, __ATOMIC_RELAXED, __HIP_MEMORY_SCOPE_AGENT); }
__device__ __forceinline__ unsigned xb_xcc_id() { return (unsigned)__builtin_amdgcn_s_getreg((3 << 11) | 20) & 0xFu; }
#define XB_SPIN(cond, bar) do { unsigned _sp = 0; while (cond) { __builtin_amdgcn_s_sleep(1); \
    if ((++_sp & 255u) == 0u) { if (xb_ld(&(bar)[XB_TMO])) break; if (_sp > XB_SPIN_CAP) { atomicAdd(&(bar)[XB_TMO], 1u); break; } } } } while (0)

struct XcdBarrier {
    unsigned* bar; unsigned x;
    volatile LAS unsigned* st;
};

__device__ __forceinline__ XcdBarrier xcd_barrier_post(unsigned* bar, volatile LAS unsigned* st) {
    XcdBarrier b; b.bar = bar; b.x = xb_xcc_id(); b.st = st;
    if (threadIdx.x == 0) (void)xb_add(&bar[XB_XCNT(b.x)], 1u);
    return b;
}
__device__ __forceinline__ void xcd_barrier_complete(unsigned* bar, unsigned x, unsigned& nloc, unsigned& nx) {
    const unsigned G = gridDim.x * gridDim.y * gridDim.z;
    unsigned sum, cnt, mine, sp = 0u;
    for (;;) {
        sum = 0u; cnt = 0u; mine = 0u;
#pragma unroll
        for (unsigned j = 0; j < 16; ++j) { const unsigned c = xb_ld(&bar[XB_XCNT(j)]); sum += c; cnt += (c > 0u) ? 1u : 0u; mine = (j == x) ? c : mine; }
        if (sum == G) break;
        __builtin_amdgcn_s_sleep(1);
        if ((++sp & 255u) == 0u) { if (xb_ld(&bar[XB_TMO])) break; if (sp > XB_SPIN_CAP) { atomicAdd(&bar[XB_TMO], 1u); break; } }
    }
    nloc = mine > 0u ? mine : 1u; nx = cnt > 0u ? cnt : 1u;
}

__device__ __forceinline__ void xcd_barrier(const XcdBarrier& b) {
    asm volatile("s_waitcnt vmcnt(0)" ::: "memory");
    __syncthreads();
    if (threadIdx.x == 0) {
        unsigned* bar = b.bar;
        __builtin_amdgcn_s_waitcnt(0);
        unsigned nloc = b.st[0], nx = b.st[1];
        if (nloc == 0u) { xcd_barrier_complete(bar, b.x, nloc, nx); b.st[0] = nloc; b.st[1] = nx; }
        const unsigned old = xb_add(&bar[XB_XSUB(b.x)], 1u);
        const unsigned gen = old / nloc;
        if (old + 1u == (gen + 1u) * nloc) {
            __builtin_amdgcn_fence(__ATOMIC_RELEASE, "agent");
            asm volatile("s_waitcnt vmcnt(0)" ::: "memory");
            const unsigned og = xb_add(&bar[XB_TOP], 1u);
            const unsigned tg = og / nx;
            if (og + 1u == (tg + 1u) * nx) xb_add(&bar[XB_TOPGEN], 1u);
            else XB_SPIN(xb_ld(&bar[XB_TOPGEN]) == tg, bar);
            __builtin_amdgcn_fence(__ATOMIC_ACQUIRE, "agent");
            xb_add(&bar[XB_XGEN(b.x)], 1u);
            asm volatile("s_waitcnt vmcnt(0)" ::: "memory");
        } else {
            XB_SPIN(xb_ld(&bar[XB_XGEN(b.x)]) == gen, bar);
            __builtin_amdgcn_fence(__ATOMIC_ACQUIRE, "agent");
            asm volatile("s_waitcnt vmcnt(0)" ::: "memory");
        }
    }
    __syncthreads();
}


constexpr int CI_D1 = 2816, CI_IN = 4224, CI_B = 6784, CI_D2 = 9600, CI_PD = 11008, CI_PS = 11136, CI_OUT = 11264, CI_END = 11776;
struct ConvItem { const float* wp; const float* gp; bf16* dp; int ldw, K; bool rperm; };
struct ConvSrc { const float *n1, *wg1, *wu1, *wd1, *nm, *win, *wpd, *wps, *wout, *n2, *wg2, *wu2, *wd2; };
__device__ __forceinline__ ConvItem conv_decode(const ConvSrc& S, int l, int r, unsigned char* dA, unsigned char* dB, int lane) {
    const float* src; const float* gain = nullptr; bf16* dst; int ldw = D, K = D, kb, nb, sc0; bool rperm = false;
    if (r < CI_D1) { kb = r / 176; nb = r % 176; const int pn = nb >> 3, i8 = nb & 7; src = (i8 < 4 ? S.wg1 : S.wu1) + (size_t)l * D * FF; gain = S.n1 + (size_t)l * D; dst = (bf16*)(dA + W_1CAT); ldw = FF; sc0 = 128 * pn + 32 * (i8 & 3); }
    else if (r < CI_IN) { r -= CI_D1; kb = r / 32; nb = r % 32; src = S.wd1 + (size_t)l * FF * D; dst = (bf16*)(dA + W_D1); K = FF; sc0 = 32 * nb; }
    else if (r < CI_B) { r -= CI_IN; kb = r / 160; nb = r % 160; src = S.win + (size_t)l * D * NIN; gain = S.nm + (size_t)l * D; dst = (bf16*)(dA + W_IN); ldw = NIN; sc0 = 32 * nb; rperm = (nb < 48) && !(nb & 1); }
    else if (r < CI_D2) { r -= CI_B; kb = r / 176; nb = r % 176; const int pn = nb >> 3, i8 = nb & 7; src = (i8 < 4 ? S.wg2 : S.wu2) + (size_t)l * D * FF; gain = S.n2 + (size_t)l * D; dst = (bf16*)(dB + W_2CAT); ldw = FF; sc0 = 128 * pn + 32 * (i8 & 3); }
    else if (r < CI_PD) { r -= CI_D2; kb = r / 32; nb = r % 32; src = S.wd2 + (size_t)l * FF * D; dst = (bf16*)(dB + W_D2); K = FF; sc0 = 32 * nb; }
    else if (r < CI_PS) { r -= CI_PD; kb = r / 32; nb = r % 32; src = S.wpd + (size_t)l * 256 * D; dst = (bf16*)(dB + W_PD); K = 256; sc0 = 32 * nb; }
    else if (r < CI_OUT) { r -= CI_PS; kb = r / 32; nb = r % 32; src = S.wps + (size_t)l * 256 * D; dst = (bf16*)(dB + W_PS); K = 256; sc0 = 32 * nb; }
    else { r -= CI_OUT; kb = r / 32; nb = r % 32; src = S.wout + (size_t)l * D * D; dst = (bf16*)(dB + W_OUT); sc0 = 32 * nb; }
    const int c4 = lane & 7, kr = lane >> 3, k0 = 64 * kb;
    ConvItem I; I.wp = src + (size_t)(k0 + kr) * ldw + sc0 + 4 * c4; I.gp = gain ? gain + k0 + kr : nullptr; I.dp = dst + (size_t)(32 * nb) * K + k0; I.ldw = ldw; I.K = K; I.rperm = rperm;
    return I;
}
__device__ __forceinline__ void conv_load(f32x4 (&v)[8], const ConvItem& I) {
#pragma unroll
    for (int i = 0; i < 8; ++i) v[i] = __builtin_nontemporal_load((const f32x4*)(I.wp + (size_t)(8 * i) * I.ldw));
}
__device__ __forceinline__ void conv_finish(f32x4 (&v)[8], const ConvItem& I, LAS float* scr, int lane) {
    const int c4 = lane & 7, kr = lane >> 3;
    if (I.gp) {
#pragma unroll
        for (int i = 0; i < 8; ++i) v[i] *= I.gp[8 * i];
    }
    int p[4];
#pragma unroll
    for (int e = 0; e < 4; ++e) { const int sc = 4 * c4 + e; p[e] = (I.rperm && sc < 16) ? (sc < 8 ? 2 * sc : 2 * (sc - 8) + 1) : sc; }
#pragma unroll
    for (int i = 0; i < 8; ++i)
#pragma unroll
        for (int e = 0; e < 4; ++e) scr[(kr + 8 * i) * 33 + p[e]] = v[i][e];
    LDS_WAIT();
    const int c = lane & 7;
#pragma unroll
    for (int jj = 0; jj < 4; ++jj) { const int n = (lane >> 3) + 8 * jj; const LAS float* s = scr + (8 * c) * 33 + n;
        u32x4 o; o.x = pk2(s[0 * 33], s[1 * 33]); o.y = pk2(s[2 * 33], s[3 * 33]); o.z = pk2(s[4 * 33], s[5 * 33]); o.w = pk2(s[6 * 33], s[7 * 33]);
        *(u32x4*)(I.dp + (size_t)n * I.K + 8 * c) = o; }
    LDS_WAIT();
}
__device__ __forceinline__ void conv_items(const ConvSrc& S, int l, int lo, int hi, unsigned char* dA, unsigned char* dB, LAS unsigned char* lds, int widx, int nw, int wave, int lane) {
    LAS float* scr = (LAS float*)(lds + wave * 8704);
    int it = lo + widx; if (it >= hi) return;
    ConvItem cur = conv_decode(S, l, __builtin_amdgcn_readfirstlane(it), dA, dB, lane); f32x4 v[8]; conv_load(v, cur);
    for (;;) {
        const int itn = it + nw; const bool more = itn < hi;
        ConvItem nxt = cur; f32x4 vn[8];
        if (more) { nxt = conv_decode(S, l, __builtin_amdgcn_readfirstlane(itn), dA, dB, lane); conv_load(vn, nxt); }
        conv_finish(v, cur, scr, lane);
        if (!more) break;
        cur = nxt; it = itn;
#pragma unroll
        for (int i = 0; i < 8; ++i) v[i] = vn[i];
    }
}
__device__ __forceinline__ void conv_phase(const float* Px, const ConvSrc& S, unsigned char* Pws, int l, LAS unsigned char* lds, int gw, int NGW, int wave, int lane) {
    unsigned char* wsw = Pws + WS_W;
    conv_items(S, l, 0, CI_END, wsw, wsw, lds, gw, NGW, wave, lane);
    if (l == 0) {
        const float* x = Px; bf16* xb = (bf16*)(Pws + WS_XB); float* ssqp = (float*)(Pws + WS_SSQ);
        for (int m = gw; m < M; m += NGW) {
            const f32x4* xr = (const f32x4*)(x + (size_t)m * D) + 2 * lane; f32x4 v[4]; float s = 0.f;
#pragma unroll
            for (int j = 0; j < 2; ++j) { v[2 * j] = __builtin_nontemporal_load(xr + 128 * j); v[2 * j + 1] = __builtin_nontemporal_load(xr + 128 * j + 1); }
#pragma unroll
            for (int j = 0; j < 4; ++j) s += (v[j][0] * v[j][0] + v[j][1] * v[j][1]) + (v[j][2] * v[j][2] + v[j][3] * v[j][3]);
            s = wave_sum(s);
            u32x4* o = (u32x4*)(xb + (size_t)m * D) + lane;
#pragma unroll
            for (int j = 0; j < 2; ++j) { u32x4 w; w.x = pk2(v[2 * j][0], v[2 * j][1]); w.y = pk2(v[2 * j][2], v[2 * j][3]); w.z = pk2(v[2 * j + 1][0], v[2 * j + 1][1]); w.w = pk2(v[2 * j + 1][2], v[2 * j + 1][3]); o[64 * j] = w; }
            if (lane < 16) ssqp[(size_t)m * 16 + lane] = (lane == 0) ? s : 0.f;
        }
        float* rope = (float*)(Pws + WS_ROPE);
        for (int idx = gw * 64 + lane; idx < SEQ * 8; idx += NGW * 64) {
            const int t = idx >> 3, i = idx & 7;
            const float invf = (i == 0) ? 1.0f : (i == 1) ? 0.1939227432012558f : (i == 2) ? 0.03760603070259094f : (i == 3) ? 0.007292664609849453f : (i == 4) ? 0.0014142135623842478f
                             : (i == 5) ? 0.00027424818836152554f : (i == 6) ? 5.3182957344688475e-05f : 1.0313385246263351e-05f;
            const float angf = (float)t * invf; const double a = (double)angf;
            const double kq = __builtin_rint(a * 0.63661977236758134308);
            double rr = __builtin_fma(-kq, 1.57079632679489655800, a); rr = __builtin_fma(-kq, 6.12323399573676603587e-17, rr);
            const int qd = ((int)kq) & 3; const float rf = (float)rr, r2 = rf * rf;
            const float sn = rf + rf * r2 * (-1.0f / 6 + r2 * (1.0f / 120 + r2 * (-1.0f / 5040 + r2 * (1.0f / 362880))));
            const float cn = 1.0f + r2 * (-0.5f + r2 * (1.0f / 24 + r2 * (-1.0f / 720 + r2 * (1.0f / 40320 + r2 * (-1.0f / 3628800)))));
            const float c = (qd == 0) ? cn : (qd == 1) ? -sn : (qd == 2) ? -cn : sn;
            const float s = (qd == 0) ? sn : (qd == 1) ? cn : (qd == 2) ? -sn : -cn;
            rope[2 * idx] = c; rope[2 * idx + 1] = s;
        }
    }
}

__device__ __forceinline__ int crow(int r, int hi) { return (r & 3) + 8 * (r >> 2) + 4 * hi; }
struct F2 { float a, b; };
__device__ __forceinline__ F2 pair32(float v) { const auto rr = __builtin_amdgcn_permlane32_swap(__float_as_uint(v), __float_as_uint(v), false, false); return F2{__uint_as_float(rr[0]), __uint_as_float(rr[1])}; }
__device__ __forceinline__ void ld_frag4(bf16x8 (&f)[4], const bf16* ubase, unsigned rowstride, int lane) {
    const unsigned off = (unsigned)(lane & 31) * rowstride + (unsigned)(lane >> 5) * 8u;
#pragma unroll
    for (int d0 = 0; d0 < 4; ++d0) f[d0] = *(const bf16x8*)(ubase + (off + d0 * 16));
}
__device__ __forceinline__ void ld_frag4_nt(bf16x8 (&f)[4], const bf16* ubase, unsigned rowstride, int lane) {
    const unsigned off = (unsigned)(lane & 31) * rowstride + (unsigned)(lane >> 5) * 8u;
#pragma unroll
    for (int d0 = 0; d0 < 4; ++d0) f[d0] = __builtin_nontemporal_load((const bf16x8*)(ubase + (off + d0 * 16)));
}
__device__ __forceinline__ f32x16 qk_tile(const bf16x8 (&kf)[4], const bf16x8 (&qf)[4]) {
    f32x16 s = {};
#pragma unroll
    for (int d0 = 0; d0 < 4; ++d0) s = __builtin_amdgcn_mfma_f32_32x32x16_bf16(kf[d0], qf[d0], s, 0, 0, 0);
    return s;
}
__device__ __forceinline__ void v_load(u32x4 (&vr)[4], const bf16* ubase, unsigned rowstride, int lane) {
#pragma unroll
    for (int i = 0; i < 4; ++i) { const unsigned c = lane + 64 * i; vr[i] = *(const u32x4*)(ubase + ((c >> 3) * rowstride + (c & 7) * 8u)); }
}
__device__ __forceinline__ void v_stage(LAS unsigned char* vb, const u32x4 (&vr)[4], int lane) {
#pragma unroll
    for (int i = 0; i < 4; ++i) { const int c = lane + 64 * i, key = c >> 3, ch = c & 7; *(LAS u32x4*)(vb + key * 128 + ((ch * 16) ^ (((key >> 1) & 1) << 6))) = vr[i]; }
}
__device__ __forceinline__ void pv_tile(f32x16 (&o)[2], LAS unsigned char* vb, const f32x16& p, int lane) {
    const int hi = lane >> 5, g1 = (lane >> 4) & 1, q4 = (lane & 15) >> 2, pp = lane & 3;
    bf16x8 pf[2];
#pragma unroll
    for (int s = 0; s < 2; ++s) { u32x4 w; w.x = pk2(p[8 * s + 0], p[8 * s + 1]); w.y = pk2(p[8 * s + 2], p[8 * s + 3]); w.z = pk2(p[8 * s + 4], p[8 * s + 5]); w.w = pk2(p[8 * s + 6], p[8 * s + 7]);
        pf[s] = __builtin_bit_cast(bf16x8, w); }
    const int swz = ((q4 >> 1) & 1) << 6;
#pragma unroll
    for (int dblk = 0; dblk < 2; ++dblk)
#pragma unroll
        for (int s = 0; s < 2; ++s) {
            const int colb = (dblk * 64 + g1 * 32 + pp * 8) ^ swz;
            const int row0 = 16 * s + 4 * hi + q4;
            const s16x4 t0 = __builtin_bit_cast(s16x4, __builtin_amdgcn_ds_read_tr16_b64_v4i16((LAS s16x4*)(vb + row0 * 128 + colb)));
            const s16x4 t1 = __builtin_bit_cast(s16x4, __builtin_amdgcn_ds_read_tr16_b64_v4i16((LAS s16x4*)(vb + (row0 + 8) * 128 + colb)));
            const bf16x8 a = (bf16x8){t0[0], t0[1], t0[2], t0[3], t1[0], t1[1], t1[2], t1[3]};
            o[dblk] = __builtin_amdgcn_mfma_f32_32x32x16_bf16(a, pf[s], o[dblk], 0, 0, 0);
        }
}
__device__ __forceinline__ void store_ot(bf16* rowp, const f32x16 (&o)[2], float sc, int hi) {
#pragma unroll
    for (int dblk = 0; dblk < 2; ++dblk)
#pragma unroll
        for (int p = 0; p < 2; ++p) {
            const unsigned x0 = pk2(o[dblk][8 * p] * sc, o[dblk][8 * p + 1] * sc), x1 = pk2(o[dblk][8 * p + 2] * sc, o[dblk][8 * p + 3] * sc);
            const unsigned y0 = pk2(o[dblk][8 * p + 4] * sc, o[dblk][8 * p + 5] * sc), y1 = pk2(o[dblk][8 * p + 6] * sc, o[dblk][8 * p + 7] * sc);
            const auto s0 = __builtin_amdgcn_permlane32_swap(x0, y0, false, false), s1 = __builtin_amdgcn_permlane32_swap(x1, y1, false, false);
            u32x4 w; w.x = s0[0]; w.y = s1[0]; w.z = s0[1]; w.w = s1[1];
            *(u32x4*)(rowp + dblk * 32 + 16 * p + 8 * hi) = w; }
}
struct DilGeo { size_t rowb, kstride; int h12, dil, r, i0; };
__device__ __forceinline__ DilGeo dil_geo(int item) {
    DilGeo g; const int b = item / 1536, rem = item % 1536, ch = rem & 127; g.h12 = rem >> 7;
    const int gg = g.h12 >> 2, ncl = 7 - 2 * gg; g.dil = 1 << (2 * gg); g.r = ch >> ncl; g.i0 = 32 * (ch & ((1 << ncl) - 1));
    g.rowb = (size_t)b * SEQ; g.kstride = (size_t)g.dil * 64; return g;
}
__device__ __forceinline__ void dil_load_qk(const bf16* QKV, const DilGeo& g, bf16x8 (&qf)[4], bf16x8 (&kf)[5][4], int lane) {
    const int q = lane & 31, hi = lane >> 5;
    ld_frag4_nt(qf, QKV + ((size_t)g.h12 * M + g.rowb + (size_t)g.i0 * g.dil + g.r) * 64, (unsigned)g.kstride, lane);
#pragma unroll
    for (int kt = 0; kt < 5; ++kt) { const int ib = g.i0 - 128 + 32 * kt, ibc = ib < 0 ? 0 : ib; ld_frag4(kf[kt], QKV + ((size_t)(12 + g.h12) * M + g.rowb + (size_t)ibc * g.dil + g.r) * 64, (unsigned)g.kstride, lane); }
}
__device__ __forceinline__ void dil_vload(const bf16* QKV, const DilGeo& g, u32x4 (&vr)[4], int kt, int lane) {
    const int ib = g.i0 - 128 + 32 * kt, ibc = ib < 0 ? 0 : ib;
    v_load(vr, QKV + ((size_t)(24 + g.h12) * M + g.rowb + g.r) * 64 + (size_t)ibc * g.kstride, (unsigned)g.kstride, lane);
}
__device__ __forceinline__ void pv_tile_p(f32x16 (&o)[2], LAS unsigned char* vb, const bf16x8 (&pf)[2], int lane) {
    const int hi = lane >> 5, g1 = (lane >> 4) & 1, q4 = (lane & 15) >> 2, pp = lane & 3;
    const int swz = ((q4 >> 1) & 1) << 6;
#pragma unroll
    for (int dblk = 0; dblk < 2; ++dblk)
#pragma unroll
        for (int s = 0; s < 2; ++s) {
            const int colb = (dblk * 64 + g1 * 32 + pp * 8) ^ swz;
            const int row0 = 16 * s + 4 * hi + q4;
            const s16x4 t0 = __builtin_bit_cast(s16x4, __builtin_amdgcn_ds_read_tr16_b64_v4i16((LAS s16x4*)(vb + row0 * 128 + colb)));
            const s16x4 t1 = __builtin_bit_cast(s16x4, __builtin_amdgcn_ds_read_tr16_b64_v4i16((LAS s16x4*)(vb + (row0 + 8) * 128 + colb)));
            const bf16x8 a = (bf16x8){t0[0], t0[1], t0[2], t0[3], t1[0], t1[1], t1[2], t1[3]};
            o[dblk] = __builtin_amdgcn_mfma_f32_32x32x16_bf16(a, pf[s], o[dblk], 0, 0, 0);
        }
}
__device__ __forceinline__ void dil_items(const bf16* QKV, bf16* OD3, float* LSE, LAS unsigned char* vb, int first, int stride, int lane) {
    int it = first; if (it >= 6144) return;
    const int q = lane & 31, hi = lane >> 5;
    DilGeo g = dil_geo(__builtin_amdgcn_readfirstlane(it));
    for (;;) {
        bf16x8 qf[4], kf[5][4];
        dil_load_qk(QKV, g, qf, kf, lane);
        u32x4 vr[5][4];
#pragma unroll
        for (int kt = 0; kt < 5; ++kt) dil_vload(QKV, g, vr[kt], kt, lane);
        float mx = -INFINITY, l = 0.f;
        f32x16 s[5];
#pragma unroll
        for (int kt = 0; kt < 5; ++kt) {
            s[kt] = qk_tile(kf[kt], qf);
            if (g.i0 - 128 + 32 * kt < 0) {
#pragma unroll
                for (int rr = 0; rr < 16; ++rr) s[kt][rr] = -INFINITY;
            }
        }
#pragma unroll
        for (int rr = 0; rr < 16; ++rr) { const int kk = crow(rr, hi); if (kk < q) s[0][rr] = -INFINITY; if (kk > q) s[4][rr] = -INFINITY; }
#pragma unroll
        for (int kt = 0; kt < 5; ++kt)
#pragma unroll
            for (int rr = 0; rr < 16; ++rr) mx = fmaxf(mx, s[kt][rr]);
        { const F2 t = pair32(mx); mx = fmaxf(t.a, t.b); }
        const float mb = mx * LOG2E;
#define DIL_EXP_PACK(kt_, dst) do { _Pragma("unroll") for (int rr = 0; rr < 16; ++rr) { const float p = __builtin_amdgcn_exp2f(__builtin_fmaf(s[kt_][rr], LOG2E, -mb)); s[kt_][rr] = p; l += p; } \
        _Pragma("unroll") for (int h2 = 0; h2 < 2; ++h2) { u32x4 w; w.x = pk2(s[kt_][8 * h2 + 0], s[kt_][8 * h2 + 1]); w.y = pk2(s[kt_][8 * h2 + 2], s[kt_][8 * h2 + 3]); \
            w.z = pk2(s[kt_][8 * h2 + 4], s[kt_][8 * h2 + 5]); w.w = pk2(s[kt_][8 * h2 + 6], s[kt_][8 * h2 + 7]); dst[h2] = __builtin_bit_cast(bf16x8, w); } } while (0)
        bf16x8 pf[2][2];
        DIL_EXP_PACK(0, pf[0]);
        const int itn = it + stride; const bool more = itn < 6144;
        const DilGeo gn = dil_geo(__builtin_amdgcn_readfirstlane(more ? itn : it));
        f32x16 o[2]; o[0] = f32x16{}; o[1] = f32x16{};
#pragma unroll
        for (int kt = 0; kt < 5; ++kt) {
            LDS_WAIT();
            v_stage(vb, vr[kt], lane);
            LDS_WAIT();
            pv_tile_p(o, vb, pf[kt & 1], lane);
            if (kt + 1 < 5) DIL_EXP_PACK(kt + 1, pf[(kt + 1) & 1]);
        }
#undef DIL_EXP_PACK
        { const F2 t = pair32(l); l = t.a + t.b; }
        const float inv = 1.0f / l;
        const size_t tok = g.rowb + (size_t)(g.i0 + q) * g.dil + g.r;
        store_ot(OD3 + (g.rowb + (size_t)g.i0 * g.dil + g.r) * 768 + g.h12 * 64 + (unsigned)q * (unsigned)(g.dil * 768), o, inv, hi);
        if (hi == 0) LSE[tok * 12 + g.h12] = mx + __logf(l);
        if (!more) break;
        it = itn; g = gn;
    }
}
__device__ __forceinline__ void sb_step(f32x16 (&o)[2], float& R, const bf16x8 (&kf)[4], const bf16x8 (&qf)[4], const u32x4 (&vr)[4], LAS unsigned char* vb, int dq, int lane) {
    const int hi = lane >> 5;
    f32x16 z = qk_tile(kf, qf);
    float gp[4];
#pragma unroll
    for (int c4 = 0; c4 < 4; ++c4) {
        float be[4], ke[4];
#pragma unroll
        for (int i = 0; i < 4; ++i) { const float zz = z[4 * c4 + i]; const float e = __builtin_amdgcn_exp2f(zz * LOG2E); const float kp = __builtin_amdgcn_rcpf(1.0f + e);
            const bool past = (8 * c4 + 4 * hi + i) < dq;
            be[i] = past ? 1.0f - kp : 0.f; ke[i] = past ? kp : 1.f; }
        const float e2 = ke[3], e1 = e2 * ke[2], e0 = e1 * ke[1];
        gp[c4] = e0 * ke[0];
        z[4 * c4 + 3] = be[3]; z[4 * c4 + 2] = be[2] * e2; z[4 * c4 + 1] = be[1] * e1; z[4 * c4 + 0] = be[0] * e0;
    }
    float U = R;
#pragma unroll
    for (int c4 = 3; c4 >= 0; --c4) {
        const F2 t = pair32(gp[c4]);
        const float T = (hi == 0) ? U * t.b : U;
#pragma unroll
        for (int i = 0; i < 4; ++i) z[4 * c4 + i] *= T;
        U *= t.a * t.b;
    }
    R = U;
    LDS_WAIT();
    v_stage(vb, vr, lane);
    LDS_WAIT();
    pv_tile(o, vb, z, lane);
}
__device__ __forceinline__ void sb_item(const bf16* QKV, bf16* OS, LAS unsigned char* vb, int bh, int c, int lane) {
    const int b = bh >> 2, h = bh & 3, q = lane & 31, hi = lane >> 5;
    const size_t rowb = (size_t)b * SEQ;
    const bf16* Qp = QKV + ((size_t)(36 + h) * M + rowb + 32 * c) * 64;
    const bf16* Kb = QKV + ((size_t)(40 + h) * M + rowb) * 64;
    const bf16* Vb = QKV + ((size_t)(44 + h) * M + rowb) * 64;
    bf16x8 qf[4]; ld_frag4_nt(qf, Qp, 64, lane);
    f32x16 o[2]; o[0] = f32x16{}; o[1] = f32x16{};
    float R = 1.0f;
    bf16x8 kf[3][4]; u32x4 vr[3][4];
#pragma unroll
    for (int j = 0; j < 3; ++j) { const int t = (c - j) < 0 ? 0 : (c - j); ld_frag4(kf[j], Kb + (size_t)(32 * t) * 64, 64, lane); v_load(vr[j], Vb + (size_t)(32 * t) * 64, 64, lane); }
#if SB_EARLY_EXIT
#define SB_DONE() (__all(R < 1e-20f))
#else
#define SB_DONE() (false)
#endif
#define SB_STEP(j, kt_) do { sb_step(o, R, kf[j], qf, vr[j], vb, 32 * (c - (kt_)) + q, lane); \
        { const int t = (kt_) - 3 < 0 ? 0 : (kt_) - 3; ld_frag4(kf[j], Kb + (size_t)(32 * t) * 64, 64, lane); v_load(vr[j], Vb + (size_t)(32 * t) * 64, 64, lane); } } while (0)
    for (int kt = c; kt >= 0; kt -= 3) {
        SB_STEP(0, kt); if (kt - 1 < 0 || SB_DONE()) break;
        SB_STEP(1, kt - 1); if (kt - 2 < 0 || SB_DONE()) break;
        SB_STEP(2, kt - 2); if (SB_DONE()) break;
    }
#undef SB_STEP
#undef SB_DONE
    store_ot(OS + (rowb + 32 * c) * 256 + h * 64 + (unsigned)q * 256u, o, 1.0f, hi);
}
__device__ __forceinline__ void attn_phase(unsigned char* Pws, unsigned char* Pscr, LAS unsigned char* lds, int G, int wg, int NGW, int wave, int lane) {
    LAS unsigned char* vb = lds + wave * 4096;
    const bf16* QKV = (const bf16*)(Pws + WS_R);
    const int v = (G % 8 == 0) ? (wg % 8) * (G / 8) + wg / 8 : wg;
    const int base = v * NWAVES + wave;
    for (int it = base; it < 2048; it += NGW) { const int itu = __builtin_amdgcn_readfirstlane(it);
#if SB_EARLY_EXIT
        sb_item(QKV, (bf16*)(Pws + WS_OS), vb, itu >> 7, itu & 127, lane);
#else
        sb_item(QKV, (bf16*)(Pws + WS_OS), vb, itu >> 7, ((itu & 127) + 16 * (itu >> 8)) & 127, lane);
#endif
    }
    dil_items(QKV, (bf16*)(Pscr + OUT_OD3), (float*)(Pws + WS_LSE), vb, base, NGW, lane);
}
__device__ __forceinline__ void merge_phase(unsigned char* Pws, unsigned char* Pscr, int idx_lo, int idx_hi, int first, int stride) {
    const bf16* OD3 = (const bf16*)(Pscr + OUT_OD3); bf16* OD = (bf16*)(Pscr + OUT_OD); const float* LSE = (const float*)(Pws + WS_LSE);
    const __amdgpu_buffer_rsrc_t odr = __builtin_amdgcn_make_buffer_rsrc(OD, 0, M * 256 * 2, 0x00020000);
    for (int idx = idx_lo + first; idx < idx_hi; idx += stride) {
        const int t = idx >> 5, hh = (idx >> 3) & 3, ch = idx & 7;
        const float l0 = LSE[(size_t)t * 12 + hh], l1 = LSE[(size_t)t * 12 + 4 + hh], l2 = LSE[(size_t)t * 12 + 8 + hh];
        const float mx = fmaxf(l0, fmaxf(l1, l2)); float e0 = __expf(l0 - mx), e1 = __expf(l1 - mx), e2 = __expf(l2 - mx); const float inv = 1.0f / (e0 + e1 + e2);
        e0 *= inv; e1 *= inv; e2 *= inv;
        const u32x4 a = *(const u32x4*)(OD3 + (size_t)t * 768 + hh * 64 + ch * 8), bq = *(const u32x4*)(OD3 + (size_t)t * 768 + (4 + hh) * 64 + ch * 8), cq = *(const u32x4*)(OD3 + (size_t)t * 768 + (8 + hh) * 64 + ch * 8);
        u32x4 o;
#pragma unroll
        for (int k = 0; k < 4; ++k) {
            const float lo = e0 * __uint_as_float(a[k] << 16) + e1 * __uint_as_float(bq[k] << 16) + e2 * __uint_as_float(cq[k] << 16);
            const float hi = e0 * __uint_as_float(a[k] & 0xffff0000u) + e1 * __uint_as_float(bq[k] & 0xffff0000u) + e2 * __uint_as_float(cq[k] & 0xffff0000u);
            o[k] = pk2(lo, hi);
        }
        __builtin_amdgcn_raw_buffer_store_b128(o, odr, (unsigned)(t * 256 + hh * 64 + ch * 8) * 2u, 0,   16);
    }
}
__device__ __forceinline__ void merge_quarter(unsigned char* Pws, unsigned char* Pscr, int idx_lo, int tid) {
    const bf16* OD3 = (const bf16*)(Pscr + OUT_OD3); bf16* OD = (bf16*)(Pscr + OUT_OD); const float* LSE = (const float*)(Pws + WS_LSE);
    const __amdgpu_buffer_rsrc_t odr = __builtin_amdgcn_make_buffer_rsrc(OD, 0, M * 256 * 2, 0x00020000);
    float ls[4][3]; u32x4 v[4][3];
#pragma unroll
    for (int j = 0; j < 4; ++j) { const unsigned idx = (unsigned)(idx_lo + tid + 512 * j), t = idx >> 5, hh = (idx >> 3) & 3, ch = idx & 7;
#pragma unroll
        for (int g = 0; g < 3; ++g) { ls[j][g] = __builtin_nontemporal_load(LSE + (t * 12u + 4u * g + hh)); v[j][g] = __builtin_nontemporal_load((const u32x4*)(OD3 + (t * 768u + (4u * g + hh) * 64u + ch * 8u))); } }
#pragma unroll
    for (int j = 0; j < 4; ++j) { const unsigned idx = (unsigned)(idx_lo + tid + 512 * j), t = idx >> 5, hh = (idx >> 3) & 3, ch = idx & 7;
        const float mx = fmaxf(ls[j][0], fmaxf(ls[j][1], ls[j][2])); float e0 = __expf(ls[j][0] - mx), e1 = __expf(ls[j][1] - mx), e2 = __expf(ls[j][2] - mx); const float inv = 1.0f / (e0 + e1 + e2);
        e0 *= inv; e1 *= inv; e2 *= inv;
        u32x4 o;
#pragma unroll
        for (int k = 0; k < 4; ++k) {
            const float lo = e0 * __uint_as_float(v[j][0][k] << 16) + e1 * __uint_as_float(v[j][1][k] << 16) + e2 * __uint_as_float(v[j][2][k] << 16);
            const float hi = e0 * __uint_as_float(v[j][0][k] & 0xffff0000u) + e1 * __uint_as_float(v[j][1][k] & 0xffff0000u) + e2 * __uint_as_float(v[j][2][k] & 0xffff0000u);
            o[k] = pk2(lo, hi);
        }
        __builtin_amdgcn_raw_buffer_store_b128(o, odr, (t * 256u + hh * 64u + ch * 8u) * 2u, 0,   16); }
}
__device__ __forceinline__ void panel_arrive(unsigned* cnt, int pm, int wave, int lane) {
    asm volatile("s_waitcnt vmcnt(0)" ::: "memory");
    __syncthreads();
    if (wave == 0 && lane == 0) __hip_atomic_fetch_add(cnt + 64 * pm, 1u, __ATOMIC_RELAXED, __HIP_MEMORY_SCOPE_AGENT);
}
__device__ __forceinline__ void panel_sync(unsigned* cnt, int pm, int wave, int lane) {
    asm volatile("s_waitcnt vmcnt(0)" ::: "memory");
    __syncthreads();
    if (wave == 0) {
        if (lane == 0) __hip_atomic_fetch_add(cnt + 64 * pm, 1u, __ATOMIC_RELAXED, __HIP_MEMORY_SCOPE_AGENT);
        unsigned spins = 0;
        while ((unsigned)__builtin_amdgcn_readfirstlane(__hip_atomic_load(cnt + 64 * pm, __ATOMIC_RELAXED, __HIP_MEMORY_SCOPE_AGENT)) < 4u) { __builtin_amdgcn_s_sleep(1); if (++spins > (1u << 20)) break; }
        __builtin_amdgcn_fence(__ATOMIC_ACQUIRE, "agent"); }
    asm volatile("s_waitcnt vmcnt(0) lgkmcnt(0)" ::: "memory"); __syncthreads();
}
__device__ __forceinline__ void final_phase(unsigned char* Pws, float* Pout, const float* Pnf, int gw, int NGW, int lane) {
    const float* ssqp = (const float*)(Pws + WS_SSQ); const f32x4* gf = (const f32x4*)Pnf + 2 * lane; const bf16* xb = (const bf16*)(Pws + WS_XB);
    for (int m = gw; m < M; m += NGW) {
        const float rs = pg8::row_rstd(ssqp, m);
        const u32x4* xr = (const u32x4*)(xb + (size_t)m * D) + lane; f32x4* orow = (f32x4*)(Pout + (size_t)m * D) + 2 * lane;
#pragma unroll
        for (int j = 0; j < 2; ++j) { const u32x4 w = xr[64 * j];
            const f32x4 v0 = {__uint_as_float(w.x << 16), __uint_as_float(w.x & 0xffff0000u), __uint_as_float(w.y << 16), __uint_as_float(w.y & 0xffff0000u)};
            const f32x4 v1 = {__uint_as_float(w.z << 16), __uint_as_float(w.z & 0xffff0000u), __uint_as_float(w.w << 16), __uint_as_float(w.w & 0xffff0000u)};
            orow[128 * j] = v0 * rs * gf[128 * j]; orow[128 * j + 1] = v1 * rs * gf[128 * j + 1]; }
    }
}

struct Args { const float* in[15]; float* out; unsigned char* ws; int ph_lo, ph_hi; };
constexpr int N_PHASES = 10 * DEPTH + 1;
__global__ void __launch_bounds__(NWAVES * 64, 2) fwd_megakernel(Args args) {
    extern __shared__ __attribute__((aligned(16))) unsigned char lds_raw[];
    LAS unsigned char* lds = (LAS unsigned char*)lds_raw;
    cg::grid_group grid = cg::this_grid();
    volatile LAS unsigned* bst = (volatile LAS unsigned*)(lds + 131072);
    if (threadIdx.x < 2) bst[threadIdx.x] = 0u;
    __syncthreads();
    (void)xcd_barrier_post((unsigned*)(args.ws + WS_BAR), bst);
    for (int ph = args.ph_lo; ph < args.ph_hi; ++ph) {
        const __attribute__((address_space(4))) unsigned char* ka = (const __attribute__((address_space(4))) unsigned char*)__builtin_amdgcn_kernarg_segment_ptr();
        asm volatile("" : "+s"(ka));
#define KARG(i) (*(const float* const __attribute__((address_space(4)))*)(ka + 8 * (i)))
        const float* Px = KARG(0); float* Pout = (float*)KARG(15); unsigned char* ws = (unsigned char*)KARG(16);
        int tid = threadIdx.x, G = gridDim.x, wg = blockIdx.x; asm volatile("" : "+v"(tid), "+s"(G), "+s"(wg));
        const int lane = tid & 63, wave = __builtin_amdgcn_readfirstlane(tid >> 6);
        const int gw = wave * G + wg, NGW = G * NWAVES;
        const int gtid = wg * (NWAVES * 64) + tid, NT = G * NWAVES * 64;
        unsigned char* wsw = ws + WS_W;
        float* ssqp = (float*)(ws + WS_SSQ);
        bf16* XB = (bf16*)(ws + WS_XB); bf16* H = (bf16*)(ws + WS_R); bf16* QKV = (bf16*)(ws + WS_R); bf16* GATE = (bf16*)(ws + WS_GATE);
        const int l = ph / 10, k = (ph == N_PHASES - 1) ? 10 : ph % 10;
        const bool fuse_final = (G == 256);
        if (k == 10 && fuse_final) continue;
        const bool chain = (G == 256);
        if ((k == 6 || k == 7) && chain) continue;
        if (k == 0 && l > 0) continue;
        unsigned char* dA1 = (unsigned char*)Pout + 32 * MiB;
        unsigned char* wA = (l == 0) ? wsw : dA1;
        if (k == 0) {
            { const ConvSrc CS{KARG(1), KARG(2), KARG(3), KARG(4), KARG(5), KARG(6), KARG(7), KARG(8), KARG(9), KARG(10), KARG(11), KARG(12), KARG(13)}; conv_phase(Px, CS, ws, l, lds, gw, NGW, wave, lane); }
        }
        else if (k == 1 || k == 8) {
            pg8::Gemm g{XB, (const bf16*)(k == 1 ? wA + W_1CAT : wsw + W_2CAT), M, 2 * FF, D}; pg8::StaticOrder S; S.init(M, 2 * FF, G, wg);
            { const LAS float* rsl_c = (const LAS float*)(lds + RSL_OFF); LAS float* rsl_w = (LAS float*)(lds + RSL_OFF); pg8::Unit uu;
#pragma unroll 1
              for (int i = 0; i < pg8::RSL_UNITS; ++i) if (S.next(i, uu) && tid < 256) rsl_w[i * 256 + tid] = pg8::row_rstd(ssqp, uu.pm * 256 + tid);
              __syncthreads(); (void)rsl_c; }
            pg8::EpiSwiglu E{H, ssqp, (const LAS float*)(lds + RSL_OFF)};
            pg8::gemm_phase<pg8::EpiSwiglu, pg8::StaticOrder, true, true>(lds, g, S, E);
            if ((l == 0) || (k == 1)) {
                const int rem = ((M / 256) * (2 * FF / 256)) % G; const bool idle = (rem == 0) || (wg >= rem);
                if (idle) {
                    const int nidle = (rem == 0) ? G : G - rem, iw = (rem == 0) ? wg : wg - rem;
                    const ConvSrc CS{KARG(1), KARG(2), KARG(3), KARG(4), KARG(5), KARG(6), KARG(7), KARG(8), KARG(9), KARG(10), KARG(11), KARG(12), KARG(13)};
                    const int lo = (l == 0) ? (k == 1 ? 0 : CI_IN) : CI_B, hi = (l == 0) ? (k == 1 ? CI_IN : CI_B) : CI_END;
                    conv_items(CS, 1, lo, hi, dA1, wsw, lds, wave * nidle + iw, nidle * NWAVES, wave, lane);
                }
            }
        } else if (k == 2 || k == 9) {
            pg8::Gemm g{H, (const bf16*)(k == 2 ? wA + W_D1 : wsw + W_D2), M, D, FF}; pg8::StaticOrder S; S.init(M, D, G, wg);
            if (ph == 2) { pg8::EpiResid<true> E{Px, XB, ssqp, 0.5f}; pg8::gemm_phase<pg8::EpiResid<true>, pg8::StaticOrder, true, true>(lds, g, S, E); }
            else if (ph == N_PHASES - 2 && fuse_final) { pg8::EpiResidFinal E{XB, Pout, KARG(14), (unsigned*)(ws + WS_XSLOT), (unsigned*)(ws + WS_CNT), 0.5f};
                pg8::gemm_phase<pg8::EpiResidFinal, pg8::StaticOrder, true, true>(lds, g, S, E); }
            else { pg8::EpiResid<false> E{nullptr, XB, ssqp, 0.5f}; pg8::gemm_phase<pg8::EpiResid<false>, pg8::StaticOrder, true, true>(lds, g, S, E); }
        } else if (k == 3) {
            pg8::Gemm g{XB, (const bf16*)(wA + W_IN), M, NIN, D}; pg8::StaticOrder S; S.init(M, NIN, G, wg);
            { const LAS float* rsl_c = (const LAS float*)(lds + RSL_OFF); LAS float* rsl_w = (LAS float*)(lds + RSL_OFF); pg8::Unit uu;
#pragma unroll 1
              for (int i = 0; i < pg8::RSL_UNITS; ++i) if (S.next(i, uu) && tid < 256) rsl_w[i * 256 + tid] = pg8::row_rstd(ssqp, uu.pm * 256 + tid);
              __syncthreads(); (void)rsl_c; }
            pg8::EpiWin E{QKV, GATE, ssqp, (const float*)(ws + WS_ROPE), (const LAS float*)(lds + RSL_OFF)};
            pg8::gemm_phase<pg8::EpiWin, pg8::StaticOrder, true, true>(lds, g, S, E);
        } else if (k == 4) {
            attn_phase(ws, (unsigned char*)Pout, lds, G, wg, NGW, wave, lane);
        }
        else if (k == 5) {
            pg8::Unit pu; { pg8::StaticOrder S; S.init(M, D, G, wg); S.next(0, pu); }
            unsigned* pcnt = (unsigned*)(ws + WS_PCNT) + (size_t)l * 2 * 4096;
            if (chain) { const int r0 = pu.pm * 256 + pu.pn * 64; merge_quarter(ws, (unsigned char*)Pout, r0 * 32, tid); panel_arrive(pcnt, pu.pm, wave, lane); }
            else merge_phase(ws, (unsigned char*)Pout, 0, M * 32, gtid, NT);
            if (chain) {
                int K256 = 256; asm volatile("" : "+s"(K256));
                { pg8::Gemm g{(const bf16*)(ws + WS_OS), (const bf16*)(wsw + W_PS), M, D, K256, (const bf16*)((unsigned char*)Pout + OUT_OD), (const bf16*)(wsw + W_PD)}; pg8::PairOrder S; S.init(M, D, G, wg); S.cnt = pcnt;
                  pg8::EpiGate2 E{GATE, (bf16*)(ws + WS_Y1), (bf16*)(ws + WS_Y)};
                  pg8::gemm_phase<pg8::EpiGate2, pg8::PairOrder, true, true>(lds, g, S, E); }
                panel_sync(pcnt + 4096, pu.pm, wave, lane);
                { pg8::Gemm g{(const bf16*)(ws + WS_Y), (const bf16*)(wsw + W_OUT), M, D, D}; pg8::StaticOrder S; S.init(M, D, G, wg);
                  pg8::EpiResid<false> E{nullptr, XB, ssqp, 1.0f};
                  pg8::gemm_phase<pg8::EpiResid<false>, pg8::StaticOrder, true, true>(lds, g, S, E); }
            }
        }
        else if (k == 6) {
            int K256 = 256; asm volatile("" : "+s"(K256));
            { pg8::Gemm g{(const bf16*)((unsigned char*)Pout + OUT_OD), (const bf16*)(wsw + W_PD), M, D, K256}; pg8::StaticOrder S; S.init(M, D, G, wg);
              pg8::EpiGate<false> E{GATE, (bf16*)(ws + WS_Y1), (bf16*)(ws + WS_Y)};
              pg8::gemm_phase<pg8::EpiGate<false>, pg8::StaticOrder, true, true>(lds, g, S, E); }
            { pg8::Gemm g{(const bf16*)(ws + WS_OS), (const bf16*)(wsw + W_PS), M, D, K256}; pg8::StaticOrder S; S.init(M, D, G, wg);
              pg8::EpiGate<true> E{GATE + 1024, (bf16*)(ws + WS_Y1), (bf16*)(ws + WS_Y)};
              pg8::gemm_phase<pg8::EpiGate<true>, pg8::StaticOrder, true, true>(lds, g, S, E); }
        } else if (k == 7) {
            pg8::Gemm g{(const bf16*)(ws + WS_Y), (const bf16*)(wsw + W_OUT), M, D, D}; pg8::StaticOrder S; S.init(M, D, G, wg);
            pg8::EpiResid<false> E{nullptr, XB, ssqp, 1.0f};
            pg8::gemm_phase<pg8::EpiResid<false>, pg8::StaticOrder, true, true>(lds, g, S, E);
        } else final_phase(ws, Pout, KARG(14), gw, NGW, lane);
        if (ph + 1 < args.ph_hi && !(fuse_final && ph == N_PHASES - 2)) {
            unsigned* barw = (unsigned*)(ws + WS_BAR);
            if (args.ph_hi > 1000) grid.sync();
            { XcdBarrier bar; bar.bar = barw; bar.x = xb_xcc_id(); bar.st = bst; xcd_barrier(bar);
            }
        }
    }
}

extern "C" void kernel_launch(void* const* d_in, const int* in_sizes, int n_in, void* d_out, int out_size, void* d_ws, size_t ws_size, hipStream_t stream) {
    static int grid = 0;
    if (grid == 0) {
        if (n_in != 15 || in_sizes[0] != M * D || out_size != M * D || ws_size < WS_END) { fprintf(stderr, "kernel_launch: unexpected shapes (n_in %d, in0 %d, out %d, ws %zu)\n", n_in, n_in > 0 ? in_sizes[0] : -1, out_size, ws_size); grid = -1; return; }
        int dev = 0, cus = 0, per_cu = 0;
        if (hipGetDevice(&dev) != hipSuccess || hipDeviceGetAttribute(&cus, hipDeviceAttributeMultiprocessorCount, dev) != hipSuccess) { grid = -1; return; }
        if (hipFuncSetAttribute((const void*)fwd_megakernel, hipFuncAttributeMaxDynamicSharedMemorySize, LDS_BYTES) != hipSuccess) { fprintf(stderr, "kernel_launch: hipFuncSetAttribute failed\n"); grid = -1; return; }
        if (hipOccupancyMaxActiveBlocksPerMultiprocessor(&per_cu, (const void*)fwd_megakernel, NWAVES * 64, LDS_BYTES) != hipSuccess || per_cu < 1) { fprintf(stderr, "kernel_launch: occupancy query says %d\n", per_cu); per_cu = 1; }
        (void)hipGetLastError();
        grid = cus;
        if (grid < 176) { fprintf(stderr, "kernel_launch: %d CUs: the per-workgroup rstd table holds 8 units per GEMM phase (needs >= 176 workgroups)\n", grid); grid = -1; return; }
    }
    if (grid < 0) return;
    Args a{};
    for (int i = 0; i < 15; ++i) a.in[i] = (const float*)d_in[i];
    a.out = (float*)d_out; a.ws = (unsigned char*)d_ws;
#if N_LAUNCH_MODE == 0
    a.ph_lo = 0; a.ph_hi = N_PHASES;
    if (hipMemsetAsync((char*)d_ws + WS_BAR, 0, WS_ZERO_BYTES, stream) != hipSuccess) { fprintf(stderr, "kernel_launch: memset of the barrier words failed\n"); return; }
    void* kargs[] = {&a};
    const hipError_t e = hipLaunchCooperativeKernel((const void*)fwd_megakernel, dim3(grid), dim3(NWAVES * 64), kargs, LDS_BYTES, stream);
    if (e != hipSuccess) fprintf(stderr, "kernel_launch: cooperative launch failed: %s (grid %d)\n", hipGetErrorString(e), grid);
#else
    for (int ph = 0; ph < N_PHASES; ++ph) {
        a.ph_lo = ph; a.ph_hi = ph + 1;
        hipLaunchKernelGGL(fwd_megakernel, dim3(grid), dim3(NWAVES * 64), LDS_BYTES, stream, a);
    }
#endif
}
```
